# Optimizing an MI355X kernel written in HIP

```python
import math
import jax
import jax.numpy as jnp
from jax import lax
import numpy as np


D_MODEL = 1024
BATCH = 16
SEQ = 2048
DEPTH = 2

GRID_W = 64
CTX_LEN = 256
N_MIXERS = 2
NORM_EPS = 1e-6

RW_HEAD = 64
RW_HEADS = D_MODEL // RW_HEAD
DECAY_LORA = 64
AAA_LORA = 64
GATE_LORA = 128
LNX_EPS = 64e-5

DA_HEADS = 8
DA_HEAD = D_MODEL // (2 * DA_HEADS)
QBLOCK = 128
ROPE_BASE = 10000.0
ROPE_FREQS = DA_HEAD // 4

N_GROUPS = 4
EXPERTS_PER_GROUP = 8
TOP_K_IN_GROUP = 2
D_EXPERT = D_MODEL // 4

kernel_name = 'hybrid_rwkv7_diffattn_hmoe_prefix_dit'


def rmsnorm(x, g, eps=NORM_EPS):
    xf = x.astype(jnp.float32)
    y = xf * lax.rsqrt(jnp.mean(xf * xf, axis=-1, keepdims=True) + eps)
    return y.astype(x.dtype) * g


def modulate(x, g, shift, scale):
    return rmsnorm(x, g) * (1 + scale) + shift


def centred_delta(h):
    hp = jnp.pad(h, ((0, 0), (1, 1), (0, 0)))
    return 0.5 * (hp[:, :-2] + hp[:, 2:]) - h


def split_heads(z):
    return z.reshape(z.shape[:-1] + (RW_HEADS, RW_HEAD))


def rwkv_features(h, mu, w_rkv, w0, w1, w2, a0, a1, a2, g1, g2, k_k, k_a):
    dx = centred_delta(h)
    mix = lambda j: h + dx * mu[j]
    r, k, v = jnp.einsum('jbtd,jde->jbte', jnp.stack([mix(0), mix(1), mix(2)]), w_rkv)
    xw, xa, xg = mix(3), mix(4), mix(5)
    w_lora = jnp.einsum('zbtr,zre->zbte', jnp.tanh(jnp.einsum('btd,zdr->zbtr', xw, w1)), w2)
    decay = jnp.exp(-jnp.exp(-jax.nn.softplus(-(w0[:, None, None, :] + w_lora)) - 0.5))
    a = jax.nn.sigmoid(a0[:, None, None, :]
                       + jnp.einsum('zbtr,zre->zbte', jnp.einsum('btd,zdr->zbtr', xa, a1), a2))
    g = jax.nn.sigmoid(xg @ g1) @ g2
    kkf = split_heads(k * k_k).astype(jnp.float32)
    kk = (kkf * lax.rsqrt(jnp.sum(kkf * kkf, axis=-1, keepdims=True) + 1e-12)).astype(k.dtype)
    k_dir = k[None] * (1 + (a - 1) * k_a)
    return (split_heads(r), split_heads(decay), split_heads(k_dir), split_heads(v), kk,
            split_heads(a), g)


def dir_time_major(z):
    z = jnp.stack([z[0], jnp.flip(z[1], axis=1)])
    return jnp.moveaxis(z, 2, 0).astype(jnp.float32)


def both_dirs(z):
    return dir_time_major(jnp.stack([z, z]))


def rwkv_scan(S0, r, decay, k_dir, v, kk, a):
    xs = (both_dirs(r), dir_time_major(decay), dir_time_major(k_dir), both_dirs(v),
          both_dirs(kk), dir_time_major(a))

    def step(S, inp):
        r_t, w_t, k_t, v_t, kk_t, a_t = inp
        sa = jnp.einsum('zbhij,zbhj->zbhi', S, -kk_t)
        S = (S * w_t[..., None, :] + sa[..., None] * (kk_t * a_t)[..., None, :]
             + v_t[..., None] * k_t[..., None, :])
        return S, jnp.einsum('zbhij,zbhj->zbhi', S, r_t)

    S_final, y = lax.scan(step, S0, xs)
    y = jnp.moveaxis(y, 0, 2)
    return S_final, y[0] + jnp.flip(y[1], axis=1)


def rwkv_output(y, r, k_dir, v, g, r_k, lnx_g, lnx_b, w_o):
    B, T, H, N = y.shape
    mean = jnp.mean(y, axis=-1, keepdims=True)
    var = jnp.mean(jnp.square(y - mean), axis=-1, keepdims=True)
    yn = ((y - mean) * lax.rsqrt(var + LNX_EPS)).reshape(B, T, H * N).astype(v.dtype) * lnx_g + lnx_b
    bonus = jnp.sum(r[None] * k_dir * r_k, axis=(0, 4))[..., None] * v
    return ((yn + bonus.reshape(B, T, H * N)) * g) @ w_o


def rwkv_mixer(hc, hl, need_ctx, mu, w_rkv, w0, w1, w2, a0, a1, a2, g1, g2, k_k, k_a, r_k,
               lnx_g, lnx_b, w_o):
    rc, wc, kc, vc, kkc, ac, gc = rwkv_features(hc, mu, w_rkv, w0, w1, w2, a0, a1, a2, g1, g2, k_k, k_a)
    rl, wl, kl, vl, kkl, al, gl = rwkv_features(hl, mu, w_rkv, w0, w1, w2, a0, a1, a2, g1, g2, k_k, k_a)
    S0 = jnp.zeros((2, hl.shape[0], RW_HEADS, RW_HEAD, RW_HEAD), jnp.float32)
    S_ctx, yc = rwkv_scan(S0, rc, wc, kc, vc, kkc, ac)
    _, yl = rwkv_scan(S_ctx, rl, wl, kl, vl, kkl, al)
    ol = rwkv_output(yl, rl, kl, vl, gl, r_k, lnx_g, lnx_b, w_o)
    oc = rwkv_output(yc, rc, kc, vc, gc, r_k, lnx_g, lnx_b, w_o) if need_ctx else None
    return oc, ol


def axial_rope_tables(L):
    rows = L // GRID_W
    row = jnp.repeat(jnp.arange(rows), GRID_W)
    col = jnp.tile(jnp.arange(GRID_W), rows)
    inv = ROPE_BASE ** (-jnp.arange(ROPE_FREQS, dtype=jnp.float32) / ROPE_FREQS)
    ang = jnp.stack([row, col], axis=-1).astype(jnp.float32)[:, :, None] * inv
    return jnp.cos(ang), jnp.sin(ang)


def apply_axial_rope(x, cos, sin):
    xs = x.reshape(x.shape[:-1] + (2, 2, ROPE_FREQS))
    x1, x2 = xs[..., 0, :], xs[..., 1, :]
    c = cos.astype(x.dtype)[:, None, None]
    s = sin.astype(x.dtype)[:, None, None]
    out = jnp.stack([x1 * c - x2 * s, x1 * s + x2 * c], axis=-2)
    return out.reshape(x.shape)


def diff_attend(q, k, v, lam):
    s = jnp.einsum('bqhmd,bkhmd->bhmqk', q, k).astype(jnp.float32) * (DA_HEAD ** -0.5)
    p = jax.nn.softmax(s, axis=-1)
    attn = (p[:, :, 0] - lam * p[:, :, 1]).astype(v.dtype)
    return jnp.einsum('bhqk,bkhe->bqhe', attn, v)


def diff_mixer(hc, hl, need_ctx, lam_init, w_qkv, q_norm_g, k_norm_g, lam_q1, lam_k1, lam_q2,
               lam_k2, subln_g, w_o):
    def project(h):
        B, T, _ = h.shape
        q, k, v = jnp.split(h @ w_qkv, 3, axis=-1)
        q = rmsnorm(q.reshape(B, T, DA_HEADS, 2, DA_HEAD), q_norm_g)
        k = rmsnorm(k.reshape(B, T, DA_HEADS, 2, DA_HEAD), k_norm_g)
        return q, k, v.reshape(B, T, DA_HEADS, 2 * DA_HEAD)

    def finish(o):
        B, T = o.shape[:2]
        return (rmsnorm(o, subln_g) * (1 - lam_init)).reshape(B, T, D_MODEL) @ w_o

    f32 = jnp.float32
    lam = (jnp.exp(jnp.sum(lam_q1.astype(f32) * lam_k1.astype(f32)))
           - jnp.exp(jnp.sum(lam_q2.astype(f32) * lam_k2.astype(f32))) + lam_init)
    qc, kc, vc = project(hc)
    ql, kl, vl = project(hl)
    B, L = hl.shape[:2]
    cos, sin = axial_rope_tables(L)
    ql = apply_axial_rope(ql, cos, sin)
    kl = apply_axial_rope(kl, cos, sin)
    k_all = jnp.concatenate([kc, kl], axis=1)
    v_all = jnp.concatenate([vc, vl], axis=1)
    nb = L // QBLOCK
    qb = jnp.moveaxis(ql.reshape(B, nb, QBLOCK, DA_HEADS, 2, DA_HEAD), 1, 0)
    ob = lax.map(lambda q: diff_attend(q, k_all, v_all, lam), qb)
    ol = finish(jnp.moveaxis(ob, 0, 1).reshape(B, L, DA_HEADS, 2 * DA_HEAD))
    oc = finish(diff_attend(qc, kc, vc, lam)) if need_ctx else None
    return oc, ol


def hier_moe(h, router_g, router_g_b, router_e, router_e_b, w_gate, w_up, w_down):
    pg = jax.nn.softmax((h @ router_g + router_g_b).astype(jnp.float32), axis=-1)
    gi = jnp.argmax(pg, axis=-1)
    gw = jnp.take_along_axis(pg, gi[:, None], axis=-1)
    el = (jnp.einsum('nd,gde->nge', h, router_e) + router_e_b).astype(jnp.float32)
    el = jnp.take_along_axis(el, gi[:, None, None], axis=1)[:, 0]
    tv, ti = lax.top_k(jax.nn.softmax(el, axis=-1), TOP_K_IN_GROUP)
    w_comb = gw * tv / jnp.sum(tv, axis=-1, keepdims=True)
    eid = gi[:, None] * EXPERTS_PER_GROUP + ti
    gates = jnp.sum(jax.nn.one_hot(eid, N_GROUPS * EXPERTS_PER_GROUP, dtype=jnp.float32)
                    * w_comb[..., None], axis=1)
    gates = gates.reshape(-1, N_GROUPS, EXPERTS_PER_GROUP).astype(h.dtype)
    y = jnp.zeros_like(h)
    for g in range(N_GROUPS):
        hid = (jax.nn.silu(jnp.einsum('nd,edf->nef', h, w_gate[g]))
               * jnp.einsum('nd,edf->nef', h, w_up[g]))
        y = y + jnp.einsum('nef,efd->nd', hid * gates[:, g, :, None], w_down[g])
    return y


def setup_inputs(seed: int = 0) -> dict:
    key = jax.random.key(seed)
    ks = iter(jax.random.split(key, 64))
    f32 = jnp.float32
    D = D_MODEL
    sd = D ** -0.5
    nr = (DEPTH + 1) // 2
    nd = DEPTH // 2

    def nrm(shape, scale=1.0):
        return scale * jax.random.normal(next(ks), shape, f32)

    def near(shape, base=1.0):
        return base + 0.05 * jax.random.normal(next(ks), shape, f32)

    G, E, F = N_GROUPS, EXPERTS_PER_GROUP, D_EXPERT
    return {
        'x': nrm((BATCH, SEQ, D)),
        'c': nrm((BATCH, D)),
        'ctx': nrm((BATCH, CTX_LEN, D)),
        'c_ctx': nrm((D,)),
        'norm1_g': near((DEPTH, D)),
        'norm2_g': near((DEPTH, D)),
        'w_mod': nrm((DEPTH, D, 6 * D), 0.5 * sd),
        'b_mod': nrm((DEPTH, 6 * D), 0.02),
        'rw_mu': jax.random.uniform(next(ks), (nr, 6, D), f32),
        'rw_w_rkv': nrm((nr, 3, D, D), sd),
        'rw_w0': jax.random.uniform(next(ks), (nr, 2, D), f32, -6.0, -0.5),
        'rw_w1': nrm((nr, 2, D, DECAY_LORA), sd),
        'rw_w2': nrm((nr, 2, DECAY_LORA, D), 0.1 * DECAY_LORA ** -0.5),
        'rw_a0': nrm((nr, 2, D), 0.1),
        'rw_a1': nrm((nr, 2, D, AAA_LORA), sd),
        'rw_a2': nrm((nr, 2, AAA_LORA, D), 0.1 * AAA_LORA ** -0.5),
        'rw_g1': nrm((nr, D, GATE_LORA), sd),
        'rw_g2': nrm((nr, GATE_LORA, D), GATE_LORA ** -0.5),
        'rw_k_k': near((nr, D), 0.85),
        'rw_k_a': near((nr, D)),
        'rw_r_k': nrm((nr, RW_HEADS, RW_HEAD), 0.1),
        'rw_lnx_g': near((nr, D)),
        'rw_lnx_b': nrm((nr, D), 0.02),
        'rw_w_o': nrm((nr, D, D), sd),
        'da_w_qkv': nrm((nd, D, 3 * D), sd),
        'da_q_norm_g': near((nd, DA_HEAD)),
        'da_k_norm_g': near((nd, DA_HEAD)),
        'da_lam_q1': nrm((nd, DA_HEAD), 0.1),
        'da_lam_k1': nrm((nd, DA_HEAD), 0.1),
        'da_lam_q2': nrm((nd, DA_HEAD), 0.1),
        'da_lam_k2': nrm((nd, DA_HEAD), 0.1),
        'da_subln_g': near((nd, 2 * DA_HEAD)),
        'da_w_o': nrm((nd, D, D), sd),
        'moe_router_g': nrm((DEPTH, D, G), sd),
        'moe_router_g_b': nrm((DEPTH, G), 0.01),
        'moe_router_e': nrm((DEPTH, G, D, E), sd),
        'moe_router_e_b': nrm((DEPTH, G, E), 0.01),
        'moe_w_gate': nrm((DEPTH, G, E, D, F), sd),
        'moe_w_up': nrm((DEPTH, G, E, D, F), sd),
        'moe_w_down': nrm((DEPTH, G, E, F, D), F ** -0.5),
    }


def reference(x, c, ctx, c_ctx, norm1_g, norm2_g, w_mod, b_mod,
              rw_mu, rw_w_rkv, rw_w0, rw_w1, rw_w2, rw_a0, rw_a1, rw_a2, rw_g1, rw_g2,
              rw_k_k, rw_k_a, rw_r_k, rw_lnx_g, rw_lnx_b, rw_w_o,
              da_w_qkv, da_q_norm_g, da_k_norm_g, da_lam_q1, da_lam_k1, da_lam_q2, da_lam_k2,
              da_subln_g, da_w_o,
              moe_router_g, moe_router_g_b, moe_router_e, moe_router_e_b,
              moe_w_gate, moe_w_up, moe_w_down):
    B, L, D = x.shape
    n_ctx = ctx.shape[1]
    for i in range(DEPTH):
        need_ctx = i < DEPTH - 1
        j = i // N_MIXERS
        mod = jnp.split((jax.nn.silu(c) @ w_mod[i] + b_mod[i])[:, None, :], 6, axis=-1)
        mod_c = jnp.split(jax.nn.silu(c_ctx) @ w_mod[i] + b_mod[i], 6, axis=-1)
        hl = modulate(x, norm1_g[i], mod[0], mod[1])
        hc = modulate(ctx, norm1_g[i], mod_c[0], mod_c[1])
        if i % N_MIXERS == 0:
            oc, ol = rwkv_mixer(hc, hl, need_ctx, rw_mu[j], rw_w_rkv[j], rw_w0[j], rw_w1[j], rw_w2[j],
                                rw_a0[j], rw_a1[j], rw_a2[j], rw_g1[j], rw_g2[j], rw_k_k[j],
                                rw_k_a[j], rw_r_k[j], rw_lnx_g[j], rw_lnx_b[j], rw_w_o[j])
        else:
            lam_init = 0.8 - 0.6 * math.exp(-0.3 * i)
            oc, ol = diff_mixer(hc, hl, need_ctx, lam_init, da_w_qkv[j], da_q_norm_g[j],
                                da_k_norm_g[j], da_lam_q1[j], da_lam_k1[j], da_lam_q2[j],
                                da_lam_k2[j], da_subln_g[j], da_w_o[j])
        x = x + mod[2] * ol
        hl = modulate(x, norm2_g[i], mod[3], mod[4])
        moe_args = (moe_router_g[i], moe_router_g_b[i], moe_router_e[i], moe_router_e_b[i],
                    moe_w_gate[i], moe_w_up[i], moe_w_down[i])
        if need_ctx:
            ctx = ctx + mod_c[2] * oc
            hc = modulate(ctx, norm2_g[i], mod_c[3], mod_c[4])
            f = hier_moe(jnp.concatenate([hc.reshape(-1, D), hl.reshape(-1, D)], axis=0), *moe_args)
            ctx = ctx + mod_c[5] * f[:B * n_ctx].reshape(ctx.shape)
            x = x + mod[5] * f[B * n_ctx:].reshape(x.shape)
        else:
            x = x + mod[5] * hier_moe(hl.reshape(-1, D), *moe_args).reshape(x.shape)
    return x
```

```cpp
#include <hip/hip_runtime.h>
#include <cstdio>
#include <cstdint>

#ifndef MK_SCAN_CHUNKED
#define MK_SCAN_CHUNKED 2
#endif
#ifndef MK_ONE_LAUNCH
#define MK_ONE_LAUNCH 1
#endif
namespace pg8 {
#define PG8_LAS __attribute__((address_space(3)))
typedef unsigned short bf16_t;
typedef short bf16x8 __attribute__((ext_vector_type(8)));
typedef float f32x4 __attribute__((ext_vector_type(4)));
typedef unsigned u32x4 __attribute__((ext_vector_type(4)));
constexpr int BM = 256, BK = 64, HALF = 128, HTB = HALF * BK * 2  , STAGE_BYTES = 8 * HTB, NXCD = 8, WGM = 8;

__host__ __device__ __forceinline__ int lds_byte(int r, int c) { const int st = (r >> 4) * 2 + (c >> 5), rr = r & 15, cc = c & 31, ob = rr * 64 + cc * 2; return st * 1024 + (ob ^ (((ob >> 9) & 1) << 5)); }
__host__ __device__ __forceinline__ void stage_rc(int b, int& R, int& C) { const int st = b / 1024, sb = b % 1024, swz = sb ^ (((sb >> 9) & 1) << 5); R = (st >> 1) * 16 + swz / 64; C = (st & 1) * 32 + (swz % 64) / 2; }
__host__ __device__ __forceinline__ int perm32(int rho) { const int n = rho >> 4, i = rho & 15; return 8 * (i >> 2) + 4 * n + (i & 3); }

struct Unit { int pm, pn; };
struct Gemm { const bf16_t* A; const bf16_t* Bt; int lda, K; };

struct StaticOrder {
    int nM, nN, nwg, G, c;
    __host__ __device__ void init(int M, int N, int G_, int c_) { nM = M / BM; nN = N / BM; nwg = nM * nN; G = G_; c = c_; }
    __host__ __device__ bool next(int i, Unit& u) const {
        const long L = (long)i * G + c; if (L >= nwg) return false;
        int wgid = (int)L; { const int q = nwg / NXCD, r = nwg % NXCD, xcd = wgid % NXCD, off = wgid / NXCD; wgid = (xcd < r ? xcd * (q + 1) : r * (q + 1) + (xcd - r) * q) + off; }
        const int nig = WGM * nN, gid = wgid / nig, fm = gid * WGM, gsz = (nM - fm) < WGM ? (nM - fm) : WGM;
        u.pm = fm + ((wgid % nig) % gsz); u.pn = (wgid % nig) / gsz; return true;
    }
    __device__ __forceinline__ void a_ready(const Unit&) const {}
    __device__ __forceinline__ void done(const Unit&) const {}
};

__device__ __forceinline__ unsigned cvt_pk_bf16(float lo, float hi) { unsigned r; asm volatile("v_cvt_pk_bf16_f32 %0, %1, %2" : "=v"(r) : "v"(lo), "v"(hi)); return r; }
template <class F> struct EpiP {
    static constexpr bool PERM = true, AFTER_DRAIN = false; F f;
    __device__ __forceinline__ void operator()(const f32x4 (&acc)[2][2][4][2], const Unit& u, int wr, int wc, int fr, int fq) const {
        const int row0 = u.pm * BM + wr * 64 + fr, col0 = u.pn * BM + wc * 32 + 8 * fq;
#pragma unroll
        for (int ai = 0; ai < 2; ++ai)
#pragma unroll
            for (int m = 0; m < 4; ++m)
#pragma unroll
                for (int bj = 0; bj < 2; ++bj) f.op(row0 + ai * HALF + m * 16, col0 + bj * HALF, acc[ai][bj][m][0], acc[ai][bj][m][1]);
    }
};
template <class F> struct EpiN {
    static constexpr bool PERM = false, AFTER_DRAIN = false; F f;
    __device__ __forceinline__ void operator()(const f32x4 (&acc)[2][2][4][2], const Unit& u, int wr, int wc, int fr, int fq) const {
        const int row0 = u.pm * BM + wr * 64 + fr, col0 = u.pn * BM + wc * 32 + 4 * fq;
#pragma unroll
        for (int ai = 0; ai < 2; ++ai)
#pragma unroll
            for (int m = 0; m < 4; ++m)
#pragma unroll
                for (int bj = 0; bj < 2; ++bj)
#pragma unroll
                    for (int n = 0; n < 2; ++n) f.op(row0 + ai * HALF + m * 16, col0 + bj * HALF + n * 16, acc[ai][bj][m][n]);
    }
};
template <class Epi, class Sched, bool ALIGN_EPI = false, bool SP2 = false, bool GATHER = false>
__device__ __forceinline__ void gemm_phase(PG8_LAS unsigned char* lds, const Gemm g, const Sched& S, const Epi& E) {
    const int tid = threadIdx.x, wid = __builtin_amdgcn_readfirstlane(tid >> 6), lane = tid & 63, wr = wid >> 2, wc = wid & 3, fr = lane & 15, fq = lane >> 4;
    const int K = g.K, nt = K / BK;
    unsigned voffA[2], voffB[2];
#pragma unroll
    for (int i = 0; i < 2; ++i) { int R, C; stage_rc(tid * 16 + i * 8192, R, C); const int Rb = Epi::PERM ? ((R & ~31) + perm32(R & 31)) : R;
        voffA[i] = (unsigned)(R * g.lda + C) * 2u; voffB[i] = (unsigned)(Rb * K + C) * 2u; }
    const size_t kstep = (size_t)(BK * 2);
    const size_t hstepA = GATHER ? (size_t)0 : (size_t)HALF * g.lda * 2, hstepB = (size_t)HALF * K * 2;
    const size_t tstepA = 2 * hstepA, tstepB = 2 * hstepB;
    unsigned vC[2][2], vN[2][2];
    const PG8_LAS int* gtab = (const PG8_LAS int*)(lds + 131072);
#define PG8_GLOAD(dst, ui_) do { _Pragma("unroll") for (int _h = 0; _h < 2; ++_h) _Pragma("unroll") for (int _i = 0; _i < 2; ++_i) { int R, C; stage_rc(tid * 16 + _i * 8192, R, C); dst[_h][_i] = (unsigned)(gtab[(ui_) * 256 + 128 * _h + R] + C * 2); } } while (0)
#define PG8_STAGE_A(bufoff, gbase, h, nx) do { if constexpr (GATHER) { unsigned _v[2] = {(nx) ? vN[h][0] : vC[h][0], (nx) ? vN[h][1] : vC[h][1]}; PG8_STAGE(bufoff, gbase, _v); } else { PG8_STAGE(bufoff, (gbase) + (h) * hstepA, voffA); } } while (0)
    const unsigned ldsw = (unsigned)wid * 1024u;
    const int aoff = lds_byte(wr * 64 + fr, fq * 8), boff = lds_byte(wc * 32 + fr, fq * 8);
#define PG8_SA(b, h) (((b) * 2 + (h)) * HTB)
#define PG8_SB(b, h) ((4 + (b) * 2 + (h)) * HTB)
#define PG8_STAGE(bufoff, gbase, voff) do { _Pragma("unroll") for (int _i = 0; _i < 2; ++_i) \
        __builtin_amdgcn_global_load_lds((const unsigned*)((const char*)(gbase) + (voff)[_i]), (PG8_LAS unsigned*)(lds + (bufoff) + ldsw + _i * 8192), 16, 0, 0); } while (0)
#define PG8_LDA(dst, b, h) do { _Pragma("unroll") for (int m = 0; m < 4; ++m) _Pragma("unroll") for (int k = 0; k < 2; ++k) dst[m][k] = *(const PG8_LAS bf16x8*)(lds + PG8_SA(b, h) + aoff + m * 2048 + k * 1024); } while (0)
#define PG8_LDB(dst, b, h) do { _Pragma("unroll") for (int n = 0; n < 2; ++n) _Pragma("unroll") for (int k = 0; k < 2; ++k) dst[n][k] = *(const PG8_LAS bf16x8*)(lds + PG8_SB(b, h) + boff + n * 2048 + k * 1024); } while (0)
#define PG8_MMA(ai, bj, At, Bt) do { __builtin_amdgcn_s_setprio(1); _Pragma("unroll") for (int m = 0; m < 4; ++m) _Pragma("unroll") for (int n = 0; n < 2; ++n) _Pragma("unroll") for (int k = 0; k < 2; ++k) \
        acc[ai][bj][m][n] = __builtin_amdgcn_mfma_f32_16x16x32_bf16(Bt[n][k], At[m][k], acc[ai][bj][m][n], 0, 0, 0); __builtin_amdgcn_s_setprio(0); } while (0)
#define PG8_WAIT_V(n) asm volatile("s_waitcnt vmcnt(" #n ")" ::: "memory")
#define PG8_WAIT_L(n) asm volatile("s_waitcnt lgkmcnt(" #n ")" ::: "memory")
#define PG8_BAR __builtin_amdgcn_s_barrier()
#define PG8_SCHED __builtin_amdgcn_sched_barrier(0)
    Unit cur, nxt; int ui = 0;
    if (!S.next(0, cur)) return;
    f32x4 acc[2][2][4][2];
#pragma unroll
    for (int a = 0; a < 2; ++a)
#pragma unroll
        for (int b = 0; b < 2; ++b)
#pragma unroll
            for (int m = 0; m < 4; ++m)
#pragma unroll
                for (int n = 0; n < 2; ++n) acc[a][b][m][n] = (f32x4){0.f, 0.f, 0.f, 0.f};
    bf16x8 At[4][2], B0[2][2], B1[2][2];
    const char* cA = (const char*)g.A + (size_t)cur.pm * tstepA; const char* cB = (const char*)g.Bt + (size_t)cur.pn * tstepB;
    S.a_ready(cur);
    if constexpr (GATHER) { PG8_GLOAD(vC, 0); }
    if constexpr (SP2) {
        PG8_STAGE(PG8_SB(0, 0), cB, voffB); PG8_STAGE(PG8_SB(0, 1), cB + hstepB, voffB); PG8_STAGE_A(PG8_SA(0, 0), cA, 0, false); PG8_STAGE_A(PG8_SA(0, 1), cA, 1, false);
        if (wr == 1) PG8_BAR;
        PG8_WAIT_V(2); PG8_BAR;
        PG8_STAGE(PG8_SB(1, 0), cB + kstep, voffB); PG8_STAGE_A(PG8_SA(1, 0), cA + kstep, 0, false); PG8_STAGE(PG8_SB(1, 1), cB + hstepB + kstep, voffB);
        PG8_WAIT_V(6); PG8_BAR;
    } else {
        PG8_STAGE(PG8_SB(0, 0), cB, voffB); PG8_STAGE(PG8_SA(0, 0), cA, voffA); PG8_STAGE(PG8_SB(0, 1), cB + hstepB, voffB); PG8_STAGE(PG8_SA(0, 1), cA + hstepA, voffA);
        if (wr == 1) PG8_BAR;
        PG8_WAIT_V(4); PG8_BAR;
        PG8_STAGE(PG8_SB(1, 0), cB + kstep, voffB); PG8_STAGE(PG8_SA(1, 0), cA + kstep, voffA); PG8_STAGE(PG8_SB(1, 1), cB + hstepB + kstep, voffB);
        PG8_WAIT_V(6); PG8_BAR;
    }
    for (;;) {
        const bool has_next = S.next(ui + 1, nxt);
        if constexpr (GATHER) { if (has_next) { PG8_GLOAD(vN, ui + 1); } else { vN[0][0] = vC[0][0]; vN[0][1] = vC[0][1]; vN[1][0] = vC[1][0]; vN[1][1] = vC[1][1]; } }
        const char* nA = has_next ? (const char*)g.A + (size_t)nxt.pm * tstepA : cA; const char* nB = has_next ? (const char*)g.Bt + (size_t)nxt.pn * tstepB : cB;
        for (int t = 0; t < nt; t += 2) {
            const bool last = (t == nt - 2);
            const char* a1 = cA + (size_t)(t + 1) * kstep;
            const char* a2 = last ? nA : cA + (size_t)(t + 2) * kstep; const char* b2 = last ? nB : cB + (size_t)(t + 2) * kstep;
            const char* a3 = a2 + kstep; const char* b3 = b2 + kstep;
            if (last && has_next) S.a_ready(nxt);
            if constexpr (SP2) {
            PG8_LDB(B0, 0, 0); PG8_LDB(B1, 0, 1); PG8_SCHED; PG8_LDA(At, 0, 0); PG8_STAGE_A(PG8_SA(1, 1), a1, 1, false);
            PG8_WAIT_V(8); PG8_WAIT_L(0); PG8_BAR; PG8_MMA(0, 0, At, B0); PG8_MMA(0, 1, At, B1); PG8_BAR; PG8_SCHED;
            PG8_LDA(At, 0, 1); PG8_STAGE(PG8_SB(0, 0), b2, voffB); PG8_STAGE(PG8_SB(0, 1), b2 + hstepB, voffB); PG8_STAGE_A(PG8_SA(0, 0), a2, 0, last);
            PG8_WAIT_V(8); PG8_WAIT_L(0); PG8_BAR; PG8_MMA(1, 0, At, B0); PG8_MMA(1, 1, At, B1); PG8_BAR; PG8_SCHED;
            PG8_LDB(B0, 1, 0); PG8_LDB(B1, 1, 1); PG8_SCHED; PG8_LDA(At, 1, 0); PG8_STAGE_A(PG8_SA(0, 1), a2, 1, last);
            PG8_WAIT_V(8); PG8_WAIT_L(0); PG8_BAR; PG8_MMA(0, 0, At, B0); PG8_MMA(0, 1, At, B1); PG8_BAR; PG8_SCHED;
            PG8_LDA(At, 1, 1); PG8_STAGE(PG8_SB(1, 0), b3, voffB); PG8_STAGE(PG8_SB(1, 1), b3 + hstepB, voffB); PG8_STAGE_A(PG8_SA(1, 0), a3, 0, last);
            PG8_WAIT_V(8); PG8_WAIT_L(0); PG8_BAR; PG8_MMA(1, 0, At, B0); PG8_MMA(1, 1, At, B1); PG8_BAR; PG8_SCHED;
            } else {
            PG8_LDB(B0, 0, 0); PG8_SCHED; PG8_LDA(At, 0, 0); PG8_STAGE(PG8_SA(1, 1), a1 + hstepA, voffA);
            PG8_WAIT_L(8); PG8_BAR; PG8_WAIT_L(0); PG8_MMA(0, 0, At, B0); PG8_BAR; PG8_SCHED;
            PG8_LDB(B1, 0, 1); PG8_STAGE(PG8_SB(0, 0), b2, voffB);
            PG8_BAR; PG8_WAIT_L(0); PG8_MMA(0, 1, At, B1); PG8_BAR;
            PG8_LDA(At, 0, 1); PG8_STAGE(PG8_SA(0, 0), a2, voffA);
            PG8_BAR; PG8_WAIT_L(0); PG8_MMA(1, 0, At, B0); PG8_BAR; PG8_SCHED;
            PG8_STAGE(PG8_SB(0, 1), b2 + hstepB, voffB);
            PG8_WAIT_V(6); PG8_BAR; PG8_MMA(1, 1, At, B1); PG8_BAR;
            PG8_LDB(B0, 1, 0); PG8_SCHED; PG8_LDA(At, 1, 0); PG8_STAGE(PG8_SA(0, 1), a2 + hstepA, voffA);
            PG8_WAIT_L(8); PG8_BAR; PG8_WAIT_L(0); PG8_MMA(0, 0, At, B0); PG8_BAR; PG8_SCHED;
            PG8_LDB(B1, 1, 1); PG8_STAGE(PG8_SB(1, 0), b3, voffB);
            PG8_BAR; PG8_WAIT_L(0); PG8_MMA(0, 1, At, B1); PG8_BAR;
            PG8_LDA(At, 1, 1); PG8_STAGE(PG8_SA(1, 0), a3, voffA);
            PG8_BAR; PG8_WAIT_L(0); PG8_MMA(1, 0, At, B0); PG8_BAR; PG8_SCHED;
            PG8_STAGE(PG8_SB(1, 1), b3 + hstepB, voffB);
            PG8_WAIT_V(6); PG8_BAR; PG8_MMA(1, 1, At, B1); PG8_BAR;
            }
        }
        if constexpr (ALIGN_EPI) { if (wr == 0) PG8_BAR; }
        if constexpr (!Epi::AFTER_DRAIN) { E(acc, cur, wr, wc, fr, fq); S.done(cur); }
        if (!has_next) break;
#pragma unroll
        for (int a = 0; a < 2; ++a)
#pragma unroll
            for (int b = 0; b < 2; ++b)
#pragma unroll
                for (int m = 0; m < 4; ++m)
#pragma unroll
                    for (int n = 0; n < 2; ++n) acc[a][b][m][n] = (f32x4){0.f, 0.f, 0.f, 0.f};
        cur = nxt; cA = nA; cB = nB; ++ui;
        if constexpr (GATHER) { vC[0][0] = vN[0][0]; vC[0][1] = vN[0][1]; vC[1][0] = vN[1][0]; vC[1][1] = vN[1][1]; }
        if constexpr (ALIGN_EPI) { if (wr == 1) PG8_BAR; }
    }
    PG8_WAIT_V(0);
    if constexpr (!ALIGN_EPI) { if (wr == 0) PG8_BAR; }
    PG8_BAR;
    if constexpr (Epi::AFTER_DRAIN) { E.fused(acc, cur, wr, wc, fr, fq, lds, wid, lane); S.done(cur); }
#undef PG8_SA
#undef PG8_SB
#undef PG8_STAGE
#undef PG8_STAGE_A
#undef PG8_GLOAD
#undef PG8_LDA
#undef PG8_LDB
#undef PG8_MMA
#undef PG8_WAIT_V
#undef PG8_WAIT_L
#undef PG8_BAR
#undef PG8_SCHED
}
}

constexpr int NWAVES = 8, NTHR = 512;
constexpr int D = 1024, NB = 16, TL = 2048, TC = 256, TT = TL + TC, NT = NB * TT, NLAT = NB * TL;
constexpr int N_PH = 23;
constexpr size_t MiB = 1u << 20;
constexpr size_t US = (size_t)NT * D;
constexpr size_t WS_CTL = 0, CTL_ZERO_BYTES = 1 * MiB;
constexpr size_t WS_MOD = 1 * MiB;
constexpr size_t WS_BT0 = 2 * MiB;
constexpr size_t WS_WO0 = 16 * MiB, WS_WQKV = 18 * MiB, WS_WO1 = 24 * MiB, WS_L2A = 26 * MiB, WS_L2B = 28 * MiB;
constexpr size_t WS_BON = 30 * MiB, WS_INVN = 32 * MiB + 512 * 1024, WS_ROUTE = 35 * MiB, WS_TOKSLOT = 36 * MiB + 512 * 1024, WS_SW = 37 * MiB  , WS_TOK = 37 * MiB + 64 * 1024  , WS_BLKBASE = 37 * MiB + 512 * 1024;
constexpr size_t WS_S0 = 40 * MiB, SLOTB = 72 * MiB;
constexpr size_t WS_L1 = 472 * MiB;
constexpr size_t WS_XS = 40 * MiB, WS_HID = 200 * MiB, WS_MW0 = 240 * MiB, WS_MW1 = 256 * MiB, WS_END = 512 * MiB;
constexpr int MAXSLOT = 81920;
constexpr int CW_TMO = 0, CW_BAR = 4096, CW_CNT = 16384;
constexpr int RING_BYTES = 131072, RW_BYTES = 147456, LDSCTL_OFF = 147456, LDS_BYTES = 147456 + 1024;
constexpr int LC_LCNT = 0, LC_SEG = 32, LC_NT = 64, LC_BAR = 72, LC_TILE_B = 512;

#define GAS __attribute__((address_space(1)))
#define LAS __attribute__((address_space(3)))
typedef unsigned short bf16;
typedef unsigned v4u __attribute__((ext_vector_type(4)));
typedef unsigned v2u __attribute__((ext_vector_type(2)));
typedef float f32x4 __attribute__((ext_vector_type(4)));
#define RLX_AGENT __ATOMIC_RELAXED, __HIP_MEMORY_SCOPE_AGENT
#define LDS_WAIT() asm volatile("s_waitcnt lgkmcnt(0)" ::: "memory")
#define VM_WAIT() asm volatile("s_waitcnt vmcnt(0)" ::: "memory")

__device__ __forceinline__ unsigned f2bf(float f) { unsigned u = __builtin_bit_cast(unsigned, f); return (u + 0x7fffu + ((u >> 16) & 1u)) >> 16; }
__device__ __forceinline__ unsigned pk2(float lo, float hi) { return f2bf(lo) | (f2bf(hi) << 16); }
typedef float f32x2_t __attribute__((ext_vector_type(2)));
typedef __bf16 bf16x2_t __attribute__((ext_vector_type(2)));
__device__ __forceinline__ unsigned pk2hw(float lo, float hi) { const f32x2_t v = {lo, hi}; const bf16x2_t b = __builtin_convertvector(v, bf16x2_t); return __builtin_bit_cast(unsigned, b); }
__device__ __forceinline__ unsigned f2bfhw(float f) { return pk2hw(f, 0.f) & 0xffffu; }
__device__ __forceinline__ float bflo(unsigned w) { return __builtin_bit_cast(float, w << 16); }
__device__ __forceinline__ float bfhi(unsigned w) { return __builtin_bit_cast(float, w & 0xffff0000u); }
__device__ __forceinline__ void unpack8(v4u w, float (&f)[8]) { f[0] = bflo(w.x); f[1] = bfhi(w.x); f[2] = bflo(w.y); f[3] = bfhi(w.y); f[4] = bflo(w.z); f[5] = bfhi(w.z); f[6] = bflo(w.w); f[7] = bfhi(w.w); }
__device__ __forceinline__ v4u pack8(const float (&f)[8]) { v4u w; w.x = pk2(f[0], f[1]); w.y = pk2(f[2], f[3]); w.z = pk2(f[4], f[5]); w.w = pk2(f[6], f[7]); return w; }
__device__ __forceinline__ float fexp(float x) { return __expf(x); }
__device__ __forceinline__ float frcp(float x) { return __builtin_amdgcn_rcpf(x); }
__device__ __forceinline__ float fsigmoid(float x) { return frcp(1.f + fexp(-x)); }
__device__ __forceinline__ float ftanh(float x) { return 1.f - 2.f * frcp(1.f + fexp(2.f * x)); }
template <int CTRL, int ROWMASK> __device__ __forceinline__ float dpp_get(float v) { return __builtin_bit_cast(float, __builtin_amdgcn_update_dpp(0, __builtin_bit_cast(int, v), CTRL, ROWMASK, 0xf, false)); }
__device__ __forceinline__ float wave_sum(float v) {
    v += dpp_get<0xB1, 0xf>(v);
    v += dpp_get<0x4E, 0xf>(v);
    v += dpp_get<0x141, 0xf>(v);
    v += dpp_get<0x140, 0xf>(v);
    v += dpp_get<0x142, 0xa>(v);
    v += dpp_get<0x143, 0xc>(v);
    return __builtin_bit_cast(float, __builtin_amdgcn_readlane(__builtin_bit_cast(int, v), 63));
}
template <int N> __device__ __forceinline__ void wave_sum_n(float (&v)[N]) {
#pragma unroll
    for (int i = 0; i < N; ++i) v[i] += dpp_get<0xB1, 0xf>(v[i]);
#pragma unroll
    for (int i = 0; i < N; ++i) v[i] += dpp_get<0x4E, 0xf>(v[i]);
#pragma unroll
    for (int i = 0; i < N; ++i) v[i] += dpp_get<0x141, 0xf>(v[i]);
#pragma unroll
    for (int i = 0; i < N; ++i) v[i] += dpp_get<0x140, 0xf>(v[i]);
#pragma unroll
    for (int i = 0; i < N; ++i) v[i] += dpp_get<0x142, 0xa>(v[i]);
#pragma unroll
    for (int i = 0; i < N; ++i) v[i] += dpp_get<0x143, 0xc>(v[i]);
#pragma unroll
    for (int i = 0; i < N; ++i) v[i] = __builtin_bit_cast(float, __builtin_amdgcn_readlane(__builtin_bit_cast(int, v[i]), 63));
}
__device__ __forceinline__ float quad_sum(float v) { v += __shfl_xor(v, 1); v += __shfl_xor(v, 2); return v; }

struct Args { const float* in[40]; float* out; unsigned char* ws; int ph_lo, ph_hi; };

enum { I_X = 0, I_C, I_CTX, I_CCTX, I_N1G, I_N2G, I_WMOD, I_BMOD, I_MU, I_WRKV, I_W0, I_W1, I_W2, I_A0, I_A1, I_A2, I_G1, I_G2, I_KK, I_KA, I_RK, I_LNG, I_LNB, I_RWO,
       I_QKV, I_QNG, I_KNG, I_LQ1, I_LK1, I_LQ2, I_LK2, I_SUBG, I_DWO, I_RG, I_RGB, I_RE, I_REB, I_MG, I_MU_, I_MD };

__device__ __forceinline__ const float* in_row(const Args& a, int row) {
    const int b = row / TT, t = row - b * TT;
    return t < TC ? a.in[I_CTX] + ((size_t)b * TC + t) * D : a.in[I_X] + ((size_t)b * TL + (t - TC)) * D;
}
__device__ __forceinline__ int mod_row(int row) { const int b = row / TT, t = row - b * TT; return t < TC ? 16 : b; }
__device__ __forceinline__ const float* modp(const Args& a, int layer, int mrow, int chunk) { return (const float*)(a.ws + WS_MOD) + ((size_t)(layer * 17 + mrow) * 6 + chunk) * D; }
__device__ __forceinline__ bf16* slotp(const Args& a, int k) { return k < 6 ? (bf16*)(a.ws + WS_S0 + (size_t)k * SLOTB) : (bf16*)a.out; }
__device__ __forceinline__ int lat_row(int lr) { return (lr >> 11) * TT + TC + (lr & 2047); }
#define XB_TMO      128
#define XB_XCNT(j)  (256  + 64 * (j))
#define XB_XSUB(j)  (1280 + 64 * (j))
#define XB_XGEN(j)  (2304 + 64 * (j))
#define XB_TOP      3328
#define XB_TOPGEN   3392
#define XCD_BAR_WORDS 3456
#define XB_SPIN_CAP (1u << 22)

__device__ __forceinline__ unsigned xb_ld(unsigned* p)              { return __hip_atomic_load(p, __ATOMIC_RELAXED, __HIP_MEMORY_SCOPE_AGENT); }
__device__ __forceinline__ unsigned xb_add(unsigned* p, unsigned v) { return __hip_atomic_fetch_add(p, v, __ATOMIC_RELAXED, __HIP_MEMORY_SCOPE_AGENT); }
__device__ __forceinline__ unsigned xb_xcc_id() { return (unsigned)__builtin_amdgcn_s_getreg((3 << 11) | 20) & 0xFu; }
#define XB_SPIN(cond, bar) do { unsigned _sp = 0; while (cond) { __builtin_amdgcn_s_sleep(1); \
    if ((++_sp & 255u) == 0u) { if (xb_ld(&(bar)[XB_TMO])) break; if (_sp > XB_SPIN_CAP) { atomicAdd(&(bar)[XB_TMO], 1u); break; } } } } while (0)

struct XcdBarrier {
    unsigned* bar; unsigned x;
    volatile LAS unsigned* st;
};

__device__ __forceinline__ XcdBarrier xcd_barrier_post(unsigned* bar, volatile LAS unsigned* st) {
    XcdBarrier b; b.bar = bar; b.x = xb_xcc_id(); b.st = st;
    if (threadIdx.x == 0) (void)xb_add(&bar[XB_XCNT(b.x)], 1u);
    return b;
}
__device__ __forceinline__ void xcd_barrier_complete(unsigned* bar, unsigned x, unsigned& nloc, unsigned& nx) {
    const unsigned G = gridDim.x * gridDim.y * gridDim.z;
    unsigned sum, cnt, mine, sp = 0u;
    for (;;) {
        sum = 0u; cnt = 0u; mine = 0u;
#pragma unroll
        for (unsigned j = 0; j < 16; ++j) { const unsigned c = xb_ld(&bar[XB_XCNT(j)]); sum += c; cnt += (c > 0u) ? 1u : 0u; mine = (j == x) ? c : mine; }
        if (sum == G) break;
        __builtin_amdgcn_s_sleep(1);
        if ((++sp & 255u) == 0u) { if (xb_ld(&bar[XB_TMO])) break; if (sp > XB_SPIN_CAP) { atomicAdd(&bar[XB_TMO], 1u); break; } }
    }
    nloc = mine > 0u ? mine : 1u; nx = cnt > 0u ? cnt : 1u;
}

__device__ __forceinline__ void xcd_barrier(const XcdBarrier& b) {
    asm volatile("s_waitcnt vmcnt(0)" ::: "memory");
    __syncthreads();
    if (threadIdx.x == 0) {
        unsigned* bar = b.bar;
        __builtin_amdgcn_s_waitcnt(0);
        unsigned nloc = b.st[0], nx = b.st[1];
        if (nloc == 0u) { xcd_barrier_complete(bar, b.x, nloc, nx); b.st[0] = nloc; b.st[1] = nx; }
        const unsigned old = xb_add(&bar[XB_XSUB(b.x)], 1u);
        const unsigned gen = old / nloc;
        if (old + 1u == (gen + 1u) * nloc) {
            __builtin_amdgcn_fence(__ATOMIC_RELEASE, "agent");
            asm volatile("s_waitcnt vmcnt(0)" ::: "memory");
            const unsigned og = xb_add(&bar[XB_TOP], 1u);
            const unsigned tg = og / nx;
            if (og + 1u == (tg + 1u) * nx) xb_add(&bar[XB_TOPGEN], 1u);
            else XB_SPIN(xb_ld(&bar[XB_TOPGEN]) == tg, bar);
            __builtin_amdgcn_fence(__ATOMIC_ACQUIRE, "agent");
            xb_add(&bar[XB_XGEN(b.x)], 1u);
            asm volatile("s_waitcnt vmcnt(0)" ::: "memory");
        } else {
            XB_SPIN(xb_ld(&bar[XB_XGEN(b.x)]) == gen, bar);
            __builtin_amdgcn_fence(__ATOMIC_ACQUIRE, "agent");
            asm volatile("s_waitcnt vmcnt(0)" ::: "memory");
        }
    }
    __syncthreads();
}

__device__ __forceinline__ void tr_item(const float* W, int N, bf16* WT, int ldt, int row_off, int col_off, const float* ksc, int mode, LAS float* scr, int item, int lane) {
    const int nblk = N >> 5, kb = item / nblk, nb = item - kb * nblk, k0 = 64 * kb, n0 = 32 * nb;
    float tv[32];
#pragma unroll
    for (int i = 0; i < 32; ++i) { const int kk = 2 * i + (lane >> 5); tv[i] = W[(size_t)(k0 + kk) * N + n0 + (lane & 31)]; }
#pragma unroll
    for (int i = 0; i < 32; ++i) { const int kk = 2 * i + (lane >> 5); float v = tv[i]; if (ksc) v *= ksc[k0 + kk]; scr[kk * 33 + (lane & 31)] = v; }
    LDS_WAIT(); asm volatile("" ::: "memory");
    const int c = lane & 7;
#pragma unroll
    for (int j = 0; j < 4; ++j) { const int n = (lane >> 3) + 8 * j; const LAS float* s = scr + (8 * c) * 33 + n;
        v4u o; o.x = pk2(s[0 * 33], s[1 * 33]); o.y = pk2(s[2 * 33], s[3 * 33]); o.z = pk2(s[4 * 33], s[5 * 33]); o.w = pk2(s[6 * 33], s[7 * 33]);
        const int nn = n0 + n; const int drow = (mode == 0) ? nn : (mode == 3) ? ((nn >= 2048) ? nn : ((nn & ~255) + 128 * ((nn >> 4) & 1) + 32 * ((nn >> 6) & 3) + 16 * ((nn >> 5) & 1) + (nn & 15))) : ((nn >> 2) * 8 + (nn & 3) + (mode == 2 ? 4 : 0));
        *(GAS v4u*)(WT + (size_t)(row_off + drow) * ldt + col_off + k0 + 8 * c) = o; }
    LDS_WAIT(); asm volatile("" ::: "memory");
}
__device__ __forceinline__ void run_tr(int& base, const float* W, int K, int N, bf16* WT, int ldt, int row_off, int col_off, const float* ksc, int mode, LAS float* scr, int gw, int NGW, int lane) {
    const int nitems = (K >> 6) * (N >> 5);
    int it = gw - (base % NGW); if (it < 0) it += NGW;
    for (; it < nitems; it += NGW) tr_item(W, N, WT, ldt, row_off, col_off, ksc, mode, scr, it, lane);
    base += nitems;
}
__device__ __forceinline__ void zero_rect(bf16* base, int ld, int r0, int nr, int c0, int nc, int gt, int NGT) {
    const int cpr = nc >> 3, total = nr * cpr;
    for (int i = gt; i < total; i += NGT) { const int r = i / cpr, c = i - r * cpr; *(GAS v4u*)(base + (size_t)(r0 + r) * ld + c0 + 8 * c) = (v4u){0u, 0u, 0u, 0u}; }
}
__device__ __forceinline__ void convert_moe(const Args& a, int layer, size_t ws_off, LAS unsigned char* lds, int wave, int lane, int bid, int G) {
    LAS float* scr = (LAS float*)(lds + wave * 16384);
    const int gw = bid * NWAVES + wave, NGW = G * NWAVES; int base = 0;
    bf16* Wgu = (bf16*)(a.ws + ws_off); bf16* Wd = Wgu + (size_t)32 * 512 * 1024;
    for (int e = 0; e < 32; ++e) {
        const size_t eo = (size_t)(layer * 32 + e) * 1024 * 256;
        run_tr(base, a.in[I_MG] + eo, 1024, 256, Wgu + (size_t)e * 512 * 1024, 1024, 0, 0, nullptr, 1, scr, gw, NGW, lane);
        run_tr(base, a.in[I_MU_] + eo, 1024, 256, Wgu + (size_t)e * 512 * 1024, 1024, 0, 0, nullptr, 2, scr, gw, NGW, lane);
        run_tr(base, a.in[I_MD] + eo, 256, 1024, Wd + (size_t)e * 1024 * 256, 256, 0, 0, nullptr, 0, scr, gw, NGW, lane);
    }
}

__device__ __forceinline__ void p0_prologue(const Args& a, LAS unsigned char* lds, int tid, int lane, int wave, int bid, int G) {
    LAS float* sil = (LAS float*)lds;
    LAS float* part = (LAS float*)(lds + 69632);
    float* MOD = (float*)(a.ws + WS_MOD);
    for (int item = bid; item < 192; item += G) {
        const int l = item / 96, n0 = (item - l * 96) * 64;
        { float cv[34];
#pragma unroll
          for (int q = 0; q < 34; ++q) { const int i = tid + NTHR * q, r = q >> 1, k = i & 1023; cv[q] = (r < 16) ? a.in[I_C][r * 1024 + k] : a.in[I_CCTX][k]; }
#pragma unroll
          for (int q = 0; q < 34; ++q) sil[tid + NTHR * q] = cv[q] / (1.f + expf(-cv[q])); }
        __syncthreads();
        f32x4 acc[17];
#pragma unroll
        for (int r = 0; r < 17; ++r) acc[r] = (f32x4){0.f, 0.f, 0.f, 0.f};
        const int cq = lane & 15, kp = lane >> 4;
        const float* wm = a.in[I_WMOD] + (size_t)l * D * 6144 + n0 + 4 * cq;
#pragma unroll 1
        for (int jb = 0; jb < 4; ++jb) { f32x4 wv[2][4];
#pragma unroll
            for (int jj = 0; jj < 2; ++jj)
#pragma unroll
                for (int i = 0; i < 4; ++i) wv[jj][i] = *(const GAS f32x4*)(wm + (size_t)(128 * wave + 16 * (2 * jb + jj) + 4 * kp + i) * 6144);
#pragma unroll
            for (int jj = 0; jj < 2; ++jj) { const int k = 128 * wave + 16 * (2 * jb + jj) + 4 * kp;
#pragma unroll
                for (int r = 0; r < 17; ++r) { const f32x4 sv = *(const LAS f32x4*)(sil + r * 1024 + k); acc[r] += (wv[jj][0] * sv.x + wv[jj][1] * sv.y) + (wv[jj][2] * sv.z + wv[jj][3] * sv.w); } } }
#pragma unroll
        for (int r = 0; r < 17; ++r) {
#pragma unroll
            for (int c = 0; c < 4; ++c) { float v = acc[r][c]; v += __shfl_xor(v, 16); v += __shfl_xor(v, 32); acc[r][c] = v; }
            if (kp == 0) *(LAS f32x4*)(part + (wave * 17 + r) * 64 + 4 * cq) = acc[r]; }
        __syncthreads();
        for (int i = tid; i < 17 * 64; i += NTHR) { const int r = i >> 6, ln = i & 63; float s = 0.f;
#pragma unroll
            for (int w = 0; w < 8; ++w) s += part[(w * 17 + r) * 64 + ln];
            MOD[(size_t)(l * 17 + r) * 6144 + n0 + ln] = s + a.in[I_BMOD][l * 6144 + n0 + ln]; }
        __syncthreads();
    }
    LAS float* scr = (LAS float*)(lds + wave * 16384);
    const int gw = bid * NWAVES + wave, NGW = G * NWAVES; int base = 0;
    bf16* BT0 = (bf16*)(a.ws + WS_BT0);
    bf16* BLO = BT0 + (size_t)3072 * 1024;
    for (int j = 0; j < 3; ++j) run_tr(base, a.in[I_WRKV] + (size_t)j * D * D, 1024, 1024, BT0, 1024, j * 1024, 0, nullptr, 0, scr, gw, NGW, lane);
    for (int z = 0; z < 2; ++z) {
        run_tr(base, a.in[I_W1] + (size_t)z * D * 64, 1024, 64, BLO, 1024, 64 * z, 0, nullptr, 0, scr, gw, NGW, lane);
        run_tr(base, a.in[I_A1] + (size_t)z * D * 64, 1024, 64, BLO, 1024, 256 + 64 * z, 0, nullptr, 0, scr, gw, NGW, lane);
    }
    run_tr(base, a.in[I_G1], 1024, 128, BLO, 1024, 512, 0, nullptr, 0, scr, gw, NGW, lane);
    run_tr(base, a.in[I_RWO], 1024, 1024, (bf16*)(a.ws + WS_WO0), 1024, 0, 0, nullptr, 0, scr, gw, NGW, lane);
    run_tr(base, a.in[I_QKV], 1024, 3072, (bf16*)(a.ws + WS_WQKV), 1024, 0, 0, nullptr, 3, scr, gw, NGW, lane);
    run_tr(base, a.in[I_DWO], 1024, 1024, (bf16*)(a.ws + WS_WO1), 1024, 0, 0, nullptr, 0, scr, gw, NGW, lane);
    bf16* L2A = (bf16*)(a.ws + WS_L2A); bf16* L2B = (bf16*)(a.ws + WS_L2B);
    for (int z = 0; z < 2; ++z) {
        run_tr(base, a.in[I_W2] + (size_t)z * 64 * D, 64, 1024, L2A, 256, z * 1024, z * 64, nullptr, 0, scr, gw, NGW, lane);
        run_tr(base, a.in[I_A2] + (size_t)z * 64 * D, 64, 1024, L2A, 256, 2048 + z * 1024, 128 + z * 64, nullptr, 0, scr, gw, NGW, lane);
    }
    run_tr(base, a.in[I_G2], 128, 1024, L2B, 256, 0, 0, nullptr, 0, scr, gw, NGW, lane);
    const int gt = bid * NTHR + tid, NGT = G * NTHR;
    for (int i = gt; i < 64 * 16; i += NGT) { const int pos = i >> 4, f = i & 15; const float ang = (float)pos * exp2f(-(float)f * (13.287712379549449f / 16.f));
        float* R = (float*)(a.ws + WS_SW) + pos * 32 + (f >> 3) * 16 + (f & 7); R[0] = __cosf(ang); R[8] = __sinf(ang); }
    zero_rect(BLO, 1024, 128, 128, 0, 1024, gt, NGT); zero_rect(BLO, 1024, 384, 128, 0, 1024, gt, NGT); zero_rect(BLO, 1024, 640, 128, 0, 1024, gt, NGT);
    zero_rect(L2A, 256, 0, 1024, 64, 192, gt, NGT);
    zero_rect(L2A, 256, 1024, 1024, 0, 64, gt, NGT);  zero_rect(L2A, 256, 1024, 1024, 128, 128, gt, NGT);
    zero_rect(L2A, 256, 2048, 1024, 0, 128, gt, NGT); zero_rect(L2A, 256, 2048, 1024, 192, 64, gt, NGT);
    zero_rect(L2A, 256, 3072, 1024, 0, 192, gt, NGT);
    zero_rect(L2B, 256, 0, 1024, 128, 128, gt, NGT);
}

__device__ __forceinline__ int colb(int lane, int j) { return 8 * lane + 512 * (j >> 1) + 4 * (j & 1); }
__device__ __forceinline__ void ld_row_bf(const bf16* row, int lane, v2u (&x)[4]) {
#pragma unroll
    for (int jj = 0; jj < 2; ++jj) { const v4u t = *(const GAS v4u*)(row + 8 * lane + 512 * jj); x[2 * jj] = (v2u){t.x, t.y}; x[2 * jj + 1] = (v2u){t.z, t.w}; } }
__device__ __forceinline__ void st_row_bf(bf16* row, int lane, const v2u (&x)[4]) {
#pragma unroll
    for (int jj = 0; jj < 2; ++jj) { v4u t; t.x = x[2 * jj].x; t.y = x[2 * jj].y; t.z = x[2 * jj + 1].x; t.w = x[2 * jj + 1].y; *(GAS v4u*)(row + 8 * lane + 512 * jj) = t; } }
__device__ __forceinline__ void modulate_row(const float* xr, const float* g, const float* sh, const float* sc, int lane, f32x4 (&h)[4]) {
    f32x4 v[4]; float ss = 0.f;
#pragma unroll
    for (int j = 0; j < 4; ++j) { v[j] = *(const GAS f32x4*)(xr + colb(lane, j)); ss += (v[j].x * v[j].x + v[j].y * v[j].y) + (v[j].z * v[j].z + v[j].w * v[j].w); }
    const float rstd = rsqrtf(wave_sum(ss) * (1.f / D) + 1e-6f);
#pragma unroll
    for (int j = 0; j < 4; ++j) { const int c = colb(lane, j); const f32x4 gv = *(const GAS f32x4*)(g + c), sv = *(const GAS f32x4*)(sc + c), hv = *(const GAS f32x4*)(sh + c);
        h[j] = (v[j] * rstd) * gv * (sv + 1.f) + hv; }
}
__device__ __forceinline__ f32x4 ld4bf(const bf16* p) { const v2u y = *(const GAS v2u*)p; return (f32x4){bflo(y.x), bfhi(y.x), bflo(y.y), bfhi(y.y)}; }
__device__ __forceinline__ void modulate_row_bf(const bf16* xr, const float* g, const float* sh, const float* sc, int lane, f32x4 (&h)[4]) {
    f32x4 v[4]; float ss = 0.f;
    v2u xb_[4]; ld_row_bf(xr, lane, xb_);
#pragma unroll
    for (int j = 0; j < 4; ++j) { v[j] = (f32x4){bflo(xb_[j].x), bfhi(xb_[j].x), bflo(xb_[j].y), bfhi(xb_[j].y)}; ss += (v[j].x * v[j].x + v[j].y * v[j].y) + (v[j].z * v[j].z + v[j].w * v[j].w); }
    const float rstd = rsqrtf(wave_sum(ss) * (1.f / D) + 1e-6f);
#pragma unroll
    for (int j = 0; j < 4; ++j) { const int c = colb(lane, j); const f32x4 gv = *(const GAS f32x4*)(g + c), sv = *(const GAS f32x4*)(sc + c), hv = *(const GAS f32x4*)(sh + c);
        h[j] = (v[j] * rstd) * gv * (sv + 1.f) + hv; }
}
__device__ __forceinline__ void store_row_bf16(bf16* dst, int lane, const f32x4 (&h)[4]) {
#pragma unroll
    for (int jj = 0; jj < 2; ++jj) { v4u o; o.x = pk2hw(h[2 * jj].x, h[2 * jj].y); o.y = pk2hw(h[2 * jj].z, h[2 * jj].w); o.z = pk2hw(h[2 * jj + 1].x, h[2 * jj + 1].y); o.w = pk2hw(h[2 * jj + 1].z, h[2 * jj + 1].w); *(GAS v4u*)(dst + 8 * lane + 512 * jj) = o; }
}
__device__ __forceinline__ void h_l0(const Args& a, int row, int lane, f32x4 (&h)[4]) {
    const int mr = mod_row(row); modulate_row(in_row(a, row), a.in[I_N1G], modp(a, 0, mr, 0), modp(a, 0, mr, 1), lane, h);
}
__device__ __forceinline__ void p1_h(const Args& a, int row, int lane, int& cmr, f32x4 (&gg)[4], f32x4 (&hh)[4], f32x4 (&h)[4]) {
    const float* xr = in_row(a, row); f32x4 v[4]; float ss = 0.f;
#pragma unroll
    for (int j = 0; j < 4; ++j) { v[j] = *(const GAS f32x4*)(xr + colb(lane, j)); ss += (v[j].x * v[j].x + v[j].y * v[j].y) + (v[j].z * v[j].z + v[j].w * v[j].w); }
    const int mr = mod_row(row);
    if (mr != cmr) { cmr = mr; const float* g = a.in[I_N1G]; const float* sh = modp(a, 0, mr, 0); const float* sc = modp(a, 0, mr, 1);
#pragma unroll
        for (int j = 0; j < 4; ++j) { const int c = colb(lane, j); gg[j] = *(const GAS f32x4*)(g + c) * (*(const GAS f32x4*)(sc + c) + 1.f); hh[j] = *(const GAS f32x4*)(sh + c); } }
    const float rstd = rsqrtf(wave_sum(ss) * (1.f / D) + 1e-6f);
#pragma unroll
    for (int j = 0; j < 4; ++j) h[j] = (v[j] * rstd) * gg[j] + hh[j];
}
__device__ __forceinline__ void p1_modshift(const Args& a, int lane, int wave, int bid, int G) {
    const int NGW = G * NWAVES, gw = bid * NWAVES + wave, rpw = (NT + NGW - 1) / NGW, first = gw * rpw, last = (first + rpw < NT) ? first + rpw : NT;
    if (first >= NT) return;
    f32x4 mu[6][4];
#pragma unroll
    for (int m = 0; m < 6; ++m)
#pragma unroll
        for (int j = 0; j < 4; ++j) mu[m][j] = *(const GAS f32x4*)(a.in[I_MU] + m * D + colb(lane, j));
    f32x4 hp[4], hc[4], hn[4], mgg[4], mhh[4]; int cmr = -1;
#pragma unroll
    for (int j = 0; j < 4; ++j) hp[j] = (f32x4){0.f, 0.f, 0.f, 0.f};
    if (first > 0) p1_h(a, first - 1, lane, cmr, mgg, mhh, hp);
    p1_h(a, first, lane, cmr, mgg, mhh, hc);
    for (int row = first; row < last; ++row) {
        const int t = row % TT;
#pragma unroll
        for (int j = 0; j < 4; ++j) hn[j] = (f32x4){0.f, 0.f, 0.f, 0.f};
        if (row + 1 < NT) p1_h(a, row + 1, lane, cmr, mgg, mhh, hn);
        const float lv = (t != 0 && t != TC) ? 0.5f : 0.f, rv = (t != TC - 1 && t != TT - 1) ? 0.5f : 0.f;
        f32x4 dx[4];
#pragma unroll
        for (int j = 0; j < 4; ++j) dx[j] = hp[j] * lv + hn[j] * rv - hc[j];
#pragma unroll
        for (int m = 0; m < 6; ++m) {
            f32x4 mx[4];
#pragma unroll
            for (int j = 0; j < 4; ++j) mx[j] = hc[j] + dx[j] * mu[m][j];
            store_row_bf16(slotp(a, m) + (size_t)row * D, lane, mx);
        }
#pragma unroll
        for (int j = 0; j < 4; ++j) { hp[j] = hc[j]; hc[j] = hn[j]; }
    }
}

__device__ __forceinline__ void load16(const bf16* p, float (&f)[16]) {
    const v4u a = *(const GAS v4u*)p, b = *(const GAS v4u*)(p + 8);
    f[0] = bflo(a.x); f[1] = bfhi(a.x); f[2] = bflo(a.y); f[3] = bfhi(a.y); f[4] = bflo(a.z); f[5] = bfhi(a.z); f[6] = bflo(a.w); f[7] = bfhi(a.w);
    f[8] = bflo(b.x); f[9] = bfhi(b.x); f[10] = bflo(b.y); f[11] = bfhi(b.y); f[12] = bflo(b.z); f[13] = bfhi(b.z); f[14] = bflo(b.w); f[15] = bfhi(b.w);
}
__device__ __forceinline__ void store16(bf16* p, const float (&f)[16]) {
    v4u a, b; a.x = pk2(f[0], f[1]); a.y = pk2(f[2], f[3]); a.z = pk2(f[4], f[5]); a.w = pk2(f[6], f[7]);
    b.x = pk2(f[8], f[9]); b.y = pk2(f[10], f[11]); b.z = pk2(f[12], f[13]); b.w = pk2(f[14], f[15]);
    *(GAS v4u*)p = a; *(GAS v4u*)(p + 8) = b;
}
__device__ __forceinline__ void p3b_invn_bonus(const Args& a, int lane, int wave, int bid, int G) {
    const bf16 *R = slotp(a, 2), *K = slotp(a, 3), *A0 = slotp(a, 0), *A1 = slotp(a, 1);
    float* BON = (float*)(a.ws + WS_BON); float* INVN = (float*)(a.ws + WS_INVN);
    float kkc[16], kac[16], rkc[16];
#pragma unroll
    for (int e = 0; e < 16; ++e) { kkc[e] = a.in[I_KK][16 * lane + e]; kac[e] = a.in[I_KA][16 * lane + e]; rkc[e] = a.in[I_RK][16 * lane + e]; }
    const int NGW = G * NWAVES;
    for (int row = bid * NWAVES + wave; row < NT; row += NGW) {
        const size_t o = (size_t)row * D + 16 * lane;
        float r[16], k[16], a0[16], a1[16];
        load16(R + o, r); load16(K + o, k); load16(A0 + o, a0); load16(A1 + o, a1);
        float ss = 0.f, bn = 0.f;
#pragma unroll
        for (int e = 0; e < 16; ++e) { const float kf = k[e] * kkc[e]; ss += kf * kf;
            bn += r[e] * rkc[e] * k[e] * ((1.f + (a0[e] - 1.f) * kac[e]) + (1.f + (a1[e] - 1.f) * kac[e])); }
        ss = quad_sum(ss); bn = quad_sum(bn);
        if ((lane & 3) == 0) { INVN[row * 16 + (lane >> 2)] = rsqrtf(ss + 1e-12f); BON[row * 16 + (lane >> 2)] = bn; }
    }
}
__device__ __forceinline__ int scan_row(int z, int b, int sg) { const int t = (z == 0) ? sg : (sg < TC ? TC - 1 - sg : TT + TC - 1 - sg); return b * TT + t; }
__device__ __forceinline__ float afma(float a, float b, float c) { float d; asm("v_fma_f32 %0, %1, %2, %3" : "=v"(d) : "v"(a), "v"(b), "v"(c)); return d; }
__device__ __forceinline__ float amul(float a, float b) { float d; asm("v_mul_f32 %0, %1, %2" : "=v"(d) : "v"(a), "v"(b)); return d; }
#define ROWSUM4_STAGE(N) asm volatile("s_nop 1\n\tv_add_f32_dpp %0, %0, %0 row_ror:" #N " row_mask:0xf bank_mask:0xf\n\tv_add_f32_dpp %1, %1, %1 row_ror:" #N " row_mask:0xf bank_mask:0xf\n\t" \
    "v_add_f32_dpp %2, %2, %2 row_ror:" #N " row_mask:0xf bank_mask:0xf\n\tv_add_f32_dpp %3, %3, %3 row_ror:" #N " row_mask:0xf bank_mask:0xf" : "+v"(a), "+v"(b), "+v"(c), "+v"(d))
__device__ __forceinline__ void row_sum16x4(float& a, float& b, float& c, float& d) { ROWSUM4_STAGE(8); ROWSUM4_STAGE(4); ROWSUM4_STAGE(2); ROWSUM4_STAGE(1); }
template <int N> __device__ __forceinline__ float row_ror(float v) { return __builtin_bit_cast(float, __builtin_amdgcn_update_dpp(0, __builtin_bit_cast(int, v), 0x120 + N, 0xf, 0xf, false)); }
__device__ __forceinline__ float row_sum16(float v) { v += row_ror<8>(v); v += row_ror<4>(v); v += row_ror<2>(v); v += row_ror<1>(v); return v; }
__device__ __forceinline__ void p4_scan(const Args& a, LAS unsigned char* lds, int tid, int lane, int wave, int bid, int G) {
    const bf16 *R = slotp(a, 2), *K = slotp(a, 3), *V = slotp(a, 4);
    const float* INVN = (const float*)(a.ws + WS_INVN);
    constexpr int NCH = TT / 16;
    const int sc = tid >> 8, ss = (tid >> 4) & 15, g4 = tid & 15;
    const int wc = wave >> 2, wq = wave & 3, ig = lane >> 4, jg = lane & 15;
    for (int pair = bid; pair < 256; pair += G) {
        const int cid = pair * 2 + sc, z = cid >> 8, b = (cid >> 4) & 15, h = cid & 15;
        const bf16* Az = slotp(a, z); bf16* DDz = slotp(a, 5 + z);
        const int col0 = h * 64 + 4 * g4;
        const f32x4 kkc = *(const GAS f32x4*)(a.in[I_KK] + col0), kac = *(const GAS f32x4*)(a.in[I_KA] + col0);
        float T[4][4];
#pragma unroll
        for (int jj = 0; jj < 4; ++jj)
#pragma unroll
            for (int ii = 0; ii < 4; ++ii) T[jj][ii] = 0.f;
        v2u gr, gk, gv, ga, gd; float ginv;
        { const int row = scan_row(z, b, ss); const size_t o = (size_t)row * D + col0;
          gr = *(const GAS v2u*)(R + o); gk = *(const GAS v2u*)(K + o); gv = *(const GAS v2u*)(V + o); ga = *(const GAS v2u*)(Az + o); gd = *(const GAS v2u*)(DDz + o); ginv = INVN[row * 16 + h]; }
        __syncthreads();
        for (int n = -1; n < NCH; ++n) {
            if (n + 1 < NCH) {
                const float k0 = bflo(gk.x), k1 = bfhi(gk.x), k2 = bflo(gk.y), k3 = bfhi(gk.y), a0 = bflo(ga.x), a1 = bfhi(ga.x), a2 = bflo(ga.y), a3 = bfhi(ga.y);
                const float q0 = k0 * kkc.x * ginv, q1 = k1 * kkc.y * ginv, q2 = k2 * kkc.z * ginv, q3 = k3 * kkc.w * ginv;
                LAS float* p = (LAS float*)(lds + ((n + 1) & 1) * 49152 + sc * 24576 + ss * 1536) + 4 * g4;
                *(LAS f32x4*)(p)       = (f32x4){-q0, -q1, -q2, -q3};
                *(LAS f32x4*)(p + 64)  = (f32x4){1.f - bflo(gd.x), 1.f - bfhi(gd.x), 1.f - bflo(gd.y), 1.f - bfhi(gd.y)};
                *(LAS f32x4*)(p + 128) = (f32x4){q0 * a0, q1 * a1, q2 * a2, q3 * a3};
                *(LAS f32x4*)(p + 192) = (f32x4){k0 * (1.f + (a0 - 1.f) * kac.x), k1 * (1.f + (a1 - 1.f) * kac.y), k2 * (1.f + (a2 - 1.f) * kac.z), k3 * (1.f + (a3 - 1.f) * kac.w)};
                *(LAS f32x4*)(p + 256) = (f32x4){bflo(gr.x), bfhi(gr.x), bflo(gr.y), bfhi(gr.y)};
                *(LAS f32x4*)(p + 320) = (f32x4){bflo(gv.x), bfhi(gv.x), bflo(gv.y), bfhi(gv.y)};
            }
            if (n >= 1) {
                const f32x4 y4 = *(const LAS f32x4*)((const LAS float*)(lds + 98304 + ((n - 1) & 1) * 8192 + sc * 4096) + ss * 64 + 4 * g4);
                v2u o; o.x = pk2(y4.x, y4.y); o.y = pk2(y4.z, y4.w);
                *(GAS v2u*)(DDz + (size_t)scan_row(z, b, (n - 1) * 16 + ss) * D + col0) = o;
            }
            __syncthreads();
            if (n + 2 < NCH) { const int row = scan_row(z, b, (n + 2) * 16 + ss); const size_t o = (size_t)row * D + col0;
                gr = *(const GAS v2u*)(R + o); gk = *(const GAS v2u*)(K + o); gv = *(const GAS v2u*)(V + o); ga = *(const GAS v2u*)(Az + o); gd = *(const GAS v2u*)(DDz + o); ginv = INVN[row * 16 + h]; }
            const int m = n + 1;
            if (m < NCH) {
                const LAS float* cb = (const LAS float*)(lds + (m & 1) * 49152 + wc * 24576);
                LAS float* yb = (LAS float*)(lds + 98304 + (m & 1) * 8192 + wc * 4096);
                f32x4 nk = *(const LAS f32x4*)(cb + 4 * jg), w4 = *(const LAS f32x4*)(cb + 64 + 4 * jg), ka = *(const LAS f32x4*)(cb + 128 + 4 * jg),
                      kd = *(const LAS f32x4*)(cb + 192 + 4 * jg), r4 = *(const LAS f32x4*)(cb + 256 + 4 * jg), v4 = *(const LAS f32x4*)(cb + 320 + 16 * wq + 4 * ig);
#pragma unroll 2
                for (int s = 0; s < 16; ++s) {
                    const LAS float* pn = cb + ((s + 1) & 15) * 384;
                    const f32x4 nk_n = *(const LAS f32x4*)(pn + 4 * jg), w4_n = *(const LAS f32x4*)(pn + 64 + 4 * jg), ka_n = *(const LAS f32x4*)(pn + 128 + 4 * jg),
                                kd_n = *(const LAS f32x4*)(pn + 192 + 4 * jg), r4_n = *(const LAS f32x4*)(pn + 256 + 4 * jg), v4_n = *(const LAS f32x4*)(pn + 320 + 16 * wq + 4 * ig);
                    float sa0 = afma(T[3][0], nk.w, afma(T[2][0], nk.z, afma(T[1][0], nk.y, amul(T[0][0], nk.x))));
                    float sa1 = afma(T[3][1], nk.w, afma(T[2][1], nk.z, afma(T[1][1], nk.y, amul(T[0][1], nk.x))));
                    float sa2 = afma(T[3][2], nk.w, afma(T[2][2], nk.z, afma(T[1][2], nk.y, amul(T[0][2], nk.x))));
                    float sa3 = afma(T[3][3], nk.w, afma(T[2][3], nk.z, afma(T[1][3], nk.y, amul(T[0][3], nk.x))));
                    row_sum16x4(sa0, sa1, sa2, sa3);
                    const float sa[4] = {sa0, sa1, sa2, sa3};
#pragma unroll
                    for (int ii = 0; ii < 4; ++ii) {
                        T[0][ii] = afma(v4[ii], kd.x, afma(sa[ii], ka.x, amul(T[0][ii], w4.x))); T[1][ii] = afma(v4[ii], kd.y, afma(sa[ii], ka.y, amul(T[1][ii], w4.y)));
                        T[2][ii] = afma(v4[ii], kd.z, afma(sa[ii], ka.z, amul(T[2][ii], w4.z))); T[3][ii] = afma(v4[ii], kd.w, afma(sa[ii], ka.w, amul(T[3][ii], w4.w))); }
                    float y0 = afma(T[3][0], r4.w, afma(T[2][0], r4.z, afma(T[1][0], r4.y, amul(T[0][0], r4.x))));
                    float y1 = afma(T[3][1], r4.w, afma(T[2][1], r4.z, afma(T[1][1], r4.y, amul(T[0][1], r4.x))));
                    float y2 = afma(T[3][2], r4.w, afma(T[2][2], r4.z, afma(T[1][2], r4.y, amul(T[0][2], r4.x))));
                    float y3 = afma(T[3][3], r4.w, afma(T[2][3], r4.z, afma(T[1][3], r4.y, amul(T[0][3], r4.x))));
                    row_sum16x4(y0, y1, y2, y3);
                    if (jg == 0) *(LAS f32x4*)(yb + s * 64 + 16 * wq + 4 * ig) = (f32x4){y0, y1, y2, y3};
                    nk = nk_n; w4 = w4_n; ka = ka_n; kd = kd_n; r4 = r4_n; v4 = v4_n;
                }
            }
        }
        __syncthreads();
        {
            const f32x4 y4 = *(const LAS f32x4*)((const LAS float*)(lds + 98304 + ((NCH - 1) & 1) * 8192 + sc * 4096) + ss * 64 + 4 * g4);
            v2u o; o.x = pk2(y4.x, y4.y); o.y = pk2(y4.z, y4.w);
            *(GAS v2u*)(DDz + (size_t)scan_row(z, b, (NCH - 1) * 16 + ss) * D + col0) = o;
        }
    }
}
typedef short s16x8c __attribute__((ext_vector_type(8)));
__device__ __forceinline__ f32x4 mfma16(v4u a, v4u b, f32x4 c) { return __builtin_amdgcn_mfma_f32_16x16x32_bf16(__builtin_bit_cast(s16x8c, a), __builtin_bit_cast(s16x8c, b), c, 0, 0, 0); }
__device__ __forceinline__ void blocksolve4(f32x4& x, const f32x4& n1, const f32x4& n2, const f32x4& n3) {
    x.y += n1.x * x.x; x.z += n2.x * x.x + n2.y * x.y; x.w += n3.x * x.x + n3.y * x.y + n3.z * x.z; }
template <int N> __device__ __forceinline__ float row_shr1(float v) {
    return __builtin_bit_cast(float, __builtin_amdgcn_update_dpp(0x3f800000, __builtin_bit_cast(int, v), 0x110 + N, 0xf, 0xf, false)); }
__device__ __forceinline__ void p4_scan_chunked(const Args& a, LAS unsigned char* lds, int tid, int lane, int wave, int bid, int G) {
    const bf16 *R = slotp(a, 2), *K = slotp(a, 3), *V = slotp(a, 4);
    constexpr int NCH = TT / 16, RP = 68, RARR = 16 * RP;
    constexpr int O_RAW = 0, O_VT = 5 * RARR * 4, O_VEC = O_VT + 4096, O_BKT = O_VEC + 9216, O_GC = O_BKT + 4096, O_YB = O_GC + 256, O_WS = O_YB + 4096, WS_B = 5120, O_WL = O_WS + 4 * WS_B, O_AL = O_WL + RARR * 4, CHAIN_B = O_AL + RARR * 4;
    static_assert(2 * CHAIN_B <= RW_BYTES, "scan LDS");
    const int sc = tid >> 8, ss = (tid >> 4) & 15, g4 = tid & 15;
    const int wc = wave >> 2, wq = wave & 3, fr = lane & 15, g = lane >> 4;
    LAS unsigned char* cs = lds + sc * CHAIN_B;
    LAS unsigned char* cw = lds + wc * CHAIN_B;
    LAS unsigned char* ws = cw + O_WS + wq * WS_B;
    for (int pair = bid; pair < 256; pair += G) {
        const int cid = pair * 2 + sc, z = cid >> 8, b = (cid >> 4) & 15, h = cid & 15;
        bf16* Yz = slotp(a, z);
        const bf16* L1b = (const bf16*)(a.ws + WS_L1) + z * 64 + 8 * g;
        const bf16* L2A = (const bf16*)(a.ws + WS_L2A);
        const int lc = h * 64 + 16 * wq + fr;
        const v4u bw0 = *(const GAS v4u*)(L2A + (size_t)(z * 1024 + lc) * 256 + z * 64 + 8 * g), bw1 = *(const GAS v4u*)(L2A + (size_t)(z * 1024 + lc) * 256 + z * 64 + 32 + 8 * g),
                  ba0 = *(const GAS v4u*)(L2A + (size_t)(2048 + z * 1024 + lc) * 256 + 128 + z * 64 + 8 * g), ba1 = *(const GAS v4u*)(L2A + (size_t)(2048 + z * 1024 + lc) * 256 + 128 + z * 64 + 32 + 8 * g);
        const float w0c = a.in[I_W0][z * 1024 + lc], a0c = a.in[I_A0][z * 1024 + lc];
        const int col0 = h * 64 + 4 * g4;
        const f32x4 kkc = *(const GAS f32x4*)(a.in[I_KK] + col0), kac = *(const GAS f32x4*)(a.in[I_KA] + col0), rkc = *(const GAS f32x4*)(a.in[I_RK] + col0);
        float* BONz = (float*)(a.ws + (z ? WS_INVN : WS_BON));
        f32x4 T[4];
#pragma unroll
        for (int jb = 0; jb < 4; ++jb) T[jb] = (f32x4){0.f, 0.f, 0.f, 0.f};
        v2u gr, gk, gv; int grow; v4u lw0, lw1, la0, la1;
#define SCAN_LOAD(chunk) do { const int row_ = scan_row(z, b, (chunk) * 16 + ss); const size_t o_ = (size_t)row_ * D + col0; \
        gr = *(const GAS v2u*)(R + o_); gk = *(const GAS v2u*)(K + o_); gv = *(const GAS v2u*)(V + o_); grow = row_; } while (0)
#define SCAN_LOAD_L1(chunk) do { const bf16* l1_ = L1b + (size_t)scan_row(z, b, (chunk) * 16 + fr) * 512; lw0 = *(const GAS v4u*)l1_; lw1 = *(const GAS v4u*)(l1_ + 32); la0 = *(const GAS v4u*)(l1_ + 128); la1 = *(const GAS v4u*)(l1_ + 160); } while (0)
#define SCAN_LORA() do { const f32x4 z4_ = (f32x4){0.f, 0.f, 0.f, 0.f}; const f32x4 cw_ = mfma16(lw1, bw1, mfma16(lw0, bw0, z4_)), ca_ = mfma16(la1, ba1, mfma16(la0, ba0, z4_)); \
        LAS float* wl_ = (LAS float*)(cw + O_WL) + (4 * g) * RP + 16 * wq + fr; LAS float* al_ = (LAS float*)(cw + O_AL) + (4 * g) * RP + 16 * wq + fr; \
        _Pragma("unroll") for (int e_ = 0; e_ < 4; ++e_) { wl_[e_ * RP] = fexp(-0.6065306597f * fsigmoid(w0c + cw_[e_])); al_[e_ * RP] = fsigmoid(a0c + ca_[e_]); } } while (0)
#define SCAN_CONVERT(chunk) do { const float k0 = bflo(gk.x), k1 = bfhi(gk.x), k2 = bflo(gk.y), k3 = bfhi(gk.y); \
        const f32x4 av_ = *(const LAS f32x4*)((const LAS float*)(cs + O_AL) + ss * RP + 4 * g4), wv_ = *(const LAS f32x4*)((const LAS float*)(cs + O_WL) + ss * RP + 4 * g4); \
        const float a0 = av_.x, a1 = av_.y, a2 = av_.z, a3 = av_.w; \
        const float u0_ = k0 * kkc.x, u1_ = k1 * kkc.y, u2_ = k2 * kkc.z, u3_ = k3 * kkc.w; \
        const float d0_ = k0 * (1.f + (a0 - 1.f) * kac.x), d1_ = k1 * (1.f + (a1 - 1.f) * kac.y), d2_ = k2 * (1.f + (a2 - 1.f) * kac.z), d3_ = k3 * (1.f + (a3 - 1.f) * kac.w); \
        const float ssq_ = row_sum16((u0_ * u0_ + u1_ * u1_) + (u2_ * u2_ + u3_ * u3_)); \
        const float bon_ = row_sum16((bflo(gr.x) * d0_ * rkc.x + bfhi(gr.x) * d1_ * rkc.y) + (bflo(gr.y) * d2_ * rkc.z + bfhi(gr.y) * d3_ * rkc.w)); \
        const float ginv = rsqrtf(ssq_ + 1e-12f); \
        if (g4 == 0) BONz[grow * 16 + h] = bon_; \
        const float q0 = u0_ * ginv, q1 = u1_ * ginv, q2 = u2_ * ginv, q3 = u3_ * ginv; \
        LAS float* p_ = (LAS float*)(cs + O_RAW) + ss * RP + 4 * g4; \
        *(LAS f32x4*)(p_)            = wv_; \
        *(LAS f32x4*)(p_ + RARR)     = (f32x4){-q0, -q1, -q2, -q3}; \
        *(LAS f32x4*)(p_ + 2 * RARR) = (f32x4){q0 * a0, q1 * a1, q2 * a2, q3 * a3}; \
        *(LAS f32x4*)(p_ + 3 * RARR) = (f32x4){d0_, d1_, d2_, d3_}; \
        *(LAS f32x4*)(p_ + 4 * RARR) = (f32x4){bflo(gr.x), bfhi(gr.x), bflo(gr.y), bfhi(gr.y)}; \
        LAS unsigned short* vt_ = (LAS unsigned short*)(cs + O_VT + ((chunk) & 1) * 2048) + (4 * g4) * 16 + ss; \
        vt_[0] = (unsigned short)(gv.x & 0xffffu); vt_[16] = (unsigned short)(gv.x >> 16); vt_[32] = (unsigned short)(gv.y & 0xffffu); vt_[48] = (unsigned short)(gv.y >> 16); } while (0)
        SCAN_LOAD(0); SCAN_LOAD_L1(0);
        __syncthreads();
        for (int i = lane; i < WS_B / 16; i += 64) *(LAS v4u*)(ws + i * 16) = (v4u){0u, 0u, 0u, 0u};
        SCAN_LORA();
        SCAN_LOAD_L1(1);
        __syncthreads();
        SCAN_CONVERT(0);
        SCAN_LOAD(1);
        __syncthreads();
        for (int n = 0; n < NCH; ++n) {
            {
                const int j0 = 16 * wq + 4 * g;
                const LAS float* rw = (const LAS float*)(cw + O_RAW) + fr * RP + j0;
                const f32x4 w = *(const LAS f32x4*)rw, ap = *(const LAS f32x4*)(rw + RARR), bb = *(const LAS f32x4*)(rw + 2 * RARR), kd = *(const LAS f32x4*)(rw + 3 * RARR), rr = *(const LAS f32x4*)(rw + 4 * RARR);
                f32x4 gm = w;
#pragma unroll
                for (int c = 0; c < 4; ++c) { gm[c] *= row_shr1<1>(gm[c]); }
#pragma unroll
                for (int c = 0; c < 4; ++c) { gm[c] *= row_shr1<2>(gm[c]); }
#pragma unroll
                for (int c = 0; c < 4; ++c) { gm[c] *= row_shr1<4>(gm[c]); }
#pragma unroll
                for (int c = 0; c < 4; ++c) { gm[c] *= row_shr1<8>(gm[c]); }
                f32x4 gp;
#pragma unroll
                for (int c = 0; c < 4; ++c) gp[c] = row_shr1<1>(gm[c]);
                const f32x4 ig = (f32x4){frcp(gm.x), frcp(gm.y), frcp(gm.z), frcp(gm.w)};
                const f32x4 at = gp * ap, bt = bb * ig, kt = kd * ig, rt = gm * rr;
                const int pos0 = 32 * (wq >> 1) + 8 * g + 4 * (wq & 1);
                LAS unsigned char* vv = cw + O_VEC + fr * 144 + pos0 * 2;
                const v2u hb = (v2u){pk2(bt.x, bt.y), pk2(bt.z, bt.w)}, hk = (v2u){pk2(kt.x, kt.y), pk2(kt.z, kt.w)};
                *(LAS v2u*)(vv) = (v2u){pk2(at.x, at.y), pk2(at.z, at.w)}; *(LAS v2u*)(vv + 2304) = hb; *(LAS v2u*)(vv + 4608) = hk; *(LAS v2u*)(vv + 6912) = (v2u){pk2(rt.x, rt.y), pk2(rt.z, rt.w)};
                LAS unsigned short* bk = (LAS unsigned short*)(cw + O_BKT) + j0 * 32 + (fr >> 2) * 8 + (fr & 3);
                bk[0] = (unsigned short)(hb.x & 0xffffu); bk[32] = (unsigned short)(hb.x >> 16); bk[64] = (unsigned short)(hb.y & 0xffffu); bk[96] = (unsigned short)(hb.y >> 16);
                bk[4] = (unsigned short)(hk.x & 0xffffu); bk[36] = (unsigned short)(hk.x >> 16); bk[68] = (unsigned short)(hk.y & 0xffffu); bk[100] = (unsigned short)(hk.y >> 16);
                if (fr == 15) *(LAS f32x4*)((LAS float*)(cw + O_GC) + j0) = gm;
            }
            if (n >= 1) {
                const f32x4 y4 = *(const LAS f32x4*)((const LAS float*)(cs + O_YB) + ss * 64 + 4 * g4);
                v2u o; o.x = pk2(y4.x, y4.y); o.y = pk2(y4.z, y4.w);
                *(GAS v2u*)(Yz + (size_t)scan_row(z, b, (n - 1) * 16 + ss) * D + col0) = o;
            }
            if (n + 1 < NCH) SCAN_LORA();
            __syncthreads();
            if (n + 2 < NCH) SCAN_LOAD_L1(n + 2);
            {
                const LAS unsigned char* vec = cw + O_VEC + fr * 144 + g * 16;
                const v4u xa0 = *(const LAS v4u*)(vec), xa1 = *(const LAS v4u*)(vec + 64), xb0 = *(const LAS v4u*)(vec + 2304), xb1 = *(const LAS v4u*)(vec + 2304 + 64),
                          xk0 = *(const LAS v4u*)(vec + 4608), xk1 = *(const LAS v4u*)(vec + 4608 + 64), xr0 = *(const LAS v4u*)(vec + 6912), xr1 = *(const LAS v4u*)(vec + 6912 + 64);
                const f32x4 zero4 = (f32x4){0.f, 0.f, 0.f, 0.f};
                f32x4 nab = mfma16(xb1, xa1, mfma16(xb0, xa0, zero4)), nak = mfma16(xk1, xa1, mfma16(xk0, xa0, zero4));
                f32x4 mbr = mfma16(xb1, xr1, mfma16(xb0, xr0, zero4)), mkr = mfma16(xk1, xr1, mfma16(xk0, xr0, zero4));
#pragma unroll
                for (int e = 0; e < 4; ++e) { const int r = 4 * g + e; if (!(r < fr)) { nab[e] = 0.f; nak[e] = 0.f; } if (!(r <= fr)) { mbr[e] = 0.f; mkr[e] = 0.f; } }
                *(LAS f32x4*)(ws + (fr * 16 + 4 * g) * 4) = nab;
                { const bool off = (g != (fr >> 2)); v4u o; o.x = off ? pk2(nab.x, nab.y) : 0u; o.y = off ? pk2(nab.z, nab.w) : 0u; o.z = 0u; o.w = 0u; *(LAS v4u*)(ws + 1024 + (fr * 4 + g) * 16) = o; }
                { v4u o; o.x = pk2(nak.x, nak.y); o.y = pk2(nak.z, nak.w); o.z = 0u; o.w = 0u; *(LAS v4u*)(ws + 2048 + (fr * 4 + g) * 16) = o; }
                { v4u o; o.x = pk2(mbr.x, mbr.y); o.y = pk2(mbr.z, mbr.w); o.z = pk2(mkr.x, mkr.y); o.w = pk2(mkr.z, mkr.w); *(LAS v4u*)(ws + 4096 + (fr * 4 + g) * 16) = o; }
                LDS_WAIT(); asm volatile("" ::: "memory");
                const f32x4 n1 = *(const LAS f32x4*)(ws + ((4 * g + 1) * 16 + 4 * g) * 4), n2 = *(const LAS f32x4*)(ws + ((4 * g + 2) * 16 + 4 * g) * 4), n3 = *(const LAS f32x4*)(ws + ((4 * g + 3) * 16 + 4 * g) * 4);
                const v4u noff = *(const LAS v4u*)(ws + 1024 + (fr * 4 + g) * 16);
                const f32x4 eye = (f32x4){(4 * g == fr) ? 1.f : 0.f, (4 * g + 1 == fr) ? 1.f : 0.f, (4 * g + 2 == fr) ? 1.f : 0.f, (4 * g + 3 == fr) ? 1.f : 0.f};
                f32x4 L = eye; blocksolve4(L, n1, n2, n3);
#pragma unroll
                for (int it = 0; it < 3; ++it) { v4u lb; lb.x = pk2(L.x, L.y); lb.y = pk2(L.z, L.w); lb.z = 0u; lb.w = 0u; L = mfma16(noff, lb, eye); blocksolve4(L, n1, n2, n3); }
                { LAS unsigned short* lu = (LAS unsigned short*)(ws + 3072) + (fr >> 2) * 8 + (fr & 3);
                  lu[(4 * g) * 32] = (unsigned short)f2bf(L.x); lu[(4 * g + 1) * 32] = (unsigned short)f2bf(L.y); lu[(4 * g + 2) * 32] = (unsigned short)f2bf(L.z); lu[(4 * g + 3) * 32] = (unsigned short)f2bf(L.w); }
                LDS_WAIT(); asm volatile("" ::: "memory");
                v4u tb0, tb1; tb0.x = pk2(T[0].x, T[0].y); tb0.y = pk2(T[0].z, T[0].w); tb0.z = pk2(T[1].x, T[1].y); tb0.w = pk2(T[1].z, T[1].w);
                tb1.x = pk2(T[2].x, T[2].y); tb1.y = pk2(T[2].z, T[2].w); tb1.z = pk2(T[3].x, T[3].y); tb1.w = pk2(T[3].z, T[3].w);
                const f32x4 Wa = mfma16(xa1, tb1, mfma16(xa0, tb0, zero4)), Wr = mfma16(xr1, tb1, mfma16(xr0, tb0, zero4));
                const v2u vt = *(const LAS v2u*)(cw + O_VT + (n & 1) * 2048 + (16 * wq + fr) * 32 + g * 8);
                v4u vb; vb.x = vt.x; vb.y = vt.y; vb.z = 0u; vb.w = 0u;
                const v4u ng = *(const LAS v4u*)(ws + 2048 + (fr * 4 + g) * 16), lu4 = *(const LAS v4u*)(ws + 3072 + (fr * 4 + g) * 16), my = *(const LAS v4u*)(ws + 4096 + (fr * 4 + g) * 16);
                const f32x4 Gm = mfma16(ng, vb, Wa);
                v4u gb; gb.x = pk2(Gm.x, Gm.y); gb.y = pk2(Gm.z, Gm.w); gb.z = 0u; gb.w = 0u;
                const f32x4 U = mfma16(lu4, gb, zero4);
                v4u bop; bop.x = pk2(U.x, U.y); bop.y = pk2(U.z, U.w); bop.z = vt.x; bop.w = vt.y;
                const f32x4 Y = mfma16(my, bop, Wr);
                { LAS float* yb = (LAS float*)(cw + O_YB) + (4 * g) * 64 + 16 * wq + fr; yb[0] = Y.x; yb[64] = Y.y; yb[128] = Y.z; yb[192] = Y.w; }
#pragma unroll
                for (int jb = 0; jb < 4; ++jb) { const v4u bkt = *(const LAS v4u*)(cw + O_BKT + ((16 * jb + fr) * 4 + g) * 16);
                    const f32x4 gc = *(const LAS f32x4*)((const LAS float*)(cw + O_GC) + 16 * jb + 4 * g);
                    T[jb] = mfma16(bkt, bop, T[jb]) * gc; }
            }
            if (n + 1 < NCH) { SCAN_CONVERT(n + 1); if (n + 2 < NCH) SCAN_LOAD(n + 2); }
            __syncthreads();
        }
#undef SCAN_LOAD
#undef SCAN_LOAD_L1
#undef SCAN_CONVERT
#undef SCAN_LORA
        {
            const f32x4 y4 = *(const LAS f32x4*)((const LAS float*)(cs + O_YB) + ss * 64 + 4 * g4);
            v2u o; o.x = pk2(y4.x, y4.y); o.y = pk2(y4.z, y4.w);
            *(GAS v2u*)(Yz + (size_t)scan_row(z, b, (NCH - 1) * 16 + ss) * D + col0) = o;
        }
    }
}
__device__ __forceinline__ void p4_scan_v3(const Args& a, LAS unsigned char* lds, int tid, int lane, int wave, int bid, int G) {
    const bf16 *R = slotp(a, 3), *K = slotp(a, 4), *V = slotp(a, 5);
    constexpr int NCH = TT / 16;
    constexpr int O_VEC = 0, O_BKT = 9216, O_GC = 13312, O_VT = 13568, BUF_B = 15616, O_YB = 2 * BUF_B, O_WS = O_YB + 8192, WS_B = 5120 + 2176, CHAIN_B = O_WS + 4 * WS_B;
    static_assert(2 * CHAIN_B <= RW_BYTES, "scan LDS");
    const int sc = tid >> 8, ss = (tid >> 4) & 15, g4 = tid & 15;
    const int wq = wave & 3, fr = lane & 15, g = lane >> 4;
    LAS unsigned char* cw = lds + sc * CHAIN_B;
    LAS unsigned char* ws = cw + O_WS + wq * WS_B;
    for (int pair = bid; pair < 256; pair += G) {
        const int cid = pair * 2 + sc, z = cid >> 8, b = (cid >> 4) & 15, h = cid & 15;
        bf16* Yz = slotp(a, z);
        float* BONP = (float*)((unsigned char*)a.out + 72 * MiB) + (size_t)(z * 4 + wq) * NT * 16;
        const bf16* L1b = (const bf16*)(a.ws + WS_L1) + z * 64 + 8 * g;
        const bf16* L2A = (const bf16*)(a.ws + WS_L2A);
        const int lc = h * 64 + 16 * wq + fr;
        const v4u bw0 = *(const GAS v4u*)(L2A + (size_t)(z * 1024 + lc) * 256 + z * 64 + 8 * g), bw1 = *(const GAS v4u*)(L2A + (size_t)(z * 1024 + lc) * 256 + z * 64 + 32 + 8 * g),
                  ba0 = *(const GAS v4u*)(L2A + (size_t)(2048 + z * 1024 + lc) * 256 + 128 + z * 64 + 8 * g), ba1 = *(const GAS v4u*)(L2A + (size_t)(2048 + z * 1024 + lc) * 256 + 128 + z * 64 + 32 + 8 * g);
        const float w0c = a.in[I_W0][z * 1024 + lc], a0c = a.in[I_A0][z * 1024 + lc];
        const int j0 = 16 * wq + 4 * g, pcol = h * 64 + j0;
        const f32x4 kkc = *(const GAS f32x4*)(a.in[I_KK] + pcol), kac = *(const GAS f32x4*)(a.in[I_KA] + pcol), rkc = *(const GAS f32x4*)(a.in[I_RK] + pcol);
        f32x4 kkn[4];
#pragma unroll
        for (int c = 0; c < 4; ++c) kkn[c] = *(const GAS f32x4*)(a.in[I_KK] + h * 64 + 16 * g + 4 * c);
        const int pos0 = 32 * (wq >> 1) + 8 * g + 4 * (wq & 1);
        f32x4 T[4];
#pragma unroll
        for (int jb = 0; jb < 4; ++jb) T[jb] = (f32x4){0.f, 0.f, 0.f, 0.f};
        v2u gr, gk, gv; v4u kn0, kn1, lw0, lw1, la0, la1; int grow;
#define V3_LOAD(chunk) do { const int row_ = scan_row(z, b, (chunk) * 16 + fr); grow = row_; const size_t o_ = (size_t)row_ * D + pcol; \
        gr = *(const GAS v2u*)(R + o_); gk = *(const GAS v2u*)(K + o_); gv = *(const GAS v2u*)(V + o_); \
        kn0 = *(const GAS v4u*)(K + (size_t)row_ * D + h * 64 + 16 * g); kn1 = *(const GAS v4u*)(K + (size_t)row_ * D + h * 64 + 16 * g + 8); \
        const bf16* l1_ = L1b + (size_t)row_ * 512; lw0 = *(const GAS v4u*)l1_; lw1 = *(const GAS v4u*)(l1_ + 32); la0 = *(const GAS v4u*)(l1_ + 128); la1 = *(const GAS v4u*)(l1_ + 160); } while (0)
#define V3_PRODUCE(chunk) do { \
        const f32x4 z4_ = (f32x4){0.f, 0.f, 0.f, 0.f}; const f32x4 cw_ = mfma16(lw1, bw1, mfma16(lw0, bw0, z4_)), ca_ = mfma16(la1, ba1, mfma16(la0, ba0, z4_)); \
        LAS float* trw_ = (LAS float*)(ws + 5120); LAS float* tra_ = trw_ + 272; \
        _Pragma("unroll") for (int e_ = 0; e_ < 4; ++e_) { trw_[(4 * g + e_) * 17 + fr] = fexp(-0.6065306597f * fsigmoid(w0c + cw_[e_])); tra_[(4 * g + e_) * 17 + fr] = fsigmoid(a0c + ca_[e_]); } \
        float n8_[8]; float ssq_ = 0.f; \
        unpack8(kn0, n8_); ssq_ += (n8_[0] * kkn[0].x) * (n8_[0] * kkn[0].x) + (n8_[1] * kkn[0].y) * (n8_[1] * kkn[0].y) + (n8_[2] * kkn[0].z) * (n8_[2] * kkn[0].z) + (n8_[3] * kkn[0].w) * (n8_[3] * kkn[0].w) \
                                 + (n8_[4] * kkn[1].x) * (n8_[4] * kkn[1].x) + (n8_[5] * kkn[1].y) * (n8_[5] * kkn[1].y) + (n8_[6] * kkn[1].z) * (n8_[6] * kkn[1].z) + (n8_[7] * kkn[1].w) * (n8_[7] * kkn[1].w); \
        unpack8(kn1, n8_); ssq_ += (n8_[0] * kkn[2].x) * (n8_[0] * kkn[2].x) + (n8_[1] * kkn[2].y) * (n8_[1] * kkn[2].y) + (n8_[2] * kkn[2].z) * (n8_[2] * kkn[2].z) + (n8_[3] * kkn[2].w) * (n8_[3] * kkn[2].w) \
                                 + (n8_[4] * kkn[3].x) * (n8_[4] * kkn[3].x) + (n8_[5] * kkn[3].y) * (n8_[5] * kkn[3].y) + (n8_[6] * kkn[3].z) * (n8_[6] * kkn[3].z) + (n8_[7] * kkn[3].w) * (n8_[7] * kkn[3].w); \
        ssq_ += __shfl_xor(ssq_, 16); ssq_ += __shfl_xor(ssq_, 32); \
        const float inv_ = rsqrtf(ssq_ + 1e-12f); \
        LDS_WAIT(); asm volatile("" ::: "memory"); \
        const f32x4 w_ = (f32x4){trw_[fr * 17 + 4 * g], trw_[fr * 17 + 4 * g + 1], trw_[fr * 17 + 4 * g + 2], trw_[fr * 17 + 4 * g + 3]}; \
        const f32x4 a_ = (f32x4){tra_[fr * 17 + 4 * g], tra_[fr * 17 + 4 * g + 1], tra_[fr * 17 + 4 * g + 2], tra_[fr * 17 + 4 * g + 3]}; \
        const f32x4 k_ = (f32x4){bflo(gk.x), bfhi(gk.x), bflo(gk.y), bfhi(gk.y)}, r_ = (f32x4){bflo(gr.x), bfhi(gr.x), bflo(gr.y), bfhi(gr.y)}; \
        const f32x4 u_ = k_ * kkc * inv_; const f32x4 d_ = k_ * ((a_ - 1.f) * kac + 1.f); \
        float bon_ = (r_.x * d_.x * rkc.x + r_.y * d_.y * rkc.y) + (r_.z * d_.z * rkc.z + r_.w * d_.w * rkc.w); \
        bon_ += __shfl_xor(bon_, 16); bon_ += __shfl_xor(bon_, 32); \
        if (g == 0) BONP[grow * 16 + h] = bon_; \
        f32x4 gm_ = w_; \
        _Pragma("unroll") for (int c_ = 0; c_ < 4; ++c_) gm_[c_] *= row_shr1<1>(gm_[c_]); \
        _Pragma("unroll") for (int c_ = 0; c_ < 4; ++c_) gm_[c_] *= row_shr1<2>(gm_[c_]); \
        _Pragma("unroll") for (int c_ = 0; c_ < 4; ++c_) gm_[c_] *= row_shr1<4>(gm_[c_]); \
        _Pragma("unroll") for (int c_ = 0; c_ < 4; ++c_) gm_[c_] *= row_shr1<8>(gm_[c_]); \
        f32x4 gp_; _Pragma("unroll") for (int c_ = 0; c_ < 4; ++c_) gp_[c_] = row_shr1<1>(gm_[c_]); \
        const f32x4 ig_ = (f32x4){frcp(gm_.x), frcp(gm_.y), frcp(gm_.z), frcp(gm_.w)}; \
        const f32x4 at_ = gp_ * (-u_), bt_ = (u_ * a_) * ig_, kt_ = d_ * ig_, rt_ = gm_ * r_; \
        LAS unsigned char* bb_ = cw + ((chunk) & 1) * BUF_B; \
        LAS unsigned char* vv_ = bb_ + O_VEC + fr * 144 + pos0 * 2; \
        const v2u hb_ = (v2u){pk2hw(bt_.x, bt_.y), pk2hw(bt_.z, bt_.w)}, hk_ = (v2u){pk2hw(kt_.x, kt_.y), pk2hw(kt_.z, kt_.w)}; \
        *(LAS v2u*)(vv_) = (v2u){pk2hw(at_.x, at_.y), pk2hw(at_.z, at_.w)}; *(LAS v2u*)(vv_ + 2304) = hb_; *(LAS v2u*)(vv_ + 4608) = hk_; *(LAS v2u*)(vv_ + 6912) = (v2u){pk2hw(rt_.x, rt_.y), pk2hw(rt_.z, rt_.w)}; \
        LAS unsigned short* bk_ = (LAS unsigned short*)(bb_ + O_BKT) + j0 * 32 + (fr >> 2) * 8 + (fr & 3); \
        bk_[0] = (unsigned short)(hb_.x & 0xffffu); bk_[32] = (unsigned short)(hb_.x >> 16); bk_[64] = (unsigned short)(hb_.y & 0xffffu); bk_[96] = (unsigned short)(hb_.y >> 16); \
        bk_[4] = (unsigned short)(hk_.x & 0xffffu); bk_[36] = (unsigned short)(hk_.x >> 16); bk_[68] = (unsigned short)(hk_.y & 0xffffu); bk_[100] = (unsigned short)(hk_.y >> 16); \
        if (fr == 15) *(LAS f32x4*)((LAS float*)(bb_ + O_GC) + j0) = gm_; \
        LAS unsigned short* vt_ = (LAS unsigned short*)(bb_ + O_VT) + j0 * 16 + fr; \
        vt_[0] = (unsigned short)(gv.x & 0xffffu); vt_[16] = (unsigned short)(gv.x >> 16); vt_[32] = (unsigned short)(gv.y & 0xffffu); vt_[48] = (unsigned short)(gv.y >> 16); } while (0)
        V3_LOAD(0);
        __syncthreads();
        for (int i = lane; i < WS_B / 16; i += 64) *(LAS v4u*)(ws + i * 16) = (v4u){0u, 0u, 0u, 0u};
        V3_PRODUCE(0);
        V3_LOAD(1);
        __syncthreads();
        for (int n = 0; n < NCH; ++n) {
            if (n + 1 < NCH) { V3_PRODUCE(n + 1); if (n + 2 < NCH) V3_LOAD(n + 2); }
            {
                const LAS unsigned char* bb = cw + (n & 1) * BUF_B;
                const LAS unsigned char* vec = bb + O_VEC + fr * 144 + g * 16;
                const v4u xa0 = *(const LAS v4u*)(vec), xa1 = *(const LAS v4u*)(vec + 64), xb0 = *(const LAS v4u*)(vec + 2304), xb1 = *(const LAS v4u*)(vec + 2304 + 64),
                          xk0 = *(const LAS v4u*)(vec + 4608), xk1 = *(const LAS v4u*)(vec + 4608 + 64), xr0 = *(const LAS v4u*)(vec + 6912), xr1 = *(const LAS v4u*)(vec + 6912 + 64);
                const f32x4 zero4 = (f32x4){0.f, 0.f, 0.f, 0.f};
                f32x4 nab = mfma16(xb1, xa1, mfma16(xb0, xa0, zero4)), nak = mfma16(xk1, xa1, mfma16(xk0, xa0, zero4));
                f32x4 mbr = mfma16(xb1, xr1, mfma16(xb0, xr0, zero4)), mkr = mfma16(xk1, xr1, mfma16(xk0, xr0, zero4));
#pragma unroll
                for (int e = 0; e < 4; ++e) { const int r = 4 * g + e; if (!(r < fr)) { nab[e] = 0.f; nak[e] = 0.f; } if (!(r <= fr)) { mbr[e] = 0.f; mkr[e] = 0.f; } }
                *(LAS f32x4*)(ws + (fr * 16 + 4 * g) * 4) = nab;
                { const bool off = (g != (fr >> 2)); v4u o; o.x = off ? pk2hw(nab.x, nab.y) : 0u; o.y = off ? pk2hw(nab.z, nab.w) : 0u; o.z = 0u; o.w = 0u; *(LAS v4u*)(ws + 1024 + (fr * 4 + g) * 16) = o; }
                { v4u o; o.x = pk2hw(nak.x, nak.y); o.y = pk2hw(nak.z, nak.w); o.z = 0u; o.w = 0u; *(LAS v4u*)(ws + 2048 + (fr * 4 + g) * 16) = o; }
                { v4u o; o.x = pk2hw(mbr.x, mbr.y); o.y = pk2hw(mbr.z, mbr.w); o.z = pk2hw(mkr.x, mkr.y); o.w = pk2hw(mkr.z, mkr.w); *(LAS v4u*)(ws + 4096 + (fr * 4 + g) * 16) = o; }
                LDS_WAIT(); asm volatile("" ::: "memory");
                const f32x4 n1 = *(const LAS f32x4*)(ws + ((4 * g + 1) * 16 + 4 * g) * 4), n2 = *(const LAS f32x4*)(ws + ((4 * g + 2) * 16 + 4 * g) * 4), n3 = *(const LAS f32x4*)(ws + ((4 * g + 3) * 16 + 4 * g) * 4);
                const v4u noff = *(const LAS v4u*)(ws + 1024 + (fr * 4 + g) * 16);
                const f32x4 eye = (f32x4){(4 * g == fr) ? 1.f : 0.f, (4 * g + 1 == fr) ? 1.f : 0.f, (4 * g + 2 == fr) ? 1.f : 0.f, (4 * g + 3 == fr) ? 1.f : 0.f};
                f32x4 L = eye; blocksolve4(L, n1, n2, n3);
#pragma unroll
                for (int it = 0; it < 3; ++it) { v4u lb; lb.x = pk2hw(L.x, L.y); lb.y = pk2hw(L.z, L.w); lb.z = 0u; lb.w = 0u; L = mfma16(noff, lb, eye); blocksolve4(L, n1, n2, n3); }
                { LAS unsigned short* lu = (LAS unsigned short*)(ws + 3072) + (fr >> 2) * 8 + (fr & 3);
                  lu[(4 * g) * 32] = (unsigned short)f2bfhw(L.x); lu[(4 * g + 1) * 32] = (unsigned short)f2bfhw(L.y); lu[(4 * g + 2) * 32] = (unsigned short)f2bfhw(L.z); lu[(4 * g + 3) * 32] = (unsigned short)f2bfhw(L.w); }
                LDS_WAIT(); asm volatile("" ::: "memory");
                v4u tb0, tb1; tb0.x = pk2hw(T[0].x, T[0].y); tb0.y = pk2hw(T[0].z, T[0].w); tb0.z = pk2hw(T[1].x, T[1].y); tb0.w = pk2hw(T[1].z, T[1].w);
                tb1.x = pk2hw(T[2].x, T[2].y); tb1.y = pk2hw(T[2].z, T[2].w); tb1.z = pk2hw(T[3].x, T[3].y); tb1.w = pk2hw(T[3].z, T[3].w);
                const f32x4 Wa = mfma16(xa1, tb1, mfma16(xa0, tb0, zero4)), Wr = mfma16(xr1, tb1, mfma16(xr0, tb0, zero4));
                const v2u vt = *(const LAS v2u*)(bb + O_VT + (16 * wq + fr) * 32 + g * 8);
                v4u vb; vb.x = vt.x; vb.y = vt.y; vb.z = 0u; vb.w = 0u;
                const v4u ng = *(const LAS v4u*)(ws + 2048 + (fr * 4 + g) * 16), lu4 = *(const LAS v4u*)(ws + 3072 + (fr * 4 + g) * 16), my = *(const LAS v4u*)(ws + 4096 + (fr * 4 + g) * 16);
                const f32x4 Gm = mfma16(ng, vb, Wa);
                v4u gb; gb.x = pk2hw(Gm.x, Gm.y); gb.y = pk2hw(Gm.z, Gm.w); gb.z = 0u; gb.w = 0u;
                const f32x4 U = mfma16(lu4, gb, zero4);
                v4u bop; bop.x = pk2hw(U.x, U.y); bop.y = pk2hw(U.z, U.w); bop.z = vt.x; bop.w = vt.y;
                const f32x4 Y = mfma16(my, bop, Wr);
                { LAS float* yb = (LAS float*)(cw + O_YB + (n & 1) * 4096) + (4 * g) * 64 + 16 * wq + fr; yb[0] = Y.x; yb[64] = Y.y; yb[128] = Y.z; yb[192] = Y.w; }
#pragma unroll
                for (int jb = 0; jb < 4; ++jb) { const v4u bkt = *(const LAS v4u*)(bb + O_BKT + ((16 * jb + fr) * 4 + g) * 16);
                    const f32x4 gc = *(const LAS f32x4*)((const LAS float*)(bb + O_GC) + 16 * jb + 4 * g);
                    T[jb] = mfma16(bkt, bop, T[jb]) * gc; }
            }
            if (n >= 1) {
                const f32x4 y4 = *(const LAS f32x4*)((const LAS float*)(cw + O_YB + ((n - 1) & 1) * 4096) + ss * 64 + 4 * g4);
                v2u o; o.x = pk2hw(y4.x, y4.y); o.y = pk2hw(y4.z, y4.w);
                *(GAS v2u*)(Yz + (size_t)scan_row(z, b, (n - 1) * 16 + ss) * D + h * 64 + 4 * g4) = o;
            }
            __syncthreads();
        }
#undef V3_LOAD
#undef V3_PRODUCE
        {
            const f32x4 y4 = *(const LAS f32x4*)((const LAS float*)(cw + O_YB + ((NCH - 1) & 1) * 4096) + ss * 64 + 4 * g4);
            v2u o; o.x = pk2hw(y4.x, y4.y); o.y = pk2hw(y4.z, y4.w);
            *(GAS v2u*)(Yz + (size_t)scan_row(z, b, (NCH - 1) * 16 + ss) * D + h * 64 + 4 * g4) = o;
        }
    }
}
__device__ __forceinline__ void p5a_groupnorm(const Args& a, int lane, int wave, int bid, int G) {
#if MK_SCAN_CHUNKED
    const bf16 *Y0 = slotp(a, 0), *Y1 = slotp(a, 1), *V = slotp(a, 5); bf16* YN = slotp(a, 6);
#else
    const bf16 *Y0 = slotp(a, 5), *Y1 = slotp(a, 6), *V = slotp(a, 4); bf16* YN = slotp(a, 0);
#endif
    const float* BON = (const float*)(a.ws + WS_BON); const float* BON1 = (const float*)(a.ws + WS_INVN); const float* BONP8 = (const float*)((const unsigned char*)a.out + 72 * MiB);
    float lg[16], lb[16];
#pragma unroll
    for (int e = 0; e < 16; ++e) { lg[e] = a.in[I_LNG][16 * lane + e]; lb[e] = a.in[I_LNB][16 * lane + e]; }
    const int NGW = G * NWAVES;
    for (int row = bid * NWAVES + wave; row < NT; row += NGW) {
        const size_t o = (size_t)row * D + 16 * lane;
        float y[16], y1[16], v[16];
        load16(Y0 + o, y); load16(Y1 + o, y1); load16(V + o, v);
        float s = 0.f;
#pragma unroll
        for (int e = 0; e < 16; ++e) { y[e] += y1[e]; s += y[e]; }
        const float mean = quad_sum(s) * (1.f / 64.f); float q = 0.f;
#pragma unroll
        for (int e = 0; e < 16; ++e) { y[e] -= mean; q += y[e] * y[e]; }
        const float rstd = rsqrtf(quad_sum(q) * (1.f / 64.f) + 64e-5f);
#if MK_SCAN_CHUNKED == 2
        float bn = 0.f;
#pragma unroll
        for (int p = 0; p < 8; ++p) bn += BONP8[(size_t)p * NT * 16 + row * 16 + (lane >> 2)];
#else
        const float bn = BON[row * 16 + (lane >> 2)] + BON1[row * 16 + (lane >> 2)];
#endif
#pragma unroll
        for (int e = 0; e < 16; ++e) y[e] = y[e] * rstd * lg[e] + lb[e] + bn * v[e];
        store16(YN + o, y);
    }
}
template <int L> __device__ __forceinline__ void p_router(const Args& a, LAS unsigned char* lds, int tid, int lane, int wave, int bid, int G) {
    constexpr int nrows = (L == 0) ? NT : NLAT;
    LAS float* RW = (LAS float*)lds;
    LAS unsigned* lcnt = (LAS unsigned*)(lds + LDSCTL_OFF) + LC_LCNT;
    const float* rg = a.in[I_RG] + (size_t)L * D * 4; const float* re = a.in[I_RE] + (size_t)L * 4 * D * 8;
    { f32x4 wg[2], we[8][2];
#pragma unroll
      for (int i = 0; i < 2; ++i) wg[i] = *(const GAS f32x4*)(rg + (size_t)(tid + NTHR * i) * 4);
#pragma unroll
      for (int i = 0; i < 8; ++i) { const int idx = tid + NTHR * i, gq = idx >> 10, k = idx & 1023; const float* p = re + (size_t)gq * 8192 + k * 8; we[i][0] = *(const GAS f32x4*)p; we[i][1] = *(const GAS f32x4*)(p + 4); }
#pragma unroll
      for (int i = 0; i < 2; ++i) { const int k0 = tid + NTHR * i, k = ((((k0 & 511) >> 3) + 64 * (2 * (k0 >> 9) + ((k0 >> 2) & 1))) << 2) | (k0 & 3); RW[k] = wg[i].x; RW[1024 + k] = wg[i].y; RW[2048 + k] = wg[i].z; RW[3072 + k] = wg[i].w; }
#pragma unroll
      for (int i = 0; i < 8; ++i) { const int idx = tid + NTHR * i, gq = idx >> 10, k0 = idx & 1023, k = ((((k0 & 511) >> 3) + 64 * (2 * (k0 >> 9) + ((k0 >> 2) & 1))) << 2) | (k0 & 3); LAS float* d = RW + (4 + gq * 8) * 1024 + k;
          d[0] = we[i][0].x; d[1024] = we[i][0].y; d[2048] = we[i][0].z; d[3072] = we[i][0].w; d[4096] = we[i][1].x; d[5120] = we[i][1].y; d[6144] = we[i][1].z; d[7168] = we[i][1].w; } }
    if (tid < 32) lcnt[tid] = 0u;
    LAS float* rbias = (LAS float*)(lds + LDSCTL_OFF) + 216;
    if (tid >= 64 && tid < 100) rbias[tid - 64] = (tid < 68) ? a.in[I_RGB][L * 4 + (tid - 64)] : a.in[I_REB][L * 32 + (tid - 68)];
    for (int i = bid * NTHR + tid; i < MAXSLOT; i += G * NTHR) ((int*)(a.ws + WS_TOK))[i] = 0;
    __syncthreads();
    const bf16* X = slotp(a, 4); bf16* H2 = slotp(a, 6);
    unsigned* ROUTE = (unsigned*)(a.ws + WS_ROUTE);
    const int chunk = (nrows + G - 1) / G;
    f32x4 mgg[4], mhh[4]; int cmr = -1;
    for (int rr = 2 * wave; rr < chunk; rr += 2 * NWAVES) {
        const int lr0 = bid * chunk + rr; if (lr0 >= nrows) break;
        const bool ok1 = (rr + 1 < chunk) && (lr0 + 1 < nrows);
        int rowu[2]; rowu[0] = (L == 0) ? lr0 : lat_row(lr0); rowu[1] = ok1 ? ((L == 0) ? lr0 + 1 : lat_row(lr0 + 1)) : rowu[0];
        f32x4 hu[2][4]; float ss[2]; v2u xraw[2][4];
        ld_row_bf(X + (size_t)rowu[0] * D, lane, xraw[0]); ld_row_bf(X + (size_t)rowu[1] * D, lane, xraw[1]);
#pragma unroll
        for (int u = 0; u < 2; ++u) { ss[u] = 0.f;
#pragma unroll
            for (int j = 0; j < 4; ++j) { hu[u][j] = (f32x4){bflo(xraw[u][j].x), bfhi(xraw[u][j].x), bflo(xraw[u][j].y), bfhi(xraw[u][j].y)}; ss[u] += (hu[u][j].x * hu[u][j].x + hu[u][j].y * hu[u][j].y) + (hu[u][j].z * hu[u][j].z + hu[u][j].w * hu[u][j].w); } }
#pragma unroll
        for (int u = 0; u < 2; ++u) { const float rstd = rsqrtf(wave_sum(ss[u]) * (1.f / D) + 1e-6f); const int mr = mod_row(rowu[u]);
            if (mr != cmr) { cmr = mr;
                const float* g = a.in[I_N2G] + L * D; const float* sh = modp(a, L, mr, 3); const float* sc = modp(a, L, mr, 4);
#pragma unroll
                for (int j = 0; j < 4; ++j) { const int c = colb(lane, j); mgg[j] = *(const GAS f32x4*)(g + c) * (*(const GAS f32x4*)(sc + c) + 1.f); mhh[j] = *(const GAS f32x4*)(sh + c); } }
#pragma unroll
            for (int j = 0; j < 4; ++j) hu[u][j] = (hu[u][j] * rstd) * mgg[j] + mhh[j];
            if (u == 0 || ok1) store_row_bf16(H2 + (size_t)rowu[u] * D, lane, hu[u]); }
        const LAS f32x4* W4 = (const LAS f32x4*)RW;
        float gl[2][4];
        { float pg[8];
#pragma unroll
        for (int o = 0; o < 4; ++o) { float p0 = 0.f, p1 = 0.f;
#pragma unroll
            for (int j = 0; j < 4; ++j) { const f32x4 w = W4[o * 256 + lane + 64 * j]; p0 = __builtin_fmaf(hu[0][j].w, w.w, __builtin_fmaf(hu[0][j].z, w.z, __builtin_fmaf(hu[0][j].y, w.y, __builtin_fmaf(hu[0][j].x, w.x, p0)))); p1 = __builtin_fmaf(hu[1][j].w, w.w, __builtin_fmaf(hu[1][j].z, w.z, __builtin_fmaf(hu[1][j].y, w.y, __builtin_fmaf(hu[1][j].x, w.x, p1)))); }
            pg[o] = p0; pg[4 + o] = p1; }
        wave_sum_n(pg);
#pragma unroll
        for (int o = 0; o < 4; ++o) { gl[0][o] = pg[o] + rbias[o]; gl[1][o] = pg[4 + o] + rbias[o]; } }
#pragma unroll
        for (int u = 0; u < 2; ++u) {
        if (u == 1 && !ok1) break;
        const int row = rowu[u];
        int gi = 0; float gm = gl[u][0];
#pragma unroll
        for (int o = 1; o < 4; ++o) if (gl[u][o] > gm) { gm = gl[u][o]; gi = o; }
        float gs = 0.f;
#pragma unroll
        for (int o = 0; o < 4; ++o) gs += __expf(gl[u][o] - gm);
        const float gwt = 1.f / gs;
        float el[8];
#pragma unroll
        for (int e = 0; e < 8; ++e) { float p = 0.f; const int o = 4 + gi * 8 + e;
#pragma unroll
            for (int j = 0; j < 4; ++j) { const f32x4 w = W4[o * 256 + lane + 64 * j]; p = __builtin_fmaf(hu[u][j].w, w.w, __builtin_fmaf(hu[u][j].z, w.z, __builtin_fmaf(hu[u][j].y, w.y, __builtin_fmaf(hu[u][j].x, w.x, p)))); }
            el[e] = p; }
        wave_sum_n(el);
#pragma unroll
        for (int e = 0; e < 8; ++e) el[e] += rbias[4 + gi * 8 + e];
        int i0 = 0; float m0 = el[0];
#pragma unroll
        for (int e = 1; e < 8; ++e) if (el[e] > m0) { m0 = el[e]; i0 = e; }
        int i1 = -1; float m1 = -3.0e38f;
#pragma unroll
        for (int e = 0; e < 8; ++e) if (e != i0 && el[e] > m1) { m1 = el[e]; i1 = e; }
        const float t1 = __expf(m1 - m0);
        const float w0 = gwt / (1.f + t1), w1 = gwt * t1 / (1.f + t1);
        if (lane == 0) {
            const unsigned e0 = (unsigned)(gi * 8 + i0), e1 = (unsigned)(gi * 8 + i1);
            const unsigned r0 = __hip_atomic_fetch_add(lcnt + e0, 1u, __ATOMIC_RELAXED, __HIP_MEMORY_SCOPE_WORKGROUP);
            const unsigned r1 = __hip_atomic_fetch_add(lcnt + e1, 1u, __ATOMIC_RELAXED, __HIP_MEMORY_SCOPE_WORKGROUP);
            v4u q0; q0.x = e0; q0.y = e1; q0.z = r0; q0.w = r1;
            v4u q1; q1.x = __builtin_bit_cast(unsigned, w0); q1.y = __builtin_bit_cast(unsigned, w1); q1.z = 0u; q1.w = 0u;
            *(GAS v4u*)(ROUTE + (size_t)row * 8) = q0; *(GAS v4u*)(ROUTE + (size_t)row * 8 + 4) = q1;
        }
        }
    }
    __syncthreads();
    if (tid < 32) { unsigned* gcnt = (unsigned*)(a.ws + WS_CTL) + CW_CNT + 64 * L;
        const unsigned base = __hip_atomic_fetch_add(gcnt + tid, lcnt[tid], __ATOMIC_RELAXED, __HIP_MEMORY_SCOPE_AGENT);
        ((unsigned*)(a.ws + WS_BLKBASE))[bid * 32 + tid] = base; }
}
template <int L> __device__ __forceinline__ void moe_tables(const Args& a, LAS unsigned char* lds, int tid) {
    LAS int* seg = (LAS int*)(lds + LDSCTL_OFF) + LC_SEG; LAS int* ntl = (LAS int*)(lds + LDSCTL_OFF) + LC_NT; LAS unsigned char* te = lds + LDSCTL_OFF + LC_TILE_B;
    if (tid < 64) {
        const unsigned* gcnt = (const unsigned*)(a.ws + WS_CTL) + CW_CNT + 64 * L;
        const int c = (tid < 32) ? (int)__hip_atomic_load(gcnt + tid, RLX_AGENT) : 0; const int nt = (c + 255) >> 8;
        int incl = nt;
#pragma unroll
        for (int d = 1; d < 32; d <<= 1) { const int t = __shfl_up(incl, d); if (tid >= d) incl += t; }
        const int run = incl - nt, total = __shfl(incl, 31);
        if (tid < 32) { seg[tid] = run * 256; for (int t = 0; t < nt && run + t < 352; ++t) te[run + t] = (unsigned char)tid; }
        if (tid == 0) *ntl = total < 352 ? total : 352;
    }
    __syncthreads();
}
template <int L> __device__ __forceinline__ void p_dispatch(const Args& a, LAS unsigned char* lds, int tid, int lane, int wave, int bid, int G) {
    constexpr int nrows = (L == 0) ? NT : NLAT;
    moe_tables<L>(a, lds, tid);
    const LAS int* seg = (const LAS int*)(lds + LDSCTL_OFF) + LC_SEG;
    const unsigned* ROUTE = (const unsigned*)(a.ws + WS_ROUTE); const unsigned* BB = (const unsigned*)(a.ws + WS_BLKBASE);
    int* TS = (int*)(a.ws + WS_TOKSLOT); int* TOK = (int*)(a.ws + WS_TOK);
    const int chunk = (nrows + G - 1) / G;
    for (int lr = bid * NTHR + tid; lr < nrows; lr += G * NTHR) {
        const int row = (L == 0) ? lr : lat_row(lr); const int blk = lr / chunk;
        const v4u q0 = *(const GAS v4u*)(ROUTE + (size_t)row * 8);
        const int s0 = seg[q0.x] + (int)BB[blk * 32 + q0.x] + (int)q0.z, s1 = seg[q0.y] + (int)BB[blk * 32 + q0.y] + (int)q0.w;
        if (s0 < MAXSLOT && s1 < MAXSLOT) { TS[row * 2] = s0; TS[row * 2 + 1] = s1; TOK[s0] = row; TOK[s1] = row; }
    }
}
__device__ __forceinline__ void p11_combine_mod(const Args& a, int lane, int wave, int bid, int G) {
    bf16* X = slotp(a, 4); const bf16* YS = (const bf16*)(a.ws + WS_XS); const int* TS = (const int*)(a.ws + WS_TOKSLOT); bf16* H1 = slotp(a, 6);
    const float* RW = (const float*)(a.ws + WS_ROUTE);
    const int NGW = G * NWAVES; constexpr int CU_ = 4;
    for (int gi = bid * NWAVES + wave; gi < NT / CU_; gi += NGW) {
        const int row0 = CU_ * gi, mr = mod_row(row0);
        int s0[CU_], s1[CU_]; float w0[CU_], w1[CU_];
#pragma unroll
        for (int u = 0; u < CU_; ++u) { const int row = row0 + u; const v2u ts = *(const GAS v2u*)(TS + row * 2); const f32x2_t w = *(const GAS f32x2_t*)(RW + (size_t)row * 8 + 4);
            s0[u] = (int)ts.x; s1[u] = (int)ts.y; w0[u] = w.x; w1[u] = w.y; }
        v2u x[CU_][4], y0[CU_][4], y1[CU_][4];
#pragma unroll
        for (int u = 0; u < CU_; ++u)
            { ld_row_bf(X + (size_t)(row0 + u) * D, lane, x[u]); ld_row_bf(YS + (size_t)s0[u] * D, lane, y0[u]); ld_row_bf(YS + (size_t)s1[u] * D, lane, y1[u]); }
        const float* g2 = modp(a, 0, mr, 5);
        f32x4 v[CU_][4]; float ss[CU_]; v2u xo[CU_][4];
#pragma unroll
        for (int j = 0; j < 4; ++j) { const int c = colb(lane, j); const f32x4 gv = *(const GAS f32x4*)(g2 + c);
#pragma unroll
            for (int u = 0; u < CU_; ++u) {
                const f32x4 f = (f32x4){w0[u] * bflo(y0[u][j].x) + w1[u] * bflo(y1[u][j].x), w0[u] * bfhi(y0[u][j].x) + w1[u] * bfhi(y1[u][j].x), w0[u] * bflo(y0[u][j].y) + w1[u] * bflo(y1[u][j].y), w0[u] * bfhi(y0[u][j].y) + w1[u] * bfhi(y1[u][j].y)};
                const f32x4 xv = (f32x4){bflo(x[u][j].x), bfhi(x[u][j].x), bflo(x[u][j].y), bfhi(x[u][j].y)};
                v[u][j] = xv + gv * f;
                xo[u][j].x = pk2(v[u][j].x, v[u][j].y); xo[u][j].y = pk2(v[u][j].z, v[u][j].w);
                const float q = (v[u][j].x * v[u][j].x + v[u][j].y * v[u][j].y) + (v[u][j].z * v[u][j].z + v[u][j].w * v[u][j].w); ss[u] = (j == 0) ? q : ss[u] + q; } }
#pragma unroll
        for (int u = 0; u < CU_; ++u) st_row_bf(X + (size_t)(row0 + u) * D, lane, xo[u]);
        float rstd[CU_];
#pragma unroll
        for (int u = 0; u < CU_; ++u) rstd[u] = rsqrtf(wave_sum(ss[u]) * (1.f / D) + 1e-6f);
        const float* g = a.in[I_N1G] + D; const float* sh = modp(a, 1, mr, 0); const float* sc = modp(a, 1, mr, 1);
#pragma unroll
        for (int j = 0; j < 4; ++j) { const int c = colb(lane, j); const f32x4 gg = *(const GAS f32x4*)(g + c) * (*(const GAS f32x4*)(sc + c) + 1.f), hh = *(const GAS f32x4*)(sh + c);
#pragma unroll
            for (int u = 0; u < CU_; ++u) { const f32x4 h = (v[u][j] * rstd[u]) * gg + hh; xo[u][j].x = pk2(h.x, h.y); xo[u][j].y = pk2(h.z, h.w); } }
#pragma unroll
        for (int u = 0; u < CU_; ++u) st_row_bf(H1 + (size_t)(row0 + u) * D, lane, xo[u]);
    }
}
__device__ __forceinline__ void p12b_qknorm_rope(const Args& a, int lane, int wave, int bid, int G) {
    bf16 *Q = slotp(a, 0), *K = slotp(a, 1);
    const int ls = lane & 3, axis = ls >> 1, half = ls & 1;
    float qg[16], kg[16], inv[16];
#pragma unroll
    for (int e = 0; e < 16; ++e) { qg[e] = a.in[I_QNG][16 * ls + e]; kg[e] = a.in[I_KNG][16 * ls + e]; inv[e] = exp2f(-(float)e * (13.287712379549449f / 16.f)); }
    const int NGW = G * NWAVES;
    for (int row = bid * NWAVES + wave; row < NT; row += NGW) {
        const int t = row % TT; const size_t o = (size_t)row * D + 16 * lane;
        float q[16], k[16];
        load16(Q + o, q); load16(K + o, k);
        float sq = 0.f, sk = 0.f;
#pragma unroll
        for (int e = 0; e < 16; ++e) { sq += q[e] * q[e]; sk += k[e] * k[e]; }
        const float rq = rsqrtf(quad_sum(sq) * (1.f / 64.f) + 1e-6f), rk = rsqrtf(quad_sum(sk) * (1.f / 64.f) + 1e-6f);
#pragma unroll
        for (int e = 0; e < 16; ++e) { q[e] = q[e] * rq * qg[e]; k[e] = k[e] * rk * kg[e]; }
        if (t >= TC) {
            const int tl = t - TC; const float pos = (float)(axis ? (tl & 63) : (tl >> 6));
#pragma unroll
            for (int e = 0; e < 16; ++e) { const float ang = pos * inv[e]; const float c = __cosf(ang), s = __sinf(ang);
                const float pq = __shfl_xor(q[e], 1), pk = __shfl_xor(k[e], 1);
                q[e] = half ? (pq * s + q[e] * c) : (q[e] * c - pq * s);
                k[e] = half ? (pk * s + k[e] * c) : (k[e] * c - pk * s); }
        }
#pragma unroll
        for (int e = 0; e < 16; ++e) q[e] *= 0.18033688011112042f;
        store16(Q + o, q); store16(K + o, k);
    }
}
__device__ __forceinline__ void p12c_vtranspose(const Args& a, LAS unsigned char* lds, int lane, int wave, int bid, int G) {
    const bf16* V = slotp(a, 2); bf16* VT = slotp(a, 6);
    LAS unsigned short* T = (LAS unsigned short*)(lds + wave * 16384);
    const int NGW = G * NWAVES;
    for (int u = bid * NWAVES + wave; u < NB * 8 * (TT / 64); u += NGW) {
        const int b = u / (8 * (TT / 64)), rem = u - b * (8 * (TT / 64)), h = rem / (TT / 64), kc = rem - h * (TT / 64);
#pragma unroll 4
        for (int i = 0; i < 16; ++i) { const int chunk = i * 64 + lane, key = chunk >> 4, cg = chunk & 15;
            const v4u w = *(const GAS v4u*)(V + (size_t)(b * TT + kc * 64 + key) * D + h * 128 + cg * 8);
            const int kq = key & 15, pos = (key & ~15) | (kq & 3) | ((kq & 4) << 1) | ((kq & 8) >> 1);
            LAS unsigned short* t = T + (cg * 8) * 64 + pos;
            t[0 * 64] = (unsigned short)(w.x & 0xffffu); t[1 * 64] = (unsigned short)(w.x >> 16); t[2 * 64] = (unsigned short)(w.y & 0xffffu); t[3 * 64] = (unsigned short)(w.y >> 16);
            t[4 * 64] = (unsigned short)(w.z & 0xffffu); t[5 * 64] = (unsigned short)(w.z >> 16); t[6 * 64] = (unsigned short)(w.w & 0xffffu); t[7 * 64] = (unsigned short)(w.w >> 16); }
        LDS_WAIT(); asm volatile("" ::: "memory");
#pragma unroll 4
        for (int i = 0; i < 16; ++i) { const int chunk = i * 64 + lane, e = chunk >> 3, c8 = chunk & 7;
            const v4u o = *(const LAS v4u*)(T + e * 64 + c8 * 8);
            *(GAS v4u*)(VT + ((size_t)((b * 8 + h) * 128 + e)) * TT + kc * 64 + c8 * 8) = o; }
        LDS_WAIT(); asm volatile("" ::: "memory");
    }
}
typedef float f32x16 __attribute__((ext_vector_type(16)));
typedef short s16x8 __attribute__((ext_vector_type(8)));
__device__ __forceinline__ unsigned cvtpk(float lo, float hi) { unsigned r; asm volatile("v_cvt_pk_bf16_f32 %0, %1, %2" : "=v"(r) : "v"(lo), "v"(hi)); return r; }
__device__ __forceinline__ s16x8 pack_p(const f32x16& x, int s8) { v4u w; w.x = cvtpk(x[s8], x[s8 + 1]); w.y = cvtpk(x[s8 + 2], x[s8 + 3]); w.z = cvtpk(x[s8 + 4], x[s8 + 5]); w.w = cvtpk(x[s8 + 6], x[s8 + 7]); return __builtin_bit_cast(s16x8, w); }
__device__ __forceinline__ void p13_attention(const Args& a, LAS unsigned char* lds, int tid, int lane, int wave, int bid, int G) {
    const bf16 *Q = slotp(a, 0), *K = slotp(a, 1), *V = slotp(a, 2); bf16* AO = slotp(a, 6);
    constexpr int KP = 144, VP = 320, KBYTES = 64 * KP, STAGE = KBYTES + 64 * VP, NTILE = TT / 64, XOFF = 2 * STAGE, XP = 272;
    typedef short s16x4 __attribute__((ext_vector_type(4)));
    const int r32 = lane & 31, hh = lane >> 5;
    const float lam_init = 0.8f - 0.6f * expf(-0.3f);
    float d1 = 0.f, d2 = 0.f;
    for (int e = 0; e < 64; ++e) { d1 += a.in[I_LQ1][e] * a.in[I_LK1][e]; d2 += a.in[I_LQ2][e] * a.in[I_LK2][e]; }
    const float lam = expf(d1) - expf(d2) + lam_init;
    const int kkey = tid >> 3, kc8 = tid & 7, vkey = tid >> 4, vch = tid & 15;
    const unsigned klds = (unsigned)(kkey * KP + kc8 * 16), vlds0 = (unsigned)(KBYTES + vkey * VP + vch * 16), vlds1 = vlds0 + 32 * VP;
    const unsigned vrd = (unsigned)((4 * hh + ((lane & 15) >> 2)) * VP + (16 * ((lane >> 4) & 1) + 4 * (lane & 3)) * 2);
    LAS unsigned char* xw = lds + XOFF + (wave * 32 + r32) * XP;
    for (int unit = bid; unit < NB * 8 * 8; unit += G) {
        const int b = unit >> 6, h = (unit >> 3) & 7, qt = unit & 7;
        const int qrow = b * TT + TC + qt * 256 + wave * 32 + r32;
        const bf16* vg = V + (size_t)(b * TT + vkey) * D + h * 128 + vch * 8;
        f32x16 acc[4];
        float lsum = 0.f;
#pragma unroll 1
        for (int m = 0; m < 2; ++m) {
            s16x8 qf[4];
#pragma unroll
            for (int ks = 0; ks < 4; ++ks) qf[ks] = __builtin_bit_cast(s16x8, *(const GAS v4u*)(Q + (size_t)qrow * D + h * 128 + m * 64 + 16 * ks + 8 * hh));
#pragma unroll
            for (int eb = 0; eb < 4; ++eb)
#pragma unroll
                for (int r = 0; r < 16; ++r) acc[eb][r] = 0.f;
            lsum = 0.f;
            const bf16* kg = K + (size_t)(b * TT + kkey) * D + h * 128 + m * 64 + kc8 * 8;
            v4u sk = *(const GAS v4u*)kg, sv0 = *(const GAS v4u*)vg, sv1 = *(const GAS v4u*)(vg + (size_t)32 * D);
            __syncthreads();
            *(LAS v4u*)(lds + klds) = sk; *(LAS v4u*)(lds + vlds0) = sv0; *(LAS v4u*)(lds + vlds1) = sv1;
            __syncthreads();
            for (int t = 0; t < NTILE; ++t) {
                const bool more = (t + 1 < NTILE);
                if (more) { sk = *(const GAS v4u*)(kg + (size_t)(t + 1) * 64 * D); sv0 = *(const GAS v4u*)(vg + (size_t)(t + 1) * 64 * D); sv1 = *(const GAS v4u*)(vg + (size_t)(t + 1) * 64 * D + (size_t)32 * D); }
                const LAS unsigned char* kb_ = lds + (t & 1) * STAGE; const LAS unsigned char* vb_ = kb_ + KBYTES;
#pragma unroll
                for (int kb = 0; kb < 2; ++kb) {
                    f32x16 x;
#pragma unroll
                    for (int r = 0; r < 16; ++r) x[r] = 0.f;
#pragma unroll
                    for (int ks = 0; ks < 4; ++ks) { const s16x8 kf = *(const LAS s16x8*)(kb_ + (32 * kb + r32) * KP + (16 * ks + 8 * hh) * 2); x = __builtin_amdgcn_mfma_f32_32x32x16_bf16(kf, qf[ks], x, 0, 0, 0); }
#pragma unroll
                    for (int r = 0; r < 16; ++r) { x[r] = __builtin_amdgcn_exp2f(x[r]); lsum += x[r]; }
                    const s16x8 p0 = pack_p(x, 0), p1 = pack_p(x, 8);
#pragma unroll
                    for (int eb = 0; eb < 4; ++eb) {
                        const LAS unsigned char* vp_ = vb_ + vrd + (32 * kb) * VP + eb * 64;
                        const s16x4 t0 = __builtin_amdgcn_ds_read_tr16_b64_v4i16((LAS s16x4*)(vp_)), t1 = __builtin_amdgcn_ds_read_tr16_b64_v4i16((LAS s16x4*)(vp_ + 8 * VP));
                        const s16x4 t2 = __builtin_amdgcn_ds_read_tr16_b64_v4i16((LAS s16x4*)(vp_ + 16 * VP)), t3 = __builtin_amdgcn_ds_read_tr16_b64_v4i16((LAS s16x4*)(vp_ + 24 * VP));
                        const s16x8 vf0 = __builtin_shufflevector(t0, t1, 0, 1, 2, 3, 4, 5, 6, 7), vf1 = __builtin_shufflevector(t2, t3, 0, 1, 2, 3, 4, 5, 6, 7);
                        acc[eb] = __builtin_amdgcn_mfma_f32_32x32x16_bf16(vf0, p0, acc[eb], 0, 0, 0);
                        acc[eb] = __builtin_amdgcn_mfma_f32_32x32x16_bf16(vf1, p1, acc[eb], 0, 0, 0); }
                }
                if (more) { LAS unsigned char* nb_ = lds + ((t + 1) & 1) * STAGE; *(LAS v4u*)(nb_ + klds) = sk; *(LAS v4u*)(nb_ + vlds0) = sv0; *(LAS v4u*)(nb_ + vlds1) = sv1; }
                __syncthreads();
            }
            lsum += __shfl_xor(lsum, 32);
            if (m == 0) {
                const float il = 1.f / lsum;
#pragma unroll
                for (int eb = 0; eb < 4; ++eb)
#pragma unroll
                    for (int g4 = 0; g4 < 4; ++g4) { v2u o; o.x = pk2(acc[eb][4 * g4] * il, acc[eb][4 * g4 + 1] * il); o.y = pk2(acc[eb][4 * g4 + 2] * il, acc[eb][4 * g4 + 3] * il);
                        *(LAS v2u*)(xw + (32 * eb + 8 * g4 + 4 * hh) * 2) = o; }
            }
        }
        const float il1 = lam / lsum;
        float ssq = 0.f;
#pragma unroll
        for (int eb = 0; eb < 4; ++eb)
#pragma unroll
            for (int g4 = 0; g4 < 4; ++g4) { const v2u x0 = *(const LAS v2u*)(xw + (32 * eb + 8 * g4 + 4 * hh) * 2);
                const float o0 = bflo(x0.x) - acc[eb][4 * g4] * il1, o1 = bfhi(x0.x) - acc[eb][4 * g4 + 1] * il1, o2 = bflo(x0.y) - acc[eb][4 * g4 + 2] * il1, o3 = bfhi(x0.y) - acc[eb][4 * g4 + 3] * il1;
                acc[eb][4 * g4] = o0; acc[eb][4 * g4 + 1] = o1; acc[eb][4 * g4 + 2] = o2; acc[eb][4 * g4 + 3] = o3; ssq += (o0 * o0 + o1 * o1) + (o2 * o2 + o3 * o3); }
        ssq += __shfl_xor(ssq, 32);
        const float rstd = rsqrtf(ssq * (1.f / 128.f) + 1e-6f) * (1.f - lam_init);
#pragma unroll
        for (int eb = 0; eb < 4; ++eb)
#pragma unroll
            for (int g4 = 0; g4 < 4; ++g4) { const int e0 = 32 * eb + 8 * g4 + 4 * hh; const f32x4 sg = *(const GAS f32x4*)(a.in[I_SUBG] + e0);
                v2u o; o.x = pk2(acc[eb][4 * g4] * rstd * sg.x, acc[eb][4 * g4 + 1] * rstd * sg.y); o.y = pk2(acc[eb][4 * g4 + 2] * rstd * sg.z, acc[eb][4 * g4 + 3] * rstd * sg.w);
                *(GAS v2u*)(AO + (size_t)qrow * D + h * 128 + e0) = o; }
    }
}
__device__ __forceinline__ void p19_final(const Args& a, int lane, int wave, int bid, int G) {
    const bf16* X = slotp(a, 4); const bf16* YS = (const bf16*)(a.ws + WS_XS); const int* TS = (const int*)(a.ws + WS_TOKSLOT);
    const float* RW = (const float*)(a.ws + WS_ROUTE);
    const int NGW = G * NWAVES;
    for (int gi = bid * NWAVES + wave; gi < NLAT / 4; gi += NGW) {
        const int lr0 = 4 * gi, b = lr0 >> 11;
        int s0[4], s1[4]; float w0[4], w1[4];
#pragma unroll
        for (int u = 0; u < 4; ++u) { const int row = lat_row(lr0 + u); const v2u ts = *(const GAS v2u*)(TS + row * 2); const f32x2_t w = *(const GAS f32x2_t*)(RW + (size_t)row * 8 + 4);
            s0[u] = (int)ts.x; s1[u] = (int)ts.y; w0[u] = w.x; w1[u] = w.y; }
        v2u x[4][4], y0[4][4], y1[4][4];
#pragma unroll
        for (int u = 0; u < 4; ++u) { const int row = lat_row(lr0 + u);
            { ld_row_bf(X + (size_t)row * D, lane, x[u]); ld_row_bf(YS + (size_t)s0[u] * D, lane, y0[u]); ld_row_bf(YS + (size_t)s1[u] * D, lane, y1[u]); } }
        const float* g2 = modp(a, 1, b, 5);
        f32x4 gv[4];
#pragma unroll
        for (int j = 0; j < 4; ++j) gv[j] = *(const GAS f32x4*)(g2 + colb(lane, j));
#pragma unroll
        for (int u = 0; u < 4; ++u)
#pragma unroll
            for (int j = 0; j < 4; ++j) { const int c = colb(lane, j);
                const f32x4 f = (f32x4){w0[u] * bflo(y0[u][j].x) + w1[u] * bflo(y1[u][j].x), w0[u] * bfhi(y0[u][j].x) + w1[u] * bfhi(y1[u][j].x), w0[u] * bflo(y0[u][j].y) + w1[u] * bflo(y1[u][j].y), w0[u] * bfhi(y0[u][j].y) + w1[u] * bfhi(y1[u][j].y)};
                const f32x4 xv = (f32x4){bflo(x[u][j].x), bfhi(x[u][j].x), bflo(x[u][j].y), bfhi(x[u][j].y)};
                *(GAS f32x4*)(a.out + (size_t)(lr0 + u) * D + c) = xv + gv[j] * f; }
    }
}
__device__ __forceinline__ v4u pack2x4(const f32x4& v0, const f32x4& v1) { v4u w; w.x = pk2(v0.x, v0.y); w.y = pk2(v0.z, v0.w); w.z = pk2(v1.x, v1.y); w.w = pk2(v1.z, v1.w); return w; }
struct F_Lora1 {
    bf16* L1;
    __device__ __forceinline__ void op(int row, int col, const f32x4& v0, const f32x4& v1) const {
        const int t = col >> 8, c = col & 255, rr = row - t * NT; f32x4 x0 = v0, x1 = v1;
        if (c < 128) {
            if (t == 0) { x0 = (f32x4){ftanh(v0.x), ftanh(v0.y), ftanh(v0.z), ftanh(v0.w)}; x1 = (f32x4){ftanh(v1.x), ftanh(v1.y), ftanh(v1.z), ftanh(v1.w)}; }
            else if (t == 2) { x0 = (f32x4){fsigmoid(v0.x), fsigmoid(v0.y), fsigmoid(v0.z), fsigmoid(v0.w)}; x1 = (f32x4){fsigmoid(v1.x), fsigmoid(v1.y), fsigmoid(v1.z), fsigmoid(v1.w)}; }
            *(GAS v4u*)(L1 + (size_t)rr * 512 + t * 128 + c) = pack2x4(x0, x1);
        } else if (t == 2) { *(GAS v4u*)(L1 + (size_t)rr * 512 + 384 + (c - 128)) = (v4u){0u, 0u, 0u, 0u}; }
    }
};
struct F_Rkv {
    bf16* O;
    __device__ __forceinline__ void op(int row, int col, const f32x4& v0, const f32x4& v1) const {
        const int t = col >> 10, c = col & 1023; *(GAS v4u*)(O + (size_t)t * US + (size_t)(row - t * NT) * D + c) = pack2x4(v0, v1); }
};
struct StackOrder : pg8::StaticOrder {
    int per;
    __device__ __forceinline__ bool next(int i, pg8::Unit& u) const { if (!pg8::StaticOrder::next(i, u)) return false; u.pm += (u.pn / per) * (NT / 256); return true; }
};
struct F_Split3 {
    bf16* O; bf16* L1;
    __device__ __forceinline__ void op(int row, int col, const f32x4& v0, const f32x4& v1) const {
        if (col < 3072) { const int t = col >> 10, c = col & 1023; *(GAS v4u*)(O + (size_t)t * US + (size_t)row * D + c) = pack2x4(v0, v1); }
        else { const int cl = col - 3072, reg = cl >> 7; f32x4 x0 = v0, x1 = v1;
            if (reg == 0) { x0 = (f32x4){ftanh(v0.x), ftanh(v0.y), ftanh(v0.z), ftanh(v0.w)}; x1 = (f32x4){ftanh(v1.x), ftanh(v1.y), ftanh(v1.z), ftanh(v1.w)}; }
            else if (reg == 2) { x0 = (f32x4){fsigmoid(v0.x), fsigmoid(v0.y), fsigmoid(v0.z), fsigmoid(v0.w)}; x1 = (f32x4){fsigmoid(v1.x), fsigmoid(v1.y), fsigmoid(v1.z), fsigmoid(v1.w)}; }
            else if (reg == 3) { x0 = (f32x4){0.f, 0.f, 0.f, 0.f}; x1 = x0; }
            *(GAS v4u*)(L1 + (size_t)row * 512 + cl) = pack2x4(x0, x1); }
    }
};
struct F_Lora2 {
    bf16 *DD0, *DD1, *A0, *A1; const float* w0; const float* a0;
    __device__ __forceinline__ void op(int row, int col, const f32x4& v0, const f32x4& v1) const {
        const int t = col >> 10, c = col & 1023;
        bf16* dst = (t == 0) ? DD0 : (t == 1) ? DD1 : (t == 2) ? A0 : A1;
        const float* bias = (t < 2) ? (w0 + t * 1024 + c) : (a0 + (t - 2) * 1024 + c);
        const f32x4 b0 = *(const GAS f32x4*)bias, b1 = *(const GAS f32x4*)(bias + 4);
        float x[8] = {v0.x + b0.x, v0.y + b0.y, v0.z + b0.z, v0.w + b0.w, v1.x + b1.x, v1.y + b1.y, v1.z + b1.z, v1.w + b1.w};
#pragma unroll
        for (int e = 0; e < 8; ++e) { const float sg = fsigmoid(x[e]); x[e] = (t < 2) ? (1.f - fexp(-0.6065306597f * sg)) : sg; }
        *(GAS v4u*)(dst + (size_t)row * D + c) = pack8(x);
    }
};
struct F_Gate {
    const bf16* YN; bf16* Z;
    __device__ __forceinline__ void op(int row, int col, const f32x4& v0, const f32x4& v1) const {
        float y[8]; unpack8(*(const GAS v4u*)(YN + (size_t)row * D + col), y);
        float x[8] = {y[0] * v0.x, y[1] * v0.y, y[2] * v0.z, y[3] * v0.w, y[4] * v1.x, y[5] * v1.y, y[6] * v1.z, y[7] * v1.w};
        *(GAS v4u*)(Z + (size_t)row * D + col) = pack8(x);
    }
};
struct F_Wo0 {
    const float* x; const float* ctx; const float* mod0; bf16* X;
    __device__ __forceinline__ void op(int row, int col, const f32x4& v0, const f32x4& v1) const {
        const int b = row / TT, t = row - b * TT;
        const float* xr = ((t < TC) ? ctx + ((size_t)b * TC + t) * D : x + ((size_t)b * TL + (t - TC)) * D) + col;
        const float* g = mod0 + (size_t)((t < TC) ? 16 : b) * 6144 + 2 * D + col;
        *(GAS v4u*)(X + (size_t)row * D + col) = pack2x4(*(const GAS f32x4*)xr + *(const GAS f32x4*)g * v0, *(const GAS f32x4*)(xr + 4) + *(const GAS f32x4*)(g + 4) * v1);
    }
};
struct F_Wo1 {
    const float* gate; bf16* X;
    __device__ __forceinline__ void op(int row, int col, const f32x4& v0, const f32x4& v1) const {
        const float* g = gate + (size_t)(row / TT) * 6144 + col;
        GAS v4u* p = (GAS v4u*)(X + (size_t)row * D + col); float y[8]; unpack8(*p, y);
        const f32x4 g0 = *(const GAS f32x4*)g, g1 = *(const GAS f32x4*)(g + 4);
        float o[8] = {y[0] + g0.x * v0.x, y[1] + g0.y * v0.y, y[2] + g0.z * v0.z, y[3] + g0.w * v0.w, y[4] + g1.x * v1.x, y[5] + g1.y * v1.y, y[6] + g1.z * v1.z, y[7] + g1.w * v1.w};
        *p = pack8(o);
    }
};
struct F_GateUp {
    bf16* HID;
    __device__ __forceinline__ void op(int row, int col, const f32x4& g, const f32x4& u) const {
        const int hc = (col & 511) >> 1;
        v2u o; o.x = pk2(g.x * fsigmoid(g.x) * u.x, g.y * fsigmoid(g.y) * u.y); o.y = pk2(g.z * fsigmoid(g.z) * u.z, g.w * fsigmoid(g.w) * u.w);
        *(GAS v2u*)(HID + (size_t)row * 256 + hc) = o;
    }
};
struct F_Down {
    bf16* YS;
    __device__ __forceinline__ void op(int row, int col, const f32x4& v0, const f32x4& v1) const { *(GAS v4u*)(YS + (size_t)row * D + (col & 1023)) = pack2x4(v0, v1); }
};
struct EpiQKV {
    static constexpr bool PERM = true, AFTER_DRAIN = false;
    bf16* O; const float* qng; const float* kng; const float* rope;
    __device__ __forceinline__ void operator()(const f32x4 (&acc)[2][2][4][2], const pg8::Unit& u, int wr, int wc, int fr, int fq) const {
        const int row0 = u.pm * pg8::BM + wr * 64 + fr;
        if (u.pn >= 8) {
            const int col0 = (u.pn - 8) * pg8::BM + wc * 32 + 8 * fq;
#pragma unroll
            for (int ai = 0; ai < 2; ++ai)
#pragma unroll
                for (int m = 0; m < 4; ++m)
#pragma unroll
                    for (int bj = 0; bj < 2; ++bj) *(GAS v4u*)(O + (size_t)2 * US + (size_t)(row0 + ai * pg8::HALF + m * 16) * D + col0 + bj * pg8::HALF) = pack2x4(acc[ai][bj][m][0], acc[ai][bj][m][1]);
            return;
        }
        const bool isq = u.pn < 4;
        const int A = fq >> 1, B = fq & 1, e0 = 32 * A + 8 * B;
        bf16* dst = O + (isq ? (size_t)0 : US) + (u.pn & 3) * pg8::BM + 64 * wc + e0;
        const float* gn = (isq ? qng : kng) + e0;
        const float qs = isq ? 0.18033688011112042f : 1.f;
        const f32x4 gl0 = *(const GAS f32x4*)gn * qs, gl1 = *(const GAS f32x4*)(gn + 4) * qs, gh0 = *(const GAS f32x4*)(gn + 16) * qs, gh1 = *(const GAS f32x4*)(gn + 20) * qs;
        const int tb = u.pm % 9;
#pragma unroll
        for (int ai = 0; ai < 2; ++ai)
#pragma unroll
            for (int m = 0; m < 4; ++m) {
                f32x4 l0 = acc[ai][0][m][0], l1 = acc[ai][0][m][1], h0 = acc[ai][1][m][0], h1 = acc[ai][1][m][1];
                float ss = ((l0.x * l0.x + l0.y * l0.y) + (l0.z * l0.z + l0.w * l0.w)) + ((l1.x * l1.x + l1.y * l1.y) + (l1.z * l1.z + l1.w * l1.w))
                         + ((h0.x * h0.x + h0.y * h0.y) + (h0.z * h0.z + h0.w * h0.w)) + ((h1.x * h1.x + h1.y * h1.y) + (h1.z * h1.z + h1.w * h1.w));
                ss += __shfl_xor(ss, 16); ss += __shfl_xor(ss, 32);
                const float rstd = rsqrtf(ss * (1.f / 64.f) + 1e-6f);
                l0 = l0 * rstd * gl0; l1 = l1 * rstd * gl1; h0 = h0 * rstd * gh0; h1 = h1 * rstd * gh1;
                if (tb != 0) {
                    const int pos = A ? (16 * m + fr) : (4 * (tb - 1) + wr + 2 * ai);
                    const float* rp = rope + pos * 32 + B * 16;
                    const f32x4 c0 = *(const GAS f32x4*)rp, c1 = *(const GAS f32x4*)(rp + 4), s0 = *(const GAS f32x4*)(rp + 8), s1 = *(const GAS f32x4*)(rp + 12);
                    const f32x4 nl0 = l0 * c0 - h0 * s0, nl1 = l1 * c1 - h1 * s1, nh0 = h0 * c0 + l0 * s0, nh1 = h1 * c1 + l1 * s1;
                    l0 = nl0; l1 = nl1; h0 = nh0; h1 = nh1;
                }
                bf16* d = dst + (size_t)(row0 + ai * pg8::HALF + m * 16) * D;
                *(GAS v4u*)d = pack2x4(l0, l1); *(GAS v4u*)(d + 16) = pack2x4(h0, h1);
            }
    }
};
struct EpiWo1 {
    static constexpr bool PERM = true, AFTER_DRAIN = false;
    const float* gate; bf16* X;
    __device__ __forceinline__ void operator()(const f32x4 (&acc)[2][2][4][2], const pg8::Unit& u, int wr, int wc, int fr, int fq) const {
        const int row0 = u.pm * pg8::BM + wr * 64 + fr, col0 = u.pn * pg8::BM + wc * 32 + 8 * fq;
        const float* g = gate + (size_t)(u.pm / 9) * 6144 + col0;
        f32x4 gv[2][2];
#pragma unroll
        for (int bj = 0; bj < 2; ++bj) { gv[bj][0] = *(const GAS f32x4*)(g + bj * pg8::HALF); gv[bj][1] = *(const GAS f32x4*)(g + bj * pg8::HALF + 4); }
        v4u xv[2][4][2];
#pragma unroll
        for (int ai = 0; ai < 2; ++ai)
#pragma unroll
            for (int m = 0; m < 4; ++m)
#pragma unroll
                for (int bj = 0; bj < 2; ++bj) xv[ai][m][bj] = *(const GAS v4u*)(X + (size_t)(row0 + ai * pg8::HALF + m * 16) * D + col0 + bj * pg8::HALF);
#pragma unroll
        for (int ai = 0; ai < 2; ++ai)
#pragma unroll
            for (int m = 0; m < 4; ++m)
#pragma unroll
                for (int bj = 0; bj < 2; ++bj) { float y[8]; unpack8(xv[ai][m][bj], y); const f32x4 v0 = acc[ai][bj][m][0], v1 = acc[ai][bj][m][1], g0 = gv[bj][0], g1 = gv[bj][1];
                    float o[8] = {y[0] + g0.x * v0.x, y[1] + g0.y * v0.y, y[2] + g0.z * v0.z, y[3] + g0.w * v0.w, y[4] + g1.x * v1.x, y[5] + g1.y * v1.y, y[6] + g1.z * v1.z, y[7] + g1.w * v1.w};
                    *(GAS v4u*)(X + (size_t)(row0 + ai * pg8::HALF + m * 16) * D + col0 + bj * pg8::HALF) = pack8(o); }
    }
};
struct EpiGate {
    static constexpr bool PERM = true, AFTER_DRAIN = false;
    const bf16* YN; bf16* Z;
    __device__ __forceinline__ void operator()(const f32x4 (&acc)[2][2][4][2], const pg8::Unit& u, int wr, int wc, int fr, int fq) const {
        const int row0 = u.pm * pg8::BM + wr * 64 + fr, col0 = u.pn * pg8::BM + wc * 32 + 8 * fq;
#pragma unroll
        for (int ai = 0; ai < 2; ++ai) {
            v4u yv[4][2];
#pragma unroll
            for (int m = 0; m < 4; ++m)
#pragma unroll
                for (int bj = 0; bj < 2; ++bj) yv[m][bj] = *(const GAS v4u*)(YN + (size_t)(row0 + ai * pg8::HALF + m * 16) * D + col0 + bj * pg8::HALF);
#pragma unroll
            for (int m = 0; m < 4; ++m)
#pragma unroll
                for (int bj = 0; bj < 2; ++bj) { float y[8]; unpack8(yv[m][bj], y); const f32x4 v0 = acc[ai][bj][m][0], v1 = acc[ai][bj][m][1];
                    float o[8] = {y[0] * v0.x, y[1] * v0.y, y[2] * v0.z, y[3] * v0.w, y[4] * v1.x, y[5] * v1.y, y[6] * v1.z, y[7] * v1.w};
                    *(GAS v4u*)(Z + (size_t)(row0 + ai * pg8::HALF + m * 16) * D + col0 + bj * pg8::HALF) = pack8(o); }
        }
    }
};
struct EpiWo0 {
    static constexpr bool PERM = true, AFTER_DRAIN = false;
    const float* x; const float* ctx; const float* mod0; bf16* X;
    __device__ __forceinline__ void operator()(const f32x4 (&acc)[2][2][4][2], const pg8::Unit& u, int wr, int wc, int fr, int fq) const {
        const int lrow = wr * 64 + fr, col0 = u.pn * pg8::BM + wc * 32 + 8 * fq;
        const int b = u.pm / 9, tb = u.pm - 9 * b;
        const float* xr0 = ((tb == 0) ? ctx + (size_t)b * TC * D : x + ((size_t)b * TL + (size_t)(tb - 1) * 256) * D) + (size_t)lrow * D + col0;
        const float* g = mod0 + (size_t)((tb == 0) ? 16 : b) * 6144 + 2 * D + col0;
        f32x4 gv[2][2];
#pragma unroll
        for (int bj = 0; bj < 2; ++bj) { gv[bj][0] = *(const GAS f32x4*)(g + bj * pg8::HALF); gv[bj][1] = *(const GAS f32x4*)(g + bj * pg8::HALF + 4); }
#pragma unroll
        for (int ai = 0; ai < 2; ++ai) {
            f32x4 xv[4][2][2];
#pragma unroll
            for (int m = 0; m < 4; ++m)
#pragma unroll
                for (int bj = 0; bj < 2; ++bj) { const float* p = xr0 + (size_t)(ai * pg8::HALF + m * 16) * D + bj * pg8::HALF; xv[m][bj][0] = *(const GAS f32x4*)p; xv[m][bj][1] = *(const GAS f32x4*)(p + 4); }
#pragma unroll
            for (int m = 0; m < 4; ++m)
#pragma unroll
                for (int bj = 0; bj < 2; ++bj)
                    *(GAS v4u*)(X + (size_t)(u.pm * pg8::BM + lrow + ai * pg8::HALF + m * 16) * D + col0 + bj * pg8::HALF) = pack2x4(xv[m][bj][0] + gv[bj][0] * acc[ai][bj][m][0], xv[m][bj][1] + gv[bj][1] * acc[ai][bj][m][1]);
        }
    }
};
struct MoeOrder {
    const LAS unsigned char* te; int nunits, nN, G, c;
    __device__ __forceinline__ bool next(int i, pg8::Unit& u) const { const int L = i * G + c; if (L >= nunits) return false; const int T = L / nN; u.pm = T; u.pn = (int)te[T] * nN + (L - T * nN); return true; }
    __device__ __forceinline__ void a_ready(const pg8::Unit&) const {}
    __device__ __forceinline__ void done(const pg8::Unit&) const {}
};
struct LatOrder {
    int G, c;
    __device__ __forceinline__ bool next(int i, pg8::Unit& u) const { const int L = i * G + c; if (L >= 512) return false; const int q = L >> 2; u.pm = (q >> 3) * 9 + 1 + (q & 7); u.pn = L & 3; return true; }
    __device__ __forceinline__ void a_ready(const pg8::Unit&) const {}
    __device__ __forceinline__ void done(const pg8::Unit&) const {}
};
__device__ __forceinline__ void moe_gather_table(const Args& a, LAS unsigned char* lds, int tid, int bid, int G, int nunits) {
    LAS int* gtab = (LAS int*)(lds + 131072); const int* TOK = (const int*)(a.ws + WS_TOK);
    for (int i = 0; i < 16; ++i) { const int Lu = i * G + bid; if (Lu >= nunits) break; if (tid < 256) gtab[i * 256 + tid] = TOK[(Lu >> 1) * 256 + tid] * 2048; }
    __syncthreads();
}
__device__ __forceinline__ int fresh_lane() { int t = threadIdx.x; asm volatile("" : "+v"(t)); return t & 63; }
__device__ __forceinline__ int fresh_wave() { int t = threadIdx.x; asm volatile("" : "+v"(t)); return __builtin_amdgcn_readfirstlane(t >> 6); }
__global__ void __launch_bounds__(NTHR, 2) mega_fwd(Args args) {
    extern __shared__ __attribute__((aligned(16))) unsigned char lds_raw[];
    LAS unsigned char* lds = (LAS unsigned char*)lds_raw;
    const int tid = threadIdx.x, bid = blockIdx.x, G = gridDim.x;
    { int t0 = threadIdx.x; asm volatile("" : "+v"(t0));
      for (int u = t0; u < (LDS_BYTES - LDSCTL_OFF) / 4; u += NTHR) ((LAS unsigned*)(lds + LDSCTL_OFF))[u] = 0u; }
    __syncthreads();
#if MK_ONE_LAUNCH
    XcdBarrier bar = xcd_barrier_post((unsigned*)(args.ws + WS_CTL) + CW_BAR, (volatile LAS unsigned*)(lds + LDSCTL_OFF) + LC_BAR);
#define GRID_BAR() xcd_barrier(bar)
#else
#define GRID_BAR() do { } while (0)
#endif
    const int lo = args.ph_lo, hi = args.ph_hi;
#define IN(k) (lo <= (k) && (k) < hi)
#define SEAM(k) do { if (IN(k) && IN((k) + 1)) GRID_BAR(); } while (0)
    const Args& a = args;
#define X32 (slotp(a, 4))
#define L1 ((bf16*)(a.ws + WS_L1))
#define te ((const LAS unsigned char*)(lds + LDSCTL_OFF + LC_TILE_B))
#define ntl ((const LAS int*)(lds + LDSCTL_OFF) + LC_NT)

    if (IN(0)) { p0_prologue(a, lds, tid, fresh_lane(), fresh_wave(), bid, G); } SEAM(0);
    if (IN(1)) { p1_modshift(a, fresh_lane(), fresh_wave(), bid, G); } SEAM(1);
    if (IN(2)) {
        pg8::Gemm g{slotp(a, 3), (const bf16*)(a.ws + WS_BT0) + (size_t)3072 * 1024, 1024, 1024}; StackOrder S; S.init(NT, 768, G, bid); S.per = 1;
        pg8::EpiP<F_Lora1> E{{L1}};
        pg8::gemm_phase<pg8::EpiP<F_Lora1>, StackOrder, true, true>(lds, g, S, E);
    } SEAM(2);
    if (IN(3)) {
        pg8::Gemm g{slotp(a, 0), (const bf16*)(a.ws + WS_BT0), 1024, 1024}; StackOrder S; S.init(NT, 3072, G, bid); S.per = 4;
        pg8::EpiP<F_Rkv> E{{slotp(a, 3)}};
        pg8::gemm_phase<pg8::EpiP<F_Rkv>, StackOrder, true, true>(lds, g, S, E);
    } SEAM(3);
#if MK_SCAN_CHUNKED == 2
    if (IN(5)) { p4_scan_v3(a, lds, tid, fresh_lane(), fresh_wave(), bid, G); } SEAM(5);
#elif MK_SCAN_CHUNKED
    if (IN(5)) { p4_scan_chunked(a, lds, tid, fresh_lane(), fresh_wave(), bid, G); } SEAM(5);
#else
    if (IN(5)) { p4_scan(a, lds, tid, fresh_lane(), fresh_wave(), bid, G); } SEAM(5);
#endif
    if (IN(6)) { p5a_groupnorm(a, fresh_lane(), fresh_wave(), bid, G); convert_moe(a, 0, WS_MW0, lds, fresh_wave(), fresh_lane(), bid, G); } SEAM(6);
    if (IN(7)) {
        pg8::Gemm g{L1 + 256, (const bf16*)(a.ws + WS_L2B), 512, 256}; pg8::StaticOrder S; S.init(NT, 1024, G, bid);
        EpiGate E{slotp(a, 6), slotp(a, 0)};
        pg8::gemm_phase<EpiGate, pg8::StaticOrder, true, true>(lds, g, S, E);
    } SEAM(7);
    if (IN(8)) {
        pg8::Gemm g{slotp(a, 0), (const bf16*)(a.ws + WS_WO0), 1024, 1024}; pg8::StaticOrder S; S.init(NT, 1024, G, bid);
        EpiWo0 E{a.in[I_X], a.in[I_CTX], (const float*)(a.ws + WS_MOD), X32};
        pg8::gemm_phase<EpiWo0, pg8::StaticOrder, true, true>(lds, g, S, E);
    } SEAM(8);
    if (IN(9)) { p_router<0>(a, lds, tid, fresh_lane(), fresh_wave(), bid, G); } SEAM(9);
    if (IN(10)) { p_dispatch<0>(a, lds, tid, fresh_lane(), fresh_wave(), bid, G); } SEAM(10);
    if (IN(11)) {
        moe_tables<0>(a, lds, tid);
        moe_gather_table(a, lds, tid, bid, G, *ntl * 2);
        pg8::Gemm g{slotp(a, 6), (const bf16*)(a.ws + WS_MW0), 1024, 1024}; MoeOrder S{te, *ntl * 2, 2, G, bid};
        pg8::EpiP<F_GateUp> E{{(bf16*)(a.ws + WS_HID)}};
        pg8::gemm_phase<pg8::EpiP<F_GateUp>, MoeOrder, true, true, true>(lds, g, S, E);
    } SEAM(11);
    if (IN(12)) {
        moe_tables<0>(a, lds, tid);
        pg8::Gemm g{(const bf16*)(a.ws + WS_HID), (const bf16*)(a.ws + WS_MW0) + (size_t)32 * 512 * 1024, 256, 256}; MoeOrder S{te, *ntl * 4, 4, G, bid};
        pg8::EpiP<F_Down> E{{(bf16*)(a.ws + WS_XS)}};
        pg8::gemm_phase<pg8::EpiP<F_Down>, MoeOrder, true, true>(lds, g, S, E);
    } SEAM(12);
    if (IN(13)) { p11_combine_mod(a, fresh_lane(), fresh_wave(), bid, G); convert_moe(a, 1, WS_MW1, lds, fresh_wave(), fresh_lane(), bid, G); } SEAM(13);
    if (IN(14)) {
        pg8::Gemm g{slotp(a, 6), (const bf16*)(a.ws + WS_WQKV), 1024, 1024}; pg8::StaticOrder S; S.init(NT, 3072, G, bid);
        EpiQKV E{slotp(a, 0), a.in[I_QNG], a.in[I_KNG], (const float*)(a.ws + WS_SW)};
        pg8::gemm_phase<EpiQKV, pg8::StaticOrder, true, true>(lds, g, S, E);
    } SEAM(14);
    if (IN(16)) { p13_attention(a, lds, tid, fresh_lane(), fresh_wave(), bid, G); } SEAM(16);
    if (IN(17)) {
        pg8::Gemm g{slotp(a, 6), (const bf16*)(a.ws + WS_WO1), 1024, 1024}; LatOrder S{G, bid};
        EpiWo1 E{modp(a, 1, 0, 2), X32};
        pg8::gemm_phase<EpiWo1, LatOrder, true, true>(lds, g, S, E);
    } SEAM(17);
    if (IN(18)) { p_router<1>(a, lds, tid, fresh_lane(), fresh_wave(), bid, G); } SEAM(18);
    if (IN(19)) { p_dispatch<1>(a, lds, tid, fresh_lane(), fresh_wave(), bid, G); } SEAM(19);
    if (IN(20)) {
        moe_tables<1>(a, lds, tid);
        moe_gather_table(a, lds, tid, bid, G, *ntl * 2);
        pg8::Gemm g{slotp(a, 6), (const bf16*)(a.ws + WS_MW1), 1024, 1024}; MoeOrder S{te, *ntl * 2, 2, G, bid};
        pg8::EpiP<F_GateUp> E{{(bf16*)(a.ws + WS_HID)}};
        pg8::gemm_phase<pg8::EpiP<F_GateUp>, MoeOrder, true, true, true>(lds, g, S, E);
    } SEAM(20);
    if (IN(21)) {
        moe_tables<1>(a, lds, tid);
        pg8::Gemm g{(const bf16*)(a.ws + WS_HID), (const bf16*)(a.ws + WS_MW1) + (size_t)32 * 512 * 1024, 256, 256}; MoeOrder S{te, *ntl * 4, 4, G, bid};
        pg8::EpiP<F_Down> E{{(bf16*)(a.ws + WS_XS)}};
        pg8::gemm_phase<pg8::EpiP<F_Down>, MoeOrder, true, true>(lds, g, S, E);
    } SEAM(21);
    if (IN(22)) { p19_final(a, fresh_lane(), fresh_wave(), bid, G); }
#undef IN
#undef SEAM
#undef X32
#undef L1
#undef te
#undef ntl
}

extern "C" void kernel_launch(void* const* d_in, const int* in_sizes, int n_in, void* d_out, int out_size, void* d_ws, size_t ws_size, hipStream_t stream) {
    static int grid = 0;
    if (grid == 0) {
        if (n_in != 40 || in_sizes[0] != NLAT * D || out_size != NLAT * D || ws_size < WS_END) {
            fprintf(stderr, "kernel_launch: unexpected shapes (n_in %d, in0 %d, out %d, ws %zu); nothing launched\n", n_in, n_in > 0 ? in_sizes[0] : -1, out_size, ws_size); grid = -1; return; }
        int dev = 0, cus = 0;
        if (hipGetDevice(&dev) != hipSuccess || hipDeviceGetAttribute(&cus, hipDeviceAttributeMultiprocessorCount, dev) != hipSuccess) { grid = -1; return; }
        if (hipFuncSetAttribute((const void*)mega_fwd, hipFuncAttributeMaxDynamicSharedMemorySize, LDS_BYTES) != hipSuccess) { fprintf(stderr, "kernel_launch: hipFuncSetAttribute failed\n"); grid = -1; return; }
        int per_cu = 0;
        if (hipOccupancyMaxActiveBlocksPerMultiprocessor(&per_cu, (const void*)mega_fwd, NTHR, LDS_BYTES) != hipSuccess || per_cu < 1) { fprintf(stderr, "kernel_launch: occupancy query says %d\n", per_cu); }
        (void)hipGetLastError();
        grid = cus < 256 ? cus : 256;
    }
    if (grid < 0) return;
    if (hipMemsetAsync((char*)d_ws + WS_CTL, 0, CTL_ZERO_BYTES, stream) != hipSuccess) return;
    Args a{};
    for (int i = 0; i < 40; ++i) a.in[i] = (const float*)d_in[i];
    a.out = (float*)d_out; a.ws = (unsigned char*)d_ws;
#if MK_ONE_LAUNCH
    a.ph_lo = 0; a.ph_hi = N_PH;
    hipLaunchKernelGGL(mega_fwd, dim3(grid), dim3(NTHR), LDS_BYTES, stream, a);
#else
    for (int p = 0; p < N_PH; ++p) { a.ph_lo = p; a.ph_hi = p + 1; hipLaunchKernelGGL(mega_fwd, dim3(grid), dim3(NTHR), LDS_BYTES, stream, a); }
#endif
}
```

```cpp
#include <hip/hip_runtime.h>
#include <cstdio>
#include <cstdint>

#ifndef MK_SCAN_CHUNKED
#define MK_SCAN_CHUNKED 2
#endif
#ifndef MK_ONE_LAUNCH
#define MK_ONE_LAUNCH 1
#endif
namespace pg8 {
#define PG8_LAS __attribute__((address_space(3)))
typedef unsigned short bf16_t;
typedef short bf16x8 __attribute__((ext_vector_type(8)));
typedef float f32x4 __attribute__((ext_vector_type(4)));
typedef unsigned u32x4 __attribute__((ext_vector_type(4)));
constexpr int BM = 256, BK = 64, HALF = 128, HTB = HALF * BK * 2  , STAGE_BYTES = 8 * HTB, NXCD = 8, WGM = 8;

__host__ __device__ __forceinline__ int lds_byte(int r, int c) { const int st = (r >> 4) * 2 + (c >> 5), rr = r & 15, cc = c & 31, ob = rr * 64 + cc * 2; return st * 1024 + (ob ^ (((ob >> 9) & 1) << 5)); }
__host__ __device__ __forceinline__ void stage_rc(int b, int& R, int& C) { const int st = b / 1024, sb = b % 1024, swz = sb ^ (((sb >> 9) & 1) << 5); R = (st >> 1) * 16 + swz / 64; C = (st & 1) * 32 + (swz % 64) / 2; }
__host__ __device__ __forceinline__ int perm32(int rho) { const int n = rho >> 4, i = rho & 15; return 8 * (i >> 2) + 4 * n + (i & 3); }

struct Unit { int pm, pn; };
struct Gemm { const bf16_t* A; const bf16_t* Bt; int lda, K; };

struct StaticOrder {
    int nM, nN, nwg, G, c;
    __host__ __device__ void init(int M, int N, int G_, int c_) { nM = M / BM; nN = N / BM; nwg = nM * nN; G = G_; c = c_; }
    __host__ __device__ bool next(int i, Unit& u) const {
        const long L = (long)i * G + c; if (L >= nwg) return false;
        int wgid = (int)L; { const int q = nwg / NXCD, r = nwg % NXCD, xcd = wgid % NXCD, off = wgid / NXCD; wgid = (xcd < r ? xcd * (q + 1) : r * (q + 1) + (xcd - r) * q) + off; }
        const int nig = WGM * nN, gid = wgid / nig, fm = gid * WGM, gsz = (nM - fm) < WGM ? (nM - fm) : WGM;
        u.pm = fm + ((wgid % nig) % gsz); u.pn = (wgid % nig) / gsz; return true;
    }
    __device__ __forceinline__ void a_ready(const Unit&) const {}
    __device__ __forceinline__ void done(const Unit&) const {}
};

__device__ __forceinline__ unsigned cvt_pk_bf16(float lo, float hi) { unsigned r; asm volatile("v_cvt_pk_bf16_f32 %0, %1, %2" : "=v"(r) : "v"(lo), "v"(hi)); return r; }
template <class F> struct EpiP {
    static constexpr bool PERM = true, AFTER_DRAIN = false; F f;
    __device__ __forceinline__ void operator()(const f32x4 (&acc)[2][2][4][2], const Unit& u, int wr, int wc, int fr, int fq) const {
        const int row0 = u.pm * BM + wr * 64 + fr, col0 = u.pn * BM + wc * 32 + 8 * fq;
#pragma unroll
        for (int ai = 0; ai < 2; ++ai)
#pragma unroll
            for (int m = 0; m < 4; ++m)
#pragma unroll
                for (int bj = 0; bj < 2; ++bj) f.op(row0 + ai * HALF + m * 16, col0 + bj * HALF, acc[ai][bj][m][0], acc[ai][bj][m][1]);
    }
};
template <class F> struct EpiN {
    static constexpr bool PERM = false, AFTER_DRAIN = false; F f;
    __device__ __forceinline__ void operator()(const f32x4 (&acc)[2][2][4][2], const Unit& u, int wr, int wc, int fr, int fq) const {
        const int row0 = u.pm * BM + wr * 64 + fr, col0 = u.pn * BM + wc * 32 + 4 * fq;
#pragma unroll
        for (int ai = 0; ai < 2; ++ai)
#pragma unroll
            for (int m = 0; m < 4; ++m)
#pragma unroll
                for (int bj = 0; bj < 2; ++bj)
#pragma unroll
                    for (int n = 0; n < 2; ++n) f.op(row0 + ai * HALF + m * 16, col0 + bj * HALF + n * 16, acc[ai][bj][m][n]);
    }
};
template <class Epi, class Sched, bool ALIGN_EPI = false, bool SP2 = false, bool GATHER = false>
__device__ __forceinline__ void gemm_phase(PG8_LAS unsigned char* lds, const Gemm g, const Sched& S, const Epi& E) {
    const int tid = threadIdx.x, wid = __builtin_amdgcn_readfirstlane(tid >> 6), lane = tid & 63, wr = wid >> 2, wc = wid & 3, fr = lane & 15, fq = lane >> 4;
    const int K = g.K, nt = K / BK;
    unsigned voffA[2], voffB[2];
#pragma unroll
    for (int i = 0; i < 2; ++i) { int R, C; stage_rc(tid * 16 + i * 8192, R, C); const int Rb = Epi::PERM ? ((R & ~31) + perm32(R & 31)) : R;
        voffA[i] = (unsigned)(R * g.lda + C) * 2u; voffB[i] = (unsigned)(Rb * K + C) * 2u; }
    const size_t kstep = (size_t)(BK * 2);
    const size_t hstepA = GATHER ? (size_t)0 : (size_t)HALF * g.lda * 2, hstepB = (size_t)HALF * K * 2;
    const size_t tstepA = 2 * hstepA, tstepB = 2 * hstepB;
    unsigned vC[2][2], vN[2][2];
    const PG8_LAS int* gtab = (const PG8_LAS int*)(lds + 131072);
#define PG8_GLOAD(dst, ui_) do { _Pragma("unroll") for (int _h = 0; _h < 2; ++_h) _Pragma("unroll") for (int _i = 0; _i < 2; ++_i) { int R, C; stage_rc(tid * 16 + _i * 8192, R, C); dst[_h][_i] = (unsigned)(gtab[(ui_) * 256 + 128 * _h + R] + C * 2); } } while (0)
#define PG8_STAGE_A(bufoff, gbase, h, nx) do { if constexpr (GATHER) { unsigned _v[2] = {(nx) ? vN[h][0] : vC[h][0], (nx) ? vN[h][1] : vC[h][1]}; PG8_STAGE(bufoff, gbase, _v); } else { PG8_STAGE(bufoff, (gbase) + (h) * hstepA, voffA); } } while (0)
    const unsigned ldsw = (unsigned)wid * 1024u;
    const int aoff = lds_byte(wr * 64 + fr, fq * 8), boff = lds_byte(wc * 32 + fr, fq * 8);
#define PG8_SA(b, h) (((b) * 2 + (h)) * HTB)
#define PG8_SB(b, h) ((4 + (b) * 2 + (h)) * HTB)
#define PG8_STAGE(bufoff, gbase, voff) do { _Pragma("unroll") for (int _i = 0; _i < 2; ++_i) \
        __builtin_amdgcn_global_load_lds((const unsigned*)((const char*)(gbase) + (voff)[_i]), (PG8_LAS unsigned*)(lds + (bufoff) + ldsw + _i * 8192), 16, 0, 0); } while (0)
#define PG8_LDA(dst, b, h) do { _Pragma("unroll") for (int m = 0; m < 4; ++m) _Pragma("unroll") for (int k = 0; k < 2; ++k) dst[m][k] = *(const PG8_LAS bf16x8*)(lds + PG8_SA(b, h) + aoff + m * 2048 + k * 1024); } while (0)
#define PG8_LDB(dst, b, h) do { _Pragma("unroll") for (int n = 0; n < 2; ++n) _Pragma("unroll") for (int k = 0; k < 2; ++k) dst[n][k] = *(const PG8_LAS bf16x8*)(lds + PG8_SB(b, h) + boff + n * 2048 + k * 1024); } while (0)
#define PG8_MMA(ai, bj, At, Bt) do { __builtin_amdgcn_s_setprio(1); _Pragma("unroll") for (int m = 0; m < 4; ++m) _Pragma("unroll") for (int n = 0; n < 2; ++n) _Pragma("unroll") for (int k = 0; k < 2; ++k) \
        acc[ai][bj][m][n] = __builtin_amdgcn_mfma_f32_16x16x32_bf16(Bt[n][k], At[m][k], acc[ai][bj][m][n], 0, 0, 0); __builtin_amdgcn_s_setprio(0); } while (0)
#define PG8_WAIT_V(n) asm volatile("s_waitcnt vmcnt(" #n ")" ::: "memory")
#define PG8_WAIT_L(n) asm volatile("s_waitcnt lgkmcnt(" #n ")" ::: "memory")
#define PG8_BAR __builtin_amdgcn_s_barrier()
#define PG8_SCHED __builtin_amdgcn_sched_barrier(0)
    Unit cur, nxt; int ui = 0;
    if (!S.next(0, cur)) return;
    f32x4 acc[2][2][4][2];
#pragma unroll
    for (int a = 0; a < 2; ++a)
#pragma unroll
        for (int b = 0; b < 2; ++b)
#pragma unroll
            for (int m = 0; m < 4; ++m)
#pragma unroll
                for (int n = 0; n < 2; ++n) acc[a][b][m][n] = (f32x4){0.f, 0.f, 0.f, 0.f};
    bf16x8 At[4][2], B0[2][2], B1[2][2];
    const char* cA = (const char*)g.A + (size_t)cur.pm * tstepA; const char* cB = (const char*)g.Bt + (size_t)cur.pn * tstepB;
    S.a_ready(cur);
    if constexpr (GATHER) { PG8_GLOAD(vC, 0); }
    if constexpr (SP2) {
        PG8_STAGE(PG8_SB(0, 0), cB, voffB); PG8_STAGE(PG8_SB(0, 1), cB + hstepB, voffB); PG8_STAGE_A(PG8_SA(0, 0), cA, 0, false); PG8_STAGE_A(PG8_SA(0, 1), cA, 1, false);
        if (wr == 1) PG8_BAR;
        PG8_WAIT_V(2); PG8_BAR;
        PG8_STAGE(PG8_SB(1, 0), cB + kstep, voffB); PG8_STAGE_A(PG8_SA(1, 0), cA + kstep, 0, false); PG8_STAGE(PG8_SB(1, 1), cB + hstepB + kstep, voffB);
        PG8_WAIT_V(6); PG8_BAR;
    } else {
        PG8_STAGE(PG8_SB(0, 0), cB, voffB); PG8_STAGE(PG8_SA(0, 0), cA, voffA); PG8_STAGE(PG8_SB(0, 1), cB + hstepB, voffB); PG8_STAGE(PG8_SA(0, 1), cA + hstepA, voffA);
        if (wr == 1) PG8_BAR;
        PG8_WAIT_V(4); PG8_BAR;
        PG8_STAGE(PG8_SB(1, 0), cB + kstep, voffB); PG8_STAGE(PG8_SA(1, 0), cA + kstep, voffA); PG8_STAGE(PG8_SB(1, 1), cB + hstepB + kstep, voffB);
        PG8_WAIT_V(6); PG8_BAR;
    }
    for (;;) {
        const bool has_next = S.next(ui + 1, nxt);
        if constexpr (GATHER) { if (has_next) { PG8_GLOAD(vN, ui + 1); } else { vN[0][0] = vC[0][0]; vN[0][1] = vC[0][1]; vN[1][0] = vC[1][0]; vN[1][1] = vC[1][1]; } }
        const char* nA = has_next ? (const char*)g.A + (size_t)nxt.pm * tstepA : cA; const char* nB = has_next ? (const char*)g.Bt + (size_t)nxt.pn * tstepB : cB;
        for (int t = 0; t < nt; t += 2) {
            const bool last = (t == nt - 2);
            const char* a1 = cA + (size_t)(t + 1) * kstep;
            const char* a2 = last ? nA : cA + (size_t)(t + 2) * kstep; const char* b2 = last ? nB : cB + (size_t)(t + 2) * kstep;
            const char* a3 = a2 + kstep; const char* b3 = b2 + kstep;
            if (last && has_next) S.a_ready(nxt);
            if constexpr (SP2) {
            PG8_LDB(B0, 0, 0); PG8_LDB(B1, 0, 1); PG8_SCHED; PG8_LDA(At, 0, 0); PG8_STAGE_A(PG8_SA(1, 1), a1, 1, false);
            PG8_WAIT_V(8); PG8_WAIT_L(0); PG8_BAR; PG8_MMA(0, 0, At, B0); PG8_MMA(0, 1, At, B1); PG8_BAR; PG8_SCHED;
            PG8_LDA(At, 0, 1); PG8_STAGE(PG8_SB(0, 0), b2, voffB); PG8_STAGE(PG8_SB(0, 1), b2 + hstepB, voffB); PG8_STAGE_A(PG8_SA(0, 0), a2, 0, last);
            PG8_WAIT_V(8); PG8_WAIT_L(0); PG8_BAR; PG8_MMA(1, 0, At, B0); PG8_MMA(1, 1, At, B1); PG8_BAR; PG8_SCHED;
            PG8_LDB(B0, 1, 0); PG8_LDB(B1, 1, 1); PG8_SCHED; PG8_LDA(At, 1, 0); PG8_STAGE_A(PG8_SA(0, 1), a2, 1, last);
            PG8_WAIT_V(8); PG8_WAIT_L(0); PG8_BAR; PG8_MMA(0, 0, At, B0); PG8_MMA(0, 1, At, B1); PG8_BAR; PG8_SCHED;
            PG8_LDA(At, 1, 1); PG8_STAGE(PG8_SB(1, 0), b3, voffB); PG8_STAGE(PG8_SB(1, 1), b3 + hstepB, voffB); PG8_STAGE_A(PG8_SA(1, 0), a3, 0, last);
            PG8_WAIT_V(8); PG8_WAIT_L(0); PG8_BAR; PG8_MMA(1, 0, At, B0); PG8_MMA(1, 1, At, B1); PG8_BAR; PG8_SCHED;
            } else {
            PG8_LDB(B0, 0, 0); PG8_SCHED; PG8_LDA(At, 0, 0); PG8_STAGE(PG8_SA(1, 1), a1 + hstepA, voffA);
            PG8_WAIT_L(8); PG8_BAR; PG8_WAIT_L(0); PG8_MMA(0, 0, At, B0); PG8_BAR; PG8_SCHED;
            PG8_LDB(B1, 0, 1); PG8_STAGE(PG8_SB(0, 0), b2, voffB);
            PG8_BAR; PG8_WAIT_L(0); PG8_MMA(0, 1, At, B1); PG8_BAR;
            PG8_LDA(At, 0, 1); PG8_STAGE(PG8_SA(0, 0), a2, voffA);
            PG8_BAR; PG8_WAIT_L(0); PG8_MMA(1, 0, At, B0); PG8_BAR; PG8_SCHED;
            PG8_STAGE(PG8_SB(0, 1), b2 + hstepB, voffB);
            PG8_WAIT_V(6); PG8_BAR; PG8_MMA(1, 1, At, B1); PG8_BAR;
            PG8_LDB(B0, 1, 0); PG8_SCHED; PG8_LDA(At, 1, 0); PG8_STAGE(PG8_SA(0, 1), a2 + hstepA, voffA);
            PG8_WAIT_L(8); PG8_BAR; PG8_WAIT_L(0); PG8_MMA(0, 0, At, B0); PG8_BAR; PG8_SCHED;
            PG8_LDB(B1, 1, 1); PG8_STAGE(PG8_SB(1, 0), b3, voffB);
            PG8_BAR; PG8_WAIT_L(0); PG8_MMA(0, 1, At, B1); PG8_BAR;
            PG8_LDA(At, 1, 1); PG8_STAGE(PG8_SA(1, 0), a3, voffA);
            PG8_BAR; PG8_WAIT_L(0); PG8_MMA(1, 0, At, B0); PG8_BAR; PG8_SCHED;
            PG8_STAGE(PG8_SB(1, 1), b3 + hstepB, voffB);
            PG8_WAIT_V(6); PG8_BAR; PG8_MMA(1, 1, At, B1); PG8_BAR;
            }
        }
        if constexpr (ALIGN_EPI) { if (wr == 0) PG8_BAR; }
        if constexpr (!Epi::AFTER_DRAIN) { E(acc, cur, wr, wc, fr, fq); S.done(cur); }
        if (!has_next) break;
#pragma unroll
        for (int a = 0; a < 2; ++a)
#pragma unroll
            for (int b = 0; b < 2; ++b)
#pragma unroll
                for (int m = 0; m < 4; ++m)
#pragma unroll
                    for (int n = 0; n < 2; ++n) acc[a][b][m][n] = (f32x4){0.f, 0.f, 0.f, 0.f};
        cur = nxt; cA = nA; cB = nB; ++ui;
        if constexpr (GATHER) { vC[0][0] = vN[0][0]; vC[0][1] = vN[0][1]; vC[1][0] = vN[1][0]; vC[1][1] = vN[1][1]; }
        if constexpr (ALIGN_EPI) { if (wr == 1) PG8_BAR; }
    }
    PG8_WAIT_V(0);
    if constexpr (!ALIGN_EPI) { if (wr == 0) PG8_BAR; }
    PG8_BAR;
    if constexpr (Epi::AFTER_DRAIN) { E.fused(acc, cur, wr, wc, fr, fq, lds, wid, lane); S.done(cur); }
#undef PG8_SA
#undef PG8_SB
#undef PG8_STAGE
#undef PG8_STAGE_A
#undef PG8_GLOAD
#undef PG8_LDA
#undef PG8_LDB
#undef PG8_MMA
#undef PG8_WAIT_V
#undef PG8_WAIT_L
#undef PG8_BAR
#undef PG8_SCHED
}
}

constexpr int NWAVES = 8, NTHR = 512;
constexpr int D = 1024, NB = 16, TL = 2048, TC = 256, TT = TL + TC, NT = NB * TT, NLAT = NB * TL;
constexpr int N_PH = 23;
constexpr size_t MiB = 1u << 20;
constexpr size_t US = (size_t)NT * D;
constexpr size_t WS_CTL = 0, CTL_ZERO_BYTES = 1 * MiB;
constexpr size_t WS_MOD = 1 * MiB;
constexpr size_t WS_BT0 = 2 * MiB;
constexpr size_t WS_WO0 = 16 * MiB, WS_WQKV = 18 * MiB, WS_WO1 = 24 * MiB, WS_L2A = 26 * MiB, WS_L2B = 28 * MiB;
constexpr size_t WS_BON = 30 * MiB, WS_INVN = 32 * MiB + 512 * 1024, WS_ROUTE = 35 * MiB, WS_TOKSLOT = 36 * MiB + 512 * 1024, WS_SW = 37 * MiB  , WS_TOK = 37 * MiB + 64 * 1024  , WS_BLKBASE = 37 * MiB + 512 * 1024;
constexpr size_t WS_S0 = 40 * MiB, SLOTB = 72 * MiB;
constexpr size_t WS_L1 = 472 * MiB;
constexpr size_t WS_XS = 40 * MiB, WS_HID = 200 * MiB, WS_MW0 = 240 * MiB, WS_MW1 = 256 * MiB, WS_END = 512 * MiB;
constexpr int MAXSLOT = 81920;
constexpr int CW_TMO = 0, CW_BAR = 4096, CW_CNT = 16384;
constexpr int RING_BYTES = 131072, RW_BYTES = 147456, LDSCTL_OFF = 147456, LDS_BYTES = 147456 + 1024;
constexpr int LC_LCNT = 0, LC_SEG = 32, LC_NT = 64, LC_BAR = 72, LC_TILE_B = 512;

#define GAS __attribute__((address_space(1)))
#define LAS __attribute__((address_space(3)))
typedef unsigned short bf16;
typedef unsigned v4u __attribute__((ext_vector_type(4)));
typedef unsigned v2u __attribute__((ext_vector_type(2)));
typedef float f32x4 __attribute__((ext_vector_type(4)));
#define RLX_AGENT __ATOMIC_RELAXED, __HIP_MEMORY_SCOPE_AGENT
#define LDS_WAIT() asm volatile("s_waitcnt lgkmcnt(0)" ::: "memory")
#define VM_WAIT() asm volatile("s_waitcnt vmcnt(0)" ::: "memory")

__device__ __forceinline__ unsigned f2bf(float f) { unsigned u = __builtin_bit_cast(unsigned, f); return (u + 0x7fffu + ((u >> 16) & 1u)) >> 16; }
__device__ __forceinline__ unsigned pk2(float lo, float hi) { return f2bf(lo) | (f2bf(hi) << 16); }
typedef float f32x2_t __attribute__((ext_vector_type(2)));
typedef __bf16 bf16x2_t __attribute__((ext_vector_type(2)));
__device__ __forceinline__ unsigned pk2hw(float lo, float hi) { const f32x2_t v = {lo, hi}; const bf16x2_t b = __builtin_convertvector(v, bf16x2_t); return __builtin_bit_cast(unsigned, b); }
__device__ __forceinline__ unsigned f2bfhw(float f) { return pk2hw(f, 0.f) & 0xffffu; }
__device__ __forceinline__ float bflo(unsigned w) { return __builtin_bit_cast(float, w << 16); }
__device__ __forceinline__ float bfhi(unsigned w) { return __builtin_bit_cast(float, w & 0xffff0000u); }
__device__ __forceinline__ void unpack8(v4u w, float (&f)[8]) { f[0] = bflo(w.x); f[1] = bfhi(w.x); f[2] = bflo(w.y); f[3] = bfhi(w.y); f[4] = bflo(w.z); f[5] = bfhi(w.z); f[6] = bflo(w.w); f[7] = bfhi(w.w); }
__device__ __forceinline__ v4u pack8(const float (&f)[8]) { v4u w; w.x = pk2(f[0], f[1]); w.y = pk2(f[2], f[3]); w.z = pk2(f[4], f[5]); w.w = pk2(f[6], f[7]); return w; }
__device__ __forceinline__ float fexp(float x) { return __expf(x); }
__device__ __forceinline__ float frcp(float x) { return __builtin_amdgcn_rcpf(x); }
__device__ __forceinline__ float fsigmoid(float x) { return frcp(1.f + fexp(-x)); }
__device__ __forceinline__ float ftanh(float x) { return 1.f - 2.f * frcp(1.f + fexp(2.f * x)); }
template <int CTRL, int ROWMASK> __device__ __forceinline__ float dpp_get(float v) { return __builtin_bit_cast(float, __builtin_amdgcn_update_dpp(0, __builtin_bit_cast(int, v), CTRL, ROWMASK, 0xf, false)); }
__device__ __forceinline__ float wave_sum(float v) {
    v += dpp_get<0xB1, 0xf>(v);
    v += dpp_get<0x4E, 0xf>(v);
    v += dpp_get<0x141, 0xf>(v);
    v += dpp_get<0x140, 0xf>(v);
    v += dpp_get<0x142, 0xa>(v);
    v += dpp_get<0x143, 0xc>(v);
    return __builtin_bit_cast(float, __builtin_amdgcn_readlane(__builtin_bit_cast(int, v), 63));
}
template <int N> __device__ __forceinline__ void wave_sum_n(float (&v)[N]) {
#pragma unroll
    for (int i = 0; i < N; ++i) v[i] += dpp_get<0xB1, 0xf>(v[i]);
#pragma unroll
    for (int i = 0; i < N; ++i) v[i] += dpp_get<0x4E, 0xf>(v[i]);
#pragma unroll
    for (int i = 0; i < N; ++i) v[i] += dpp_get<0x141, 0xf>(v[i]);
#pragma unroll
    for (int i = 0; i < N; ++i) v[i] += dpp_get<0x140, 0xf>(v[i]);
#pragma unroll
    for (int i = 0; i < N; ++i) v[i] += dpp_get<0x142, 0xa>(v[i]);
#pragma unroll
    for (int i = 0; i < N; ++i) v[i] += dpp_get<0x143, 0xc>(v[i]);
#pragma unroll
    for (int i = 0; i < N; ++i) v[i] = __builtin_bit_cast(float, __builtin_amdgcn_readlane(__builtin_bit_cast(int, v[i]), 63));
}
__device__ __forceinline__ float rows4_sum(float x) {
    float p = x, q = x;
    asm volatile("s_nop 1\n\tv_permlane16_swap_b32 %0, %1\n\ts_nop 1" : "+v"(p), "+v"(q));
    const float s1 = p + q; p = s1; q = s1;
    asm volatile("s_nop 1\n\tv_permlane32_swap_b32 %0, %1\n\ts_nop 1" : "+v"(p), "+v"(q));
    return p + q;
}
__device__ __forceinline__ float quad_sum(float v) { v += __shfl_xor(v, 1); v += __shfl_xor(v, 2); return v; }

struct Args { const float* in[40]; float* out; unsigned char* ws; int ph_lo, ph_hi; };

enum { I_X = 0, I_C, I_CTX, I_CCTX, I_N1G, I_N2G, I_WMOD, I_BMOD, I_MU, I_WRKV, I_W0, I_W1, I_W2, I_A0, I_A1, I_A2, I_G1, I_G2, I_KK, I_KA, I_RK, I_LNG, I_LNB, I_RWO,
       I_QKV, I_QNG, I_KNG, I_LQ1, I_LK1, I_LQ2, I_LK2, I_SUBG, I_DWO, I_RG, I_RGB, I_RE, I_REB, I_MG, I_MU_, I_MD };

__device__ __forceinline__ const float* in_row(const Args& a, int row) {
    const int b = row / TT, t = row - b * TT;
    return t < TC ? a.in[I_CTX] + ((size_t)b * TC + t) * D : a.in[I_X] + ((size_t)b * TL + (t - TC)) * D;
}
__device__ __forceinline__ int mod_row(int row) { const int b = row / TT, t = row - b * TT; return t < TC ? 16 : b; }
__device__ __forceinline__ const float* modp(const Args& a, int layer, int mrow, int chunk) { return (const float*)(a.ws + WS_MOD) + ((size_t)(layer * 17 + mrow) * 6 + chunk) * D; }
__device__ __forceinline__ bf16* slotp(const Args& a, int k) { return k < 6 ? (bf16*)(a.ws + WS_S0 + (size_t)k * SLOTB) : (bf16*)a.out; }
__device__ __forceinline__ int lat_row(int lr) { return (lr >> 11) * TT + TC + (lr & 2047); }
#define XB_TMO      128
#define XB_XCNT(j)  (256  + 64 * (j))
#define XB_XSUB(j)  (1280 + 64 * (j))
#define XB_XGEN(j)  (2304 + 64 * (j))
#define XB_TOP      3328
#define XB_TOPGEN   3392
#define XCD_BAR_WORDS 3456
#define XB_SPIN_CAP (1u << 22)

__device__ __forceinline__ unsigned xb_ld(unsigned* p)              { return __hip_atomic_load(p, __ATOMIC_RELAXED, __HIP_MEMORY_SCOPE_AGENT); }
__device__ __forceinline__ unsigned xb_add(unsigned* p, unsigned v) { return __hip_atomic_fetch_add(p, v, __ATOMIC_RELAXED, __HIP_MEMORY_SCOPE_AGENT); }
__device__ __forceinline__ unsigned xb_xcc_id() { return (unsigned)__builtin_amdgcn_s_getreg((3 << 11) | 20) & 0xFu; }
#define XB_SPIN(cond, bar) do { unsigned _sp = 0; while (cond) { __builtin_amdgcn_s_sleep(1); \
    if ((++_sp & 255u) == 0u) { if (xb_ld(&(bar)[XB_TMO])) break; if (_sp > XB_SPIN_CAP) { atomicAdd(&(bar)[XB_TMO], 1u); break; } } } } while (0)

struct XcdBarrier {
    unsigned* bar; unsigned x;
    volatile LAS unsigned* st;
};

__device__ __forceinline__ XcdBarrier xcd_barrier_post(unsigned* bar, volatile LAS unsigned* st) {
    XcdBarrier b; b.bar = bar; b.x = xb_xcc_id(); b.st = st;
    if (threadIdx.x == 0) (void)xb_add(&bar[XB_XCNT(b.x)], 1u);
    return b;
}
__device__ __forceinline__ void xcd_barrier_complete(unsigned* bar, unsigned x, unsigned& nloc, unsigned& nx) {
    const unsigned G = gridDim.x * gridDim.y * gridDim.z;
    unsigned sum, cnt, mine, sp = 0u;
    for (;;) {
        sum = 0u; cnt = 0u; mine = 0u;
#pragma unroll
        for (unsigned j = 0; j < 16; ++j) { const unsigned c = xb_ld(&bar[XB_XCNT(j)]); sum += c; cnt += (c > 0u) ? 1u : 0u; mine = (j == x) ? c : mine; }
        if (sum == G) break;
        __builtin_amdgcn_s_sleep(1);
        if ((++sp & 255u) == 0u) { if (xb_ld(&bar[XB_TMO])) break; if (sp > XB_SPIN_CAP) { atomicAdd(&bar[XB_TMO], 1u); break; } }
    }
    nloc = mine > 0u ? mine : 1u; nx = cnt > 0u ? cnt : 1u;
}

__device__ __forceinline__ void xcd_barrier(const XcdBarrier& b) {
    asm volatile("s_waitcnt vmcnt(0)" ::: "memory");
    __syncthreads();
    if (threadIdx.x == 0) {
        unsigned* bar = b.bar;
        __builtin_amdgcn_s_waitcnt(0);
        unsigned nloc = b.st[0], nx = b.st[1];
        if (nloc == 0u) { xcd_barrier_complete(bar, b.x, nloc, nx); b.st[0] = nloc; b.st[1] = nx; }
        const unsigned old = xb_add(&bar[XB_XSUB(b.x)], 1u);
        const unsigned gen = old / nloc;
        if (old + 1u == (gen + 1u) * nloc) {
            __builtin_amdgcn_fence(__ATOMIC_RELEASE, "agent");
            asm volatile("s_waitcnt vmcnt(0)" ::: "memory");
            const unsigned og = xb_add(&bar[XB_TOP], 1u);
            const unsigned tg = og / nx;
            if (og + 1u == (tg + 1u) * nx) xb_add(&bar[XB_TOPGEN], 1u);
            else XB_SPIN(xb_ld(&bar[XB_TOPGEN]) == tg, bar);
            __builtin_amdgcn_fence(__ATOMIC_ACQUIRE, "agent");
            xb_add(&bar[XB_XGEN(b.x)], 1u);
            asm volatile("s_waitcnt vmcnt(0)" ::: "memory");
        } else {
            XB_SPIN(xb_ld(&bar[XB_XGEN(b.x)]) == gen, bar);
            __builtin_amdgcn_fence(__ATOMIC_ACQUIRE, "agent");
            asm volatile("s_waitcnt vmcnt(0)" ::: "memory");
        }
    }
    __syncthreads();
}

__device__ __forceinline__ void tr_item(const float* W, int N, bf16* WT, int ldt, int row_off, int col_off, const float* ksc, int mode, LAS float* scr, int item, int lane) {
    const int nblk = N >> 5, kb = item / nblk, nb = item - kb * nblk, k0 = 64 * kb, n0 = 32 * nb;
    float tv[32];
#pragma unroll
    for (int i = 0; i < 32; ++i) { const int kk = 2 * i + (lane >> 5); tv[i] = W[(size_t)(k0 + kk) * N + n0 + (lane & 31)]; }
#pragma unroll
    for (int i = 0; i < 32; ++i) { const int kk = 2 * i + (lane >> 5); float v = tv[i]; if (ksc) v *= ksc[k0 + kk]; scr[kk * 33 + (lane & 31)] = v; }
    LDS_WAIT(); asm volatile("" ::: "memory");
    const int c = lane & 7;
#pragma unroll
    for (int j = 0; j < 4; ++j) { const int n = (lane >> 3) + 8 * j; const LAS float* s = scr + (8 * c) * 33 + n;
        v4u o; o.x = pk2(s[0 * 33], s[1 * 33]); o.y = pk2(s[2 * 33], s[3 * 33]); o.z = pk2(s[4 * 33], s[5 * 33]); o.w = pk2(s[6 * 33], s[7 * 33]);
        const int nn = n0 + n; const int drow = (mode == 0) ? nn : (mode == 3) ? ((nn >= 2048) ? nn : ((nn & ~255) + 128 * ((nn >> 4) & 1) + 32 * ((nn >> 6) & 3) + 16 * ((nn >> 5) & 1) + (nn & 15))) : ((nn >> 2) * 8 + (nn & 3) + (mode == 2 ? 4 : 0));
        *(GAS v4u*)(WT + (size_t)(row_off + drow) * ldt + col_off + k0 + 8 * c) = o; }
    LDS_WAIT(); asm volatile("" ::: "memory");
}
__device__ __forceinline__ void run_tr(int& base, const float* W, int K, int N, bf16* WT, int ldt, int row_off, int col_off, const float* ksc, int mode, LAS float* scr, int gw, int NGW, int lane) {
    const int nitems = (K >> 6) * (N >> 5);
    int it = gw - (base % NGW); if (it < 0) it += NGW;
    for (; it < nitems; it += NGW) tr_item(W, N, WT, ldt, row_off, col_off, ksc, mode, scr, it, lane);
    base += nitems;
}
__device__ __forceinline__ void zero_rect(bf16* base, int ld, int r0, int nr, int c0, int nc, int gt, int NGT) {
    const int cpr = nc >> 3, total = nr * cpr;
    for (int i = gt; i < total; i += NGT) { const int r = i / cpr, c = i - r * cpr; *(GAS v4u*)(base + (size_t)(r0 + r) * ld + c0 + 8 * c) = (v4u){0u, 0u, 0u, 0u}; }
}
__device__ __forceinline__ void convert_moe(const Args& a, int layer, size_t ws_off, LAS unsigned char* lds, int wave, int lane, int bid, int G) {
    LAS float* scr = (LAS float*)(lds + wave * 16384);
    const int gw = bid * NWAVES + wave, NGW = G * NWAVES; int base = 0;
    bf16* Wgu = (bf16*)(a.ws + ws_off); bf16* Wd = Wgu + (size_t)32 * 512 * 1024;
    for (int e = 0; e < 32; ++e) {
        const size_t eo = (size_t)(layer * 32 + e) * 1024 * 256;
        run_tr(base, a.in[I_MG] + eo, 1024, 256, Wgu + (size_t)e * 512 * 1024, 1024, 0, 0, nullptr, 1, scr, gw, NGW, lane);
        run_tr(base, a.in[I_MU_] + eo, 1024, 256, Wgu + (size_t)e * 512 * 1024, 1024, 0, 0, nullptr, 2, scr, gw, NGW, lane);
        run_tr(base, a.in[I_MD] + eo, 256, 1024, Wd + (size_t)e * 1024 * 256, 256, 0, 0, nullptr, 0, scr, gw, NGW, lane);
    }
}

__device__ __forceinline__ void p0_prologue(const Args& a, LAS unsigned char* lds, int tid, int lane, int wave, int bid, int G) {
    LAS float* sil = (LAS float*)lds;
    LAS float* part = (LAS float*)(lds + 69632);
    float* MOD = (float*)(a.ws + WS_MOD);
    for (int item = bid; item < 192; item += G) {
        const int l = item / 96, n0 = (item - l * 96) * 64;
        { float cv[34];
#pragma unroll
          for (int q = 0; q < 34; ++q) { const int i = tid + NTHR * q, r = q >> 1, k = i & 1023; cv[q] = (r < 16) ? a.in[I_C][r * 1024 + k] : a.in[I_CCTX][k]; }
#pragma unroll
          for (int q = 0; q < 34; ++q) sil[tid + NTHR * q] = cv[q] / (1.f + expf(-cv[q])); }
        __syncthreads();
        f32x4 acc[17];
#pragma unroll
        for (int r = 0; r < 17; ++r) acc[r] = (f32x4){0.f, 0.f, 0.f, 0.f};
        const int cq = lane & 15, kp = lane >> 4;
        const float* wm = a.in[I_WMOD] + (size_t)l * D * 6144 + n0 + 4 * cq;
#pragma unroll 1
        for (int jb = 0; jb < 4; ++jb) { f32x4 wv[2][4];
#pragma unroll
            for (int jj = 0; jj < 2; ++jj)
#pragma unroll
                for (int i = 0; i < 4; ++i) wv[jj][i] = *(const GAS f32x4*)(wm + (size_t)(128 * wave + 16 * (2 * jb + jj) + 4 * kp + i) * 6144);
#pragma unroll
            for (int jj = 0; jj < 2; ++jj) { const int k = 128 * wave + 16 * (2 * jb + jj) + 4 * kp;
#pragma unroll
                for (int r = 0; r < 17; ++r) { const f32x4 sv = *(const LAS f32x4*)(sil + r * 1024 + k); acc[r] += (wv[jj][0] * sv.x + wv[jj][1] * sv.y) + (wv[jj][2] * sv.z + wv[jj][3] * sv.w); } } }
#pragma unroll
        for (int r = 0; r < 17; ++r) {
#pragma unroll
            for (int c = 0; c < 4; ++c) { float v = acc[r][c]; v += __shfl_xor(v, 16); v += __shfl_xor(v, 32); acc[r][c] = v; }
            if (kp == 0) *(LAS f32x4*)(part + (wave * 17 + r) * 64 + 4 * cq) = acc[r]; }
        __syncthreads();
        for (int i = tid; i < 17 * 64; i += NTHR) { const int r = i >> 6, ln = i & 63; float s = 0.f;
#pragma unroll
            for (int w = 0; w < 8; ++w) s += part[(w * 17 + r) * 64 + ln];
            MOD[(size_t)(l * 17 + r) * 6144 + n0 + ln] = s + a.in[I_BMOD][l * 6144 + n0 + ln]; }
        __syncthreads();
    }
    LAS float* scr = (LAS float*)(lds + wave * 16384);
    const int gw = bid * NWAVES + wave, NGW = G * NWAVES; int base = 0;
    bf16* BT0 = (bf16*)(a.ws + WS_BT0);
    bf16* BLO = BT0 + (size_t)3072 * 1024;
    for (int j = 0; j < 3; ++j) run_tr(base, a.in[I_WRKV] + (size_t)j * D * D, 1024, 1024, BT0, 1024, j * 1024, 0, nullptr, 0, scr, gw, NGW, lane);
    for (int z = 0; z < 2; ++z) {
        run_tr(base, a.in[I_W1] + (size_t)z * D * 64, 1024, 64, BLO, 1024, 64 * z, 0, nullptr, 0, scr, gw, NGW, lane);
        run_tr(base, a.in[I_A1] + (size_t)z * D * 64, 1024, 64, BLO, 1024, 256 + 64 * z, 0, nullptr, 0, scr, gw, NGW, lane);
    }
    run_tr(base, a.in[I_G1], 1024, 128, BLO, 1024, 512, 0, nullptr, 0, scr, gw, NGW, lane);
    run_tr(base, a.in[I_RWO], 1024, 1024, (bf16*)(a.ws + WS_WO0), 1024, 0, 0, nullptr, 0, scr, gw, NGW, lane);
    run_tr(base, a.in[I_QKV], 1024, 3072, (bf16*)(a.ws + WS_WQKV), 1024, 0, 0, nullptr, 3, scr, gw, NGW, lane);
    run_tr(base, a.in[I_DWO], 1024, 1024, (bf16*)(a.ws + WS_WO1), 1024, 0, 0, nullptr, 0, scr, gw, NGW, lane);
    bf16* L2A = (bf16*)(a.ws + WS_L2A); bf16* L2B = (bf16*)(a.ws + WS_L2B);
    for (int z = 0; z < 2; ++z) {
        run_tr(base, a.in[I_W2] + (size_t)z * 64 * D, 64, 1024, L2A, 256, z * 1024, z * 64, nullptr, 0, scr, gw, NGW, lane);
        run_tr(base, a.in[I_A2] + (size_t)z * 64 * D, 64, 1024, L2A, 256, 2048 + z * 1024, 128 + z * 64, nullptr, 0, scr, gw, NGW, lane);
    }
    run_tr(base, a.in[I_G2], 128, 1024, L2B, 256, 0, 0, nullptr, 0, scr, gw, NGW, lane);
    const int gt = bid * NTHR + tid, NGT = G * NTHR;
    for (int i = gt; i < 64 * 16; i += NGT) { const int pos = i >> 4, f = i & 15; const float ang = (float)pos * exp2f(-(float)f * (13.287712379549449f / 16.f));
        float* R = (float*)(a.ws + WS_SW) + pos * 32 + (f >> 3) * 16 + (f & 7); R[0] = __cosf(ang); R[8] = __sinf(ang); }
    zero_rect(BLO, 1024, 128, 128, 0, 1024, gt, NGT); zero_rect(BLO, 1024, 384, 128, 0, 1024, gt, NGT); zero_rect(BLO, 1024, 640, 128, 0, 1024, gt, NGT);
    zero_rect(L2A, 256, 0, 1024, 64, 192, gt, NGT);
    zero_rect(L2A, 256, 1024, 1024, 0, 64, gt, NGT);  zero_rect(L2A, 256, 1024, 1024, 128, 128, gt, NGT);
    zero_rect(L2A, 256, 2048, 1024, 0, 128, gt, NGT); zero_rect(L2A, 256, 2048, 1024, 192, 64, gt, NGT);
    zero_rect(L2A, 256, 3072, 1024, 0, 192, gt, NGT);
    zero_rect(L2B, 256, 0, 1024, 128, 128, gt, NGT);
}

__device__ __forceinline__ int colb(int lane, int j) { return 8 * lane + 512 * (j >> 1) + 4 * (j & 1); }
__device__ __forceinline__ void ld_row_bf(const bf16* row, int lane, v2u (&x)[4]) {
#pragma unroll
    for (int jj = 0; jj < 2; ++jj) { const v4u t = *(const GAS v4u*)(row + 8 * lane + 512 * jj); x[2 * jj] = (v2u){t.x, t.y}; x[2 * jj + 1] = (v2u){t.z, t.w}; } }
__device__ __forceinline__ void st_row_bf(bf16* row, int lane, const v2u (&x)[4]) {
#pragma unroll
    for (int jj = 0; jj < 2; ++jj) { v4u t; t.x = x[2 * jj].x; t.y = x[2 * jj].y; t.z = x[2 * jj + 1].x; t.w = x[2 * jj + 1].y; *(GAS v4u*)(row + 8 * lane + 512 * jj) = t; } }
__device__ __forceinline__ void modulate_row(const float* xr, const float* g, const float* sh, const float* sc, int lane, f32x4 (&h)[4]) {
    f32x4 v[4]; float ss = 0.f;
#pragma unroll
    for (int j = 0; j < 4; ++j) { v[j] = *(const GAS f32x4*)(xr + colb(lane, j)); ss += (v[j].x * v[j].x + v[j].y * v[j].y) + (v[j].z * v[j].z + v[j].w * v[j].w); }
    const float rstd = rsqrtf(wave_sum(ss) * (1.f / D) + 1e-6f);
#pragma unroll
    for (int j = 0; j < 4; ++j) { const int c = colb(lane, j); const f32x4 gv = *(const GAS f32x4*)(g + c), sv = *(const GAS f32x4*)(sc + c), hv = *(const GAS f32x4*)(sh + c);
        h[j] = (v[j] * rstd) * gv * (sv + 1.f) + hv; }
}
__device__ __forceinline__ f32x4 ld4bf(const bf16* p) { const v2u y = *(const GAS v2u*)p; return (f32x4){bflo(y.x), bfhi(y.x), bflo(y.y), bfhi(y.y)}; }
__device__ __forceinline__ void modulate_row_bf(const bf16* xr, const float* g, const float* sh, const float* sc, int lane, f32x4 (&h)[4]) {
    f32x4 v[4]; float ss = 0.f;
    v2u xb_[4]; ld_row_bf(xr, lane, xb_);
#pragma unroll
    for (int j = 0; j < 4; ++j) { v[j] = (f32x4){bflo(xb_[j].x), bfhi(xb_[j].x), bflo(xb_[j].y), bfhi(xb_[j].y)}; ss += (v[j].x * v[j].x + v[j].y * v[j].y) + (v[j].z * v[j].z + v[j].w * v[j].w); }
    const float rstd = rsqrtf(wave_sum(ss) * (1.f / D) + 1e-6f);
#pragma unroll
    for (int j = 0; j < 4; ++j) { const int c = colb(lane, j); const f32x4 gv = *(const GAS f32x4*)(g + c), sv = *(const GAS f32x4*)(sc + c), hv = *(const GAS f32x4*)(sh + c);
        h[j] = (v[j] * rstd) * gv * (sv + 1.f) + hv; }
}
__device__ __forceinline__ void store_row_bf16(bf16* dst, int lane, const f32x4 (&h)[4]) {
#pragma unroll
    for (int jj = 0; jj < 2; ++jj) { v4u o; o.x = pk2hw(h[2 * jj].x, h[2 * jj].y); o.y = pk2hw(h[2 * jj].z, h[2 * jj].w); o.z = pk2hw(h[2 * jj + 1].x, h[2 * jj + 1].y); o.w = pk2hw(h[2 * jj + 1].z, h[2 * jj + 1].w); *(GAS v4u*)(dst + 8 * lane + 512 * jj) = o; }
}
__device__ __forceinline__ void h_l0(const Args& a, int row, int lane, f32x4 (&h)[4]) {
    const int mr = mod_row(row); modulate_row(in_row(a, row), a.in[I_N1G], modp(a, 0, mr, 0), modp(a, 0, mr, 1), lane, h);
}
__device__ __forceinline__ void p1_h(const Args& a, int row, int lane, int& cmr, f32x4 (&gg)[4], f32x4 (&hh)[4], f32x4 (&h)[4]) {
    const float* xr = in_row(a, row); f32x4 v[4]; float ss = 0.f;
#pragma unroll
    for (int j = 0; j < 4; ++j) { v[j] = *(const GAS f32x4*)(xr + colb(lane, j)); ss += (v[j].x * v[j].x + v[j].y * v[j].y) + (v[j].z * v[j].z + v[j].w * v[j].w); }
    const int mr = mod_row(row);
    if (mr != cmr) { cmr = mr; const float* g = a.in[I_N1G]; const float* sh = modp(a, 0, mr, 0); const float* sc = modp(a, 0, mr, 1);
#pragma unroll
        for (int j = 0; j < 4; ++j) { const int c = colb(lane, j); gg[j] = *(const GAS f32x4*)(g + c) * (*(const GAS f32x4*)(sc + c) + 1.f); hh[j] = *(const GAS f32x4*)(sh + c); } }
    const float rstd = rsqrtf(wave_sum(ss) * (1.f / D) + 1e-6f);
#pragma unroll
    for (int j = 0; j < 4; ++j) h[j] = (v[j] * rstd) * gg[j] + hh[j];
}
__device__ __forceinline__ void p1_modshift(const Args& a, int lane, int wave, int bid, int G) {
    const int NGW = G * NWAVES, gw = bid * NWAVES + wave, rpw = (NT + NGW - 1) / NGW, first = gw * rpw, last = (first + rpw < NT) ? first + rpw : NT;
    if (first >= NT) return;
    f32x4 mu[6][4];
#pragma unroll
    for (int m = 0; m < 6; ++m)
#pragma unroll
        for (int j = 0; j < 4; ++j) mu[m][j] = *(const GAS f32x4*)(a.in[I_MU] + m * D + colb(lane, j));
    f32x4 hp[4], hc[4], hn[4], mgg[4], mhh[4]; int cmr = -1;
#pragma unroll
    for (int j = 0; j < 4; ++j) hp[j] = (f32x4){0.f, 0.f, 0.f, 0.f};
    if (first > 0) p1_h(a, first - 1, lane, cmr, mgg, mhh, hp);
    p1_h(a, first, lane, cmr, mgg, mhh, hc);
    for (int row = first; row < last; ++row) {
        const int t = row % TT;
#pragma unroll
        for (int j = 0; j < 4; ++j) hn[j] = (f32x4){0.f, 0.f, 0.f, 0.f};
        if (row + 1 < NT) p1_h(a, row + 1, lane, cmr, mgg, mhh, hn);
        const float lv = (t != 0 && t != TC) ? 0.5f : 0.f, rv = (t != TC - 1 && t != TT - 1) ? 0.5f : 0.f;
        f32x4 dx[4];
#pragma unroll
        for (int j = 0; j < 4; ++j) dx[j] = hp[j] * lv + hn[j] * rv - hc[j];
#pragma unroll
        for (int m = 0; m < 6; ++m) {
            f32x4 mx[4];
#pragma unroll
            for (int j = 0; j < 4; ++j) mx[j] = hc[j] + dx[j] * mu[m][j];
            store_row_bf16(slotp(a, m) + (size_t)row * D, lane, mx);
        }
#pragma unroll
        for (int j = 0; j < 4; ++j) { hp[j] = hc[j]; hc[j] = hn[j]; }
    }
}

__device__ __forceinline__ void load16(const bf16* p, float (&f)[16]) {
    const v4u a = *(const GAS v4u*)p, b = *(const GAS v4u*)(p + 8);
    f[0] = bflo(a.x); f[1] = bfhi(a.x); f[2] = bflo(a.y); f[3] = bfhi(a.y); f[4] = bflo(a.z); f[5] = bfhi(a.z); f[6] = bflo(a.w); f[7] = bfhi(a.w);
    f[8] = bflo(b.x); f[9] = bfhi(b.x); f[10] = bflo(b.y); f[11] = bfhi(b.y); f[12] = bflo(b.z); f[13] = bfhi(b.z); f[14] = bflo(b.w); f[15] = bfhi(b.w);
}
__device__ __forceinline__ void store16(bf16* p, const float (&f)[16]) {
    v4u a, b; a.x = pk2(f[0], f[1]); a.y = pk2(f[2], f[3]); a.z = pk2(f[4], f[5]); a.w = pk2(f[6], f[7]);
    b.x = pk2(f[8], f[9]); b.y = pk2(f[10], f[11]); b.z = pk2(f[12], f[13]); b.w = pk2(f[14], f[15]);
    *(GAS v4u*)p = a; *(GAS v4u*)(p + 8) = b;
}
__device__ __forceinline__ void p3b_invn_bonus(const Args& a, int lane, int wave, int bid, int G) {
    const bf16 *R = slotp(a, 2), *K = slotp(a, 3), *A0 = slotp(a, 0), *A1 = slotp(a, 1);
    float* BON = (float*)(a.ws + WS_BON); float* INVN = (float*)(a.ws + WS_INVN);
    float kkc[16], kac[16], rkc[16];
#pragma unroll
    for (int e = 0; e < 16; ++e) { kkc[e] = a.in[I_KK][16 * lane + e]; kac[e] = a.in[I_KA][16 * lane + e]; rkc[e] = a.in[I_RK][16 * lane + e]; }
    const int NGW = G * NWAVES;
    for (int row = bid * NWAVES + wave; row < NT; row += NGW) {
        const size_t o = (size_t)row * D + 16 * lane;
        float r[16], k[16], a0[16], a1[16];
        load16(R + o, r); load16(K + o, k); load16(A0 + o, a0); load16(A1 + o, a1);
        float ss = 0.f, bn = 0.f;
#pragma unroll
        for (int e = 0; e < 16; ++e) { const float kf = k[e] * kkc[e]; ss += kf * kf;
            bn += r[e] * rkc[e] * k[e] * ((1.f + (a0[e] - 1.f) * kac[e]) + (1.f + (a1[e] - 1.f) * kac[e])); }
        ss = quad_sum(ss); bn = quad_sum(bn);
        if ((lane & 3) == 0) { INVN[row * 16 + (lane >> 2)] = rsqrtf(ss + 1e-12f); BON[row * 16 + (lane >> 2)] = bn; }
    }
}
__device__ __forceinline__ int scan_row(int z, int b, int sg) { const int t = (z == 0) ? sg : (sg < TC ? TC - 1 - sg : TT + TC - 1 - sg); return b * TT + t; }
__device__ __forceinline__ float afma(float a, float b, float c) { float d; asm("v_fma_f32 %0, %1, %2, %3" : "=v"(d) : "v"(a), "v"(b), "v"(c)); return d; }
__device__ __forceinline__ float amul(float a, float b) { float d; asm("v_mul_f32 %0, %1, %2" : "=v"(d) : "v"(a), "v"(b)); return d; }
#define ROWSUM4_STAGE(N) asm volatile("s_nop 1\n\tv_add_f32_dpp %0, %0, %0 row_ror:" #N " row_mask:0xf bank_mask:0xf\n\tv_add_f32_dpp %1, %1, %1 row_ror:" #N " row_mask:0xf bank_mask:0xf\n\t" \
    "v_add_f32_dpp %2, %2, %2 row_ror:" #N " row_mask:0xf bank_mask:0xf\n\tv_add_f32_dpp %3, %3, %3 row_ror:" #N " row_mask:0xf bank_mask:0xf" : "+v"(a), "+v"(b), "+v"(c), "+v"(d))
__device__ __forceinline__ void row_sum16x4(float& a, float& b, float& c, float& d) { ROWSUM4_STAGE(8); ROWSUM4_STAGE(4); ROWSUM4_STAGE(2); ROWSUM4_STAGE(1); }
template <int N> __device__ __forceinline__ float row_ror(float v) { return __builtin_bit_cast(float, __builtin_amdgcn_update_dpp(0, __builtin_bit_cast(int, v), 0x120 + N, 0xf, 0xf, false)); }
__device__ __forceinline__ float row_sum16(float v) { v += row_ror<8>(v); v += row_ror<4>(v); v += row_ror<2>(v); v += row_ror<1>(v); return v; }
__device__ __forceinline__ void p4_scan(const Args& a, LAS unsigned char* lds, int tid, int lane, int wave, int bid, int G) {
    const bf16 *R = slotp(a, 2), *K = slotp(a, 3), *V = slotp(a, 4);
    const float* INVN = (const float*)(a.ws + WS_INVN);
    constexpr int NCH = TT / 16;
    const int sc = tid >> 8, ss = (tid >> 4) & 15, g4 = tid & 15;
    const int wc = wave >> 2, wq = wave & 3, ig = lane >> 4, jg = lane & 15;
    for (int pair = bid; pair < 256; pair += G) {
        const int cid = pair * 2 + sc, z = cid >> 8, b = (cid >> 4) & 15, h = cid & 15;
        const bf16* Az = slotp(a, z); bf16* DDz = slotp(a, 5 + z);
        const int col0 = h * 64 + 4 * g4;
        const f32x4 kkc = *(const GAS f32x4*)(a.in[I_KK] + col0), kac = *(const GAS f32x4*)(a.in[I_KA] + col0);
        float T[4][4];
#pragma unroll
        for (int jj = 0; jj < 4; ++jj)
#pragma unroll
            for (int ii = 0; ii < 4; ++ii) T[jj][ii] = 0.f;
        v2u gr, gk, gv, ga, gd; float ginv;
        { const int row = scan_row(z, b, ss); const size_t o = (size_t)row * D + col0;
          gr = *(const GAS v2u*)(R + o); gk = *(const GAS v2u*)(K + o); gv = *(const GAS v2u*)(V + o); ga = *(const GAS v2u*)(Az + o); gd = *(const GAS v2u*)(DDz + o); ginv = INVN[row * 16 + h]; }
        __syncthreads();
        for (int n = -1; n < NCH; ++n) {
            if (n + 1 < NCH) {
                const float k0 = bflo(gk.x), k1 = bfhi(gk.x), k2 = bflo(gk.y), k3 = bfhi(gk.y), a0 = bflo(ga.x), a1 = bfhi(ga.x), a2 = bflo(ga.y), a3 = bfhi(ga.y);
                const float q0 = k0 * kkc.x * ginv, q1 = k1 * kkc.y * ginv, q2 = k2 * kkc.z * ginv, q3 = k3 * kkc.w * ginv;
                LAS float* p = (LAS float*)(lds + ((n + 1) & 1) * 49152 + sc * 24576 + ss * 1536) + 4 * g4;
                *(LAS f32x4*)(p)       = (f32x4){-q0, -q1, -q2, -q3};
                *(LAS f32x4*)(p + 64)  = (f32x4){1.f - bflo(gd.x), 1.f - bfhi(gd.x), 1.f - bflo(gd.y), 1.f - bfhi(gd.y)};
                *(LAS f32x4*)(p + 128) = (f32x4){q0 * a0, q1 * a1, q2 * a2, q3 * a3};
                *(LAS f32x4*)(p + 192) = (f32x4){k0 * (1.f + (a0 - 1.f) * kac.x), k1 * (1.f + (a1 - 1.f) * kac.y), k2 * (1.f + (a2 - 1.f) * kac.z), k3 * (1.f + (a3 - 1.f) * kac.w)};
                *(LAS f32x4*)(p + 256) = (f32x4){bflo(gr.x), bfhi(gr.x), bflo(gr.y), bfhi(gr.y)};
                *(LAS f32x4*)(p + 320) = (f32x4){bflo(gv.x), bfhi(gv.x), bflo(gv.y), bfhi(gv.y)};
            }
            if (n >= 1) {
                const f32x4 y4 = *(const LAS f32x4*)((const LAS float*)(lds + 98304 + ((n - 1) & 1) * 8192 + sc * 4096) + ss * 64 + 4 * g4);
                v2u o; o.x = pk2(y4.x, y4.y); o.y = pk2(y4.z, y4.w);
                *(GAS v2u*)(DDz + (size_t)scan_row(z, b, (n - 1) * 16 + ss) * D + col0) = o;
            }
            __syncthreads();
            if (n + 2 < NCH) { const int row = scan_row(z, b, (n + 2) * 16 + ss); const size_t o = (size_t)row * D + col0;
                gr = *(const GAS v2u*)(R + o); gk = *(const GAS v2u*)(K + o); gv = *(const GAS v2u*)(V + o); ga = *(const GAS v2u*)(Az + o); gd = *(const GAS v2u*)(DDz + o); ginv = INVN[row * 16 + h]; }
            const int m = n + 1;
            if (m < NCH) {
                const LAS float* cb = (const LAS float*)(lds + (m & 1) * 49152 + wc * 24576);
                LAS float* yb = (LAS float*)(lds + 98304 + (m & 1) * 8192 + wc * 4096);
                f32x4 nk = *(const LAS f32x4*)(cb + 4 * jg), w4 = *(const LAS f32x4*)(cb + 64 + 4 * jg), ka = *(const LAS f32x4*)(cb + 128 + 4 * jg),
                      kd = *(const LAS f32x4*)(cb + 192 + 4 * jg), r4 = *(const LAS f32x4*)(cb + 256 + 4 * jg), v4 = *(const LAS f32x4*)(cb + 320 + 16 * wq + 4 * ig);
#pragma unroll 2
                for (int s = 0; s < 16; ++s) {
                    const LAS float* pn = cb + ((s + 1) & 15) * 384;
                    const f32x4 nk_n = *(const LAS f32x4*)(pn + 4 * jg), w4_n = *(const LAS f32x4*)(pn + 64 + 4 * jg), ka_n = *(const LAS f32x4*)(pn + 128 + 4 * jg),
                                kd_n = *(const LAS f32x4*)(pn + 192 + 4 * jg), r4_n = *(const LAS f32x4*)(pn + 256 + 4 * jg), v4_n = *(const LAS f32x4*)(pn + 320 + 16 * wq + 4 * ig);
                    float sa0 = afma(T[3][0], nk.w, afma(T[2][0], nk.z, afma(T[1][0], nk.y, amul(T[0][0], nk.x))));
                    float sa1 = afma(T[3][1], nk.w, afma(T[2][1], nk.z, afma(T[1][1], nk.y, amul(T[0][1], nk.x))));
                    float sa2 = afma(T[3][2], nk.w, afma(T[2][2], nk.z, afma(T[1][2], nk.y, amul(T[0][2], nk.x))));
                    float sa3 = afma(T[3][3], nk.w, afma(T[2][3], nk.z, afma(T[1][3], nk.y, amul(T[0][3], nk.x))));
                    row_sum16x4(sa0, sa1, sa2, sa3);
                    const float sa[4] = {sa0, sa1, sa2, sa3};
#pragma unroll
                    for (int ii = 0; ii < 4; ++ii) {
                        T[0][ii] = afma(v4[ii], kd.x, afma(sa[ii], ka.x, amul(T[0][ii], w4.x))); T[1][ii] = afma(v4[ii], kd.y, afma(sa[ii], ka.y, amul(T[1][ii], w4.y)));
                        T[2][ii] = afma(v4[ii], kd.z, afma(sa[ii], ka.z, amul(T[2][ii], w4.z))); T[3][ii] = afma(v4[ii], kd.w, afma(sa[ii], ka.w, amul(T[3][ii], w4.w))); }
                    float y0 = afma(T[3][0], r4.w, afma(T[2][0], r4.z, afma(T[1][0], r4.y, amul(T[0][0], r4.x))));
                    float y1 = afma(T[3][1], r4.w, afma(T[2][1], r4.z, afma(T[1][1], r4.y, amul(T[0][1], r4.x))));
                    float y2 = afma(T[3][2], r4.w, afma(T[2][2], r4.z, afma(T[1][2], r4.y, amul(T[0][2], r4.x))));
                    float y3 = afma(T[3][3], r4.w, afma(T[2][3], r4.z, afma(T[1][3], r4.y, amul(T[0][3], r4.x))));
                    row_sum16x4(y0, y1, y2, y3);
                    if (jg == 0) *(LAS f32x4*)(yb + s * 64 + 16 * wq + 4 * ig) = (f32x4){y0, y1, y2, y3};
                    nk = nk_n; w4 = w4_n; ka = ka_n; kd = kd_n; r4 = r4_n; v4 = v4_n;
                }
            }
        }
        __syncthreads();
        {
            const f32x4 y4 = *(const LAS f32x4*)((const LAS float*)(lds + 98304 + ((NCH - 1) & 1) * 8192 + sc * 4096) + ss * 64 + 4 * g4);
            v2u o; o.x = pk2(y4.x, y4.y); o.y = pk2(y4.z, y4.w);
            *(GAS v2u*)(DDz + (size_t)scan_row(z, b, (NCH - 1) * 16 + ss) * D + col0) = o;
        }
    }
}
typedef short s16x8c __attribute__((ext_vector_type(8)));
__device__ __forceinline__ f32x4 mfma16(v4u a, v4u b, f32x4 c) { return __builtin_amdgcn_mfma_f32_16x16x32_bf16(__builtin_bit_cast(s16x8c, a), __builtin_bit_cast(s16x8c, b), c, 0, 0, 0); }
__device__ __forceinline__ void blocksolve4(f32x4& x, const f32x4& n1, const f32x4& n2, const f32x4& n3) {
    x.y += n1.x * x.x; x.z += n2.x * x.x + n2.y * x.y; x.w += n3.x * x.x + n3.y * x.y + n3.z * x.z; }
template <int N> __device__ __forceinline__ float row_shr1(float v) {
    return __builtin_bit_cast(float, __builtin_amdgcn_update_dpp(0x3f800000, __builtin_bit_cast(int, v), 0x110 + N, 0xf, 0xf, false)); }
__device__ __forceinline__ void p4_scan_chunked(const Args& a, LAS unsigned char* lds, int tid, int lane, int wave, int bid, int G) {
    const bf16 *R = slotp(a, 2), *K = slotp(a, 3), *V = slotp(a, 4);
    constexpr int NCH = TT / 16, RP = 68, RARR = 16 * RP;
    constexpr int O_RAW = 0, O_VT = 5 * RARR * 4, O_VEC = O_VT + 4096, O_BKT = O_VEC + 9216, O_GC = O_BKT + 4096, O_YB = O_GC + 256, O_WS = O_YB + 4096, WS_B = 5120, O_WL = O_WS + 4 * WS_B, O_AL = O_WL + RARR * 4, CHAIN_B = O_AL + RARR * 4;
    static_assert(2 * CHAIN_B <= RW_BYTES, "scan LDS");
    const int sc = tid >> 8, ss = (tid >> 4) & 15, g4 = tid & 15;
    const int wc = wave >> 2, wq = wave & 3, fr = lane & 15, g = lane >> 4;
    LAS unsigned char* cs = lds + sc * CHAIN_B;
    LAS unsigned char* cw = lds + wc * CHAIN_B;
    LAS unsigned char* ws = cw + O_WS + wq * WS_B;
    for (int pair = bid; pair < 256; pair += G) {
        const int cid = pair * 2 + sc, z = cid >> 8, b = (cid >> 4) & 15, h = cid & 15;
        bf16* Yz = slotp(a, z);
        const bf16* L1b = (const bf16*)(a.ws + WS_L1) + z * 64 + 8 * g;
        const bf16* L2A = (const bf16*)(a.ws + WS_L2A);
        const int lc = h * 64 + 16 * wq + fr;
        const v4u bw0 = *(const GAS v4u*)(L2A + (size_t)(z * 1024 + lc) * 256 + z * 64 + 8 * g), bw1 = *(const GAS v4u*)(L2A + (size_t)(z * 1024 + lc) * 256 + z * 64 + 32 + 8 * g),
                  ba0 = *(const GAS v4u*)(L2A + (size_t)(2048 + z * 1024 + lc) * 256 + 128 + z * 64 + 8 * g), ba1 = *(const GAS v4u*)(L2A + (size_t)(2048 + z * 1024 + lc) * 256 + 128 + z * 64 + 32 + 8 * g);
        const float w0c = a.in[I_W0][z * 1024 + lc], a0c = a.in[I_A0][z * 1024 + lc];
        const int col0 = h * 64 + 4 * g4;
        const f32x4 kkc = *(const GAS f32x4*)(a.in[I_KK] + col0), kac = *(const GAS f32x4*)(a.in[I_KA] + col0), rkc = *(const GAS f32x4*)(a.in[I_RK] + col0);
        float* BONz = (float*)(a.ws + (z ? WS_INVN : WS_BON));
        f32x4 T[4];
#pragma unroll
        for (int jb = 0; jb < 4; ++jb) T[jb] = (f32x4){0.f, 0.f, 0.f, 0.f};
        v2u gr, gk, gv; int grow; v4u lw0, lw1, la0, la1;
#define SCAN_LOAD(chunk) do { const int row_ = scan_row(z, b, (chunk) * 16 + ss); const size_t o_ = (size_t)row_ * D + col0; \
        gr = *(const GAS v2u*)(R + o_); gk = *(const GAS v2u*)(K + o_); gv = *(const GAS v2u*)(V + o_); grow = row_; } while (0)
#define SCAN_LOAD_L1(chunk) do { const bf16* l1_ = L1b + (size_t)scan_row(z, b, (chunk) * 16 + fr) * 512; lw0 = *(const GAS v4u*)l1_; lw1 = *(const GAS v4u*)(l1_ + 32); la0 = *(const GAS v4u*)(l1_ + 128); la1 = *(const GAS v4u*)(l1_ + 160); } while (0)
#define SCAN_LORA() do { const f32x4 z4_ = (f32x4){0.f, 0.f, 0.f, 0.f}; const f32x4 cw_ = mfma16(lw1, bw1, mfma16(lw0, bw0, z4_)), ca_ = mfma16(la1, ba1, mfma16(la0, ba0, z4_)); \
        LAS float* wl_ = (LAS float*)(cw + O_WL) + (4 * g) * RP + 16 * wq + fr; LAS float* al_ = (LAS float*)(cw + O_AL) + (4 * g) * RP + 16 * wq + fr; \
        _Pragma("unroll") for (int e_ = 0; e_ < 4; ++e_) { wl_[e_ * RP] = fexp(-0.6065306597f * fsigmoid(w0c + cw_[e_])); al_[e_ * RP] = fsigmoid(a0c + ca_[e_]); } } while (0)
#define SCAN_CONVERT(chunk) do { const float k0 = bflo(gk.x), k1 = bfhi(gk.x), k2 = bflo(gk.y), k3 = bfhi(gk.y); \
        const f32x4 av_ = *(const LAS f32x4*)((const LAS float*)(cs + O_AL) + ss * RP + 4 * g4), wv_ = *(const LAS f32x4*)((const LAS float*)(cs + O_WL) + ss * RP + 4 * g4); \
        const float a0 = av_.x, a1 = av_.y, a2 = av_.z, a3 = av_.w; \
        const float u0_ = k0 * kkc.x, u1_ = k1 * kkc.y, u2_ = k2 * kkc.z, u3_ = k3 * kkc.w; \
        const float d0_ = k0 * (1.f + (a0 - 1.f) * kac.x), d1_ = k1 * (1.f + (a1 - 1.f) * kac.y), d2_ = k2 * (1.f + (a2 - 1.f) * kac.z), d3_ = k3 * (1.f + (a3 - 1.f) * kac.w); \
        const float ssq_ = row_sum16((u0_ * u0_ + u1_ * u1_) + (u2_ * u2_ + u3_ * u3_)); \
        const float bon_ = row_sum16((bflo(gr.x) * d0_ * rkc.x + bfhi(gr.x) * d1_ * rkc.y) + (bflo(gr.y) * d2_ * rkc.z + bfhi(gr.y) * d3_ * rkc.w)); \
        const float ginv = rsqrtf(ssq_ + 1e-12f); \
        if (g4 == 0) BONz[grow * 16 + h] = bon_; \
        const float q0 = u0_ * ginv, q1 = u1_ * ginv, q2 = u2_ * ginv, q3 = u3_ * ginv; \
        LAS float* p_ = (LAS float*)(cs + O_RAW) + ss * RP + 4 * g4; \
        *(LAS f32x4*)(p_)            = wv_; \
        *(LAS f32x4*)(p_ + RARR)     = (f32x4){-q0, -q1, -q2, -q3}; \
        *(LAS f32x4*)(p_ + 2 * RARR) = (f32x4){q0 * a0, q1 * a1, q2 * a2, q3 * a3}; \
        *(LAS f32x4*)(p_ + 3 * RARR) = (f32x4){d0_, d1_, d2_, d3_}; \
        *(LAS f32x4*)(p_ + 4 * RARR) = (f32x4){bflo(gr.x), bfhi(gr.x), bflo(gr.y), bfhi(gr.y)}; \
        LAS unsigned short* vt_ = (LAS unsigned short*)(cs + O_VT + ((chunk) & 1) * 2048) + (4 * g4) * 16 + ss; \
        vt_[0] = (unsigned short)(gv.x & 0xffffu); vt_[16] = (unsigned short)(gv.x >> 16); vt_[32] = (unsigned short)(gv.y & 0xffffu); vt_[48] = (unsigned short)(gv.y >> 16); } while (0)
        SCAN_LOAD(0); SCAN_LOAD_L1(0);
        __syncthreads();
        for (int i = lane; i < WS_B / 16; i += 64) *(LAS v4u*)(ws + i * 16) = (v4u){0u, 0u, 0u, 0u};
        SCAN_LORA();
        SCAN_LOAD_L1(1);
        __syncthreads();
        SCAN_CONVERT(0);
        SCAN_LOAD(1);
        __syncthreads();
        for (int n = 0; n < NCH; ++n) {
            {
                const int j0 = 16 * wq + 4 * g;
                const LAS float* rw = (const LAS float*)(cw + O_RAW) + fr * RP + j0;
                const f32x4 w = *(const LAS f32x4*)rw, ap = *(const LAS f32x4*)(rw + RARR), bb = *(const LAS f32x4*)(rw + 2 * RARR), kd = *(const LAS f32x4*)(rw + 3 * RARR), rr = *(const LAS f32x4*)(rw + 4 * RARR);
                f32x4 gm = w;
#pragma unroll
                for (int c = 0; c < 4; ++c) { gm[c] *= row_shr1<1>(gm[c]); }
#pragma unroll
                for (int c = 0; c < 4; ++c) { gm[c] *= row_shr1<2>(gm[c]); }
#pragma unroll
                for (int c = 0; c < 4; ++c) { gm[c] *= row_shr1<4>(gm[c]); }
#pragma unroll
                for (int c = 0; c < 4; ++c) { gm[c] *= row_shr1<8>(gm[c]); }
                f32x4 gp;
#pragma unroll
                for (int c = 0; c < 4; ++c) gp[c] = row_shr1<1>(gm[c]);
                const f32x4 ig = (f32x4){frcp(gm.x), frcp(gm.y), frcp(gm.z), frcp(gm.w)};
                const f32x4 at = gp * ap, bt = bb * ig, kt = kd * ig, rt = gm * rr;
                const int pos0 = 32 * (wq >> 1) + 8 * g + 4 * (wq & 1);
                LAS unsigned char* vv = cw + O_VEC + fr * 144 + pos0 * 2;
                const v2u hb = (v2u){pk2(bt.x, bt.y), pk2(bt.z, bt.w)}, hk = (v2u){pk2(kt.x, kt.y), pk2(kt.z, kt.w)};
                *(LAS v2u*)(vv) = (v2u){pk2(at.x, at.y), pk2(at.z, at.w)}; *(LAS v2u*)(vv + 2304) = hb; *(LAS v2u*)(vv + 4608) = hk; *(LAS v2u*)(vv + 6912) = (v2u){pk2(rt.x, rt.y), pk2(rt.z, rt.w)};
                LAS unsigned short* bk = (LAS unsigned short*)(cw + O_BKT) + j0 * 32 + (fr >> 2) * 8 + (fr & 3);
                bk[0] = (unsigned short)(hb.x & 0xffffu); bk[32] = (unsigned short)(hb.x >> 16); bk[64] = (unsigned short)(hb.y & 0xffffu); bk[96] = (unsigned short)(hb.y >> 16);
                bk[4] = (unsigned short)(hk.x & 0xffffu); bk[36] = (unsigned short)(hk.x >> 16); bk[68] = (unsigned short)(hk.y & 0xffffu); bk[100] = (unsigned short)(hk.y >> 16);
                if (fr == 15) *(LAS f32x4*)((LAS float*)(cw + O_GC) + j0) = gm;
            }
            if (n >= 1) {
                const f32x4 y4 = *(const LAS f32x4*)((const LAS float*)(cs + O_YB) + ss * 64 + 4 * g4);
                v2u o; o.x = pk2(y4.x, y4.y); o.y = pk2(y4.z, y4.w);
                *(GAS v2u*)(Yz + (size_t)scan_row(z, b, (n - 1) * 16 + ss) * D + col0) = o;
            }
            if (n + 1 < NCH) SCAN_LORA();
            __syncthreads();
            if (n + 2 < NCH) SCAN_LOAD_L1(n + 2);
            {
                const LAS unsigned char* vec = cw + O_VEC + fr * 144 + g * 16;
                const v4u xa0 = *(const LAS v4u*)(vec), xa1 = *(const LAS v4u*)(vec + 64), xb0 = *(const LAS v4u*)(vec + 2304), xb1 = *(const LAS v4u*)(vec + 2304 + 64),
                          xk0 = *(const LAS v4u*)(vec + 4608), xk1 = *(const LAS v4u*)(vec + 4608 + 64), xr0 = *(const LAS v4u*)(vec + 6912), xr1 = *(const LAS v4u*)(vec + 6912 + 64);
                const f32x4 zero4 = (f32x4){0.f, 0.f, 0.f, 0.f};
                f32x4 nab = mfma16(xb1, xa1, mfma16(xb0, xa0, zero4)), nak = mfma16(xk1, xa1, mfma16(xk0, xa0, zero4));
                f32x4 mbr = mfma16(xb1, xr1, mfma16(xb0, xr0, zero4)), mkr = mfma16(xk1, xr1, mfma16(xk0, xr0, zero4));
#pragma unroll
                for (int e = 0; e < 4; ++e) { const int r = 4 * g + e; if (!(r < fr)) { nab[e] = 0.f; nak[e] = 0.f; } if (!(r <= fr)) { mbr[e] = 0.f; mkr[e] = 0.f; } }
                *(LAS f32x4*)(ws + (fr * 16 + 4 * g) * 4) = nab;
                { const bool off = (g != (fr >> 2)); v4u o; o.x = off ? pk2(nab.x, nab.y) : 0u; o.y = off ? pk2(nab.z, nab.w) : 0u; o.z = 0u; o.w = 0u; *(LAS v4u*)(ws + 1024 + (fr * 4 + g) * 16) = o; }
                { v4u o; o.x = pk2(nak.x, nak.y); o.y = pk2(nak.z, nak.w); o.z = 0u; o.w = 0u; *(LAS v4u*)(ws + 2048 + (fr * 4 + g) * 16) = o; }
                { v4u o; o.x = pk2(mbr.x, mbr.y); o.y = pk2(mbr.z, mbr.w); o.z = pk2(mkr.x, mkr.y); o.w = pk2(mkr.z, mkr.w); *(LAS v4u*)(ws + 4096 + (fr * 4 + g) * 16) = o; }
                LDS_WAIT(); asm volatile("" ::: "memory");
                const f32x4 n1 = *(const LAS f32x4*)(ws + ((4 * g + 1) * 16 + 4 * g) * 4), n2 = *(const LAS f32x4*)(ws + ((4 * g + 2) * 16 + 4 * g) * 4), n3 = *(const LAS f32x4*)(ws + ((4 * g + 3) * 16 + 4 * g) * 4);
                const v4u noff = *(const LAS v4u*)(ws + 1024 + (fr * 4 + g) * 16);
                const f32x4 eye = (f32x4){(4 * g == fr) ? 1.f : 0.f, (4 * g + 1 == fr) ? 1.f : 0.f, (4 * g + 2 == fr) ? 1.f : 0.f, (4 * g + 3 == fr) ? 1.f : 0.f};
                f32x4 L = eye; blocksolve4(L, n1, n2, n3);
#pragma unroll
                for (int it = 0; it < 3; ++it) { v4u lb; lb.x = pk2(L.x, L.y); lb.y = pk2(L.z, L.w); lb.z = 0u; lb.w = 0u; L = mfma16(noff, lb, eye); blocksolve4(L, n1, n2, n3); }
                { LAS unsigned short* lu = (LAS unsigned short*)(ws + 3072) + (fr >> 2) * 8 + (fr & 3);
                  lu[(4 * g) * 32] = (unsigned short)f2bf(L.x); lu[(4 * g + 1) * 32] = (unsigned short)f2bf(L.y); lu[(4 * g + 2) * 32] = (unsigned short)f2bf(L.z); lu[(4 * g + 3) * 32] = (unsigned short)f2bf(L.w); }
                LDS_WAIT(); asm volatile("" ::: "memory");
                v4u tb0, tb1; tb0.x = pk2(T[0].x, T[0].y); tb0.y = pk2(T[0].z, T[0].w); tb0.z = pk2(T[1].x, T[1].y); tb0.w = pk2(T[1].z, T[1].w);
                tb1.x = pk2(T[2].x, T[2].y); tb1.y = pk2(T[2].z, T[2].w); tb1.z = pk2(T[3].x, T[3].y); tb1.w = pk2(T[3].z, T[3].w);
                const f32x4 Wa = mfma16(xa1, tb1, mfma16(xa0, tb0, zero4)), Wr = mfma16(xr1, tb1, mfma16(xr0, tb0, zero4));
                const v2u vt = *(const LAS v2u*)(cw + O_VT + (n & 1) * 2048 + (16 * wq + fr) * 32 + g * 8);
                v4u vb; vb.x = vt.x; vb.y = vt.y; vb.z = 0u; vb.w = 0u;
                const v4u ng = *(const LAS v4u*)(ws + 2048 + (fr * 4 + g) * 16), lu4 = *(const LAS v4u*)(ws + 3072 + (fr * 4 + g) * 16), my = *(const LAS v4u*)(ws + 4096 + (fr * 4 + g) * 16);
                const f32x4 Gm = mfma16(ng, vb, Wa);
                v4u gb; gb.x = pk2(Gm.x, Gm.y); gb.y = pk2(Gm.z, Gm.w); gb.z = 0u; gb.w = 0u;
                const f32x4 U = mfma16(lu4, gb, zero4);
                v4u bop; bop.x = pk2(U.x, U.y); bop.y = pk2(U.z, U.w); bop.z = vt.x; bop.w = vt.y;
                const f32x4 Y = mfma16(my, bop, Wr);
                { LAS float* yb = (LAS float*)(cw + O_YB) + (4 * g) * 64 + 16 * wq + fr; yb[0] = Y.x; yb[64] = Y.y; yb[128] = Y.z; yb[192] = Y.w; }
#pragma unroll
                for (int jb = 0; jb < 4; ++jb) { const v4u bkt = *(const LAS v4u*)(cw + O_BKT + ((16 * jb + fr) * 4 + g) * 16);
                    const f32x4 gc = *(const LAS f32x4*)((const LAS float*)(cw + O_GC) + 16 * jb + 4 * g);
                    T[jb] = mfma16(bkt, bop, T[jb]) * gc; }
            }
            if (n + 1 < NCH) { SCAN_CONVERT(n + 1); if (n + 2 < NCH) SCAN_LOAD(n + 2); }
            __syncthreads();
        }
#undef SCAN_LOAD
#undef SCAN_LOAD_L1
#undef SCAN_CONVERT
#undef SCAN_LORA
        {
            const f32x4 y4 = *(const LAS f32x4*)((const LAS float*)(cs + O_YB) + ss * 64 + 4 * g4);
            v2u o; o.x = pk2(y4.x, y4.y); o.y = pk2(y4.z, y4.w);
            *(GAS v2u*)(Yz + (size_t)scan_row(z, b, (NCH - 1) * 16 + ss) * D + col0) = o;
        }
    }
}
__device__ __forceinline__ void p4_scan_v3(const Args& a, LAS unsigned char* lds, int tid, int lane, int wave, int bid, int G) {
    const bf16 *R = slotp(a, 3), *K = slotp(a, 4), *V = slotp(a, 5);
    constexpr int NCH = TT / 16;
    constexpr int O_VEC = 0, O_BKT = 9216, O_GC = 13312, O_VT = 13568, BUF_B = 15616, O_YB = 2 * BUF_B, O_WS = O_YB + 8192, WS_B = 5120 + 2176, CHAIN_B = O_WS + 4 * WS_B;
    static_assert(2 * CHAIN_B <= RW_BYTES, "scan LDS");
    const int sc = tid >> 8, ss = (tid >> 4) & 15, g4 = tid & 15;
    const int wq = wave & 3, fr = lane & 15, g = lane >> 4;
    LAS unsigned char* cw = lds + sc * CHAIN_B;
    LAS unsigned char* ws = cw + O_WS + wq * WS_B;
    for (int pair = bid; pair < 256; pair += G) {
        const int cid = pair * 2 + sc, z = cid >> 8, b = (cid >> 4) & 15, h = cid & 15;
        bf16* Yz = slotp(a, z);
        float* BONP = (float*)((unsigned char*)a.out + 72 * MiB) + (size_t)(z * 4 + wq) * NT * 16;
        const bf16* L1b = (const bf16*)(a.ws + WS_L1) + z * 64 + 8 * g;
        const bf16* L2A = (const bf16*)(a.ws + WS_L2A);
        const int lc = h * 64 + 16 * wq + fr;
        const v4u bw0 = *(const GAS v4u*)(L2A + (size_t)(z * 1024 + lc) * 256 + z * 64 + 8 * g), bw1 = *(const GAS v4u*)(L2A + (size_t)(z * 1024 + lc) * 256 + z * 64 + 32 + 8 * g),
                  ba0 = *(const GAS v4u*)(L2A + (size_t)(2048 + z * 1024 + lc) * 256 + 128 + z * 64 + 8 * g), ba1 = *(const GAS v4u*)(L2A + (size_t)(2048 + z * 1024 + lc) * 256 + 128 + z * 64 + 32 + 8 * g);
        const float w0c = a.in[I_W0][z * 1024 + lc], a0c = a.in[I_A0][z * 1024 + lc];
        const int j0 = 16 * wq + 4 * g, pcol = h * 64 + j0;
        const f32x4 kkc = *(const GAS f32x4*)(a.in[I_KK] + pcol), kac = *(const GAS f32x4*)(a.in[I_KA] + pcol), rkc = *(const GAS f32x4*)(a.in[I_RK] + pcol);
        f32x4 kkn[4];
#pragma unroll
        for (int c = 0; c < 4; ++c) kkn[c] = *(const GAS f32x4*)(a.in[I_KK] + h * 64 + 16 * g + 4 * c);
        const int pos0 = 32 * (wq >> 1) + 8 * g + 4 * (wq & 1);
        f32x4 T[4];
#pragma unroll
        for (int jb = 0; jb < 4; ++jb) T[jb] = (f32x4){0.f, 0.f, 0.f, 0.f};
        v2u gr, gk, gv; v4u kn0, kn1, lw0, lw1, la0, la1; int grow;
#define V3_LOAD(chunk) do { const int row_ = scan_row(z, b, (chunk) * 16 + fr); grow = row_; const size_t o_ = (size_t)row_ * D + pcol; \
        gr = *(const GAS v2u*)(R + o_); gk = *(const GAS v2u*)(K + o_); gv = *(const GAS v2u*)(V + o_); \
        kn0 = *(const GAS v4u*)(K + (size_t)row_ * D + h * 64 + 16 * g); kn1 = *(const GAS v4u*)(K + (size_t)row_ * D + h * 64 + 16 * g + 8); \
        const bf16* l1_ = L1b + (size_t)row_ * 512; lw0 = *(const GAS v4u*)l1_; lw1 = *(const GAS v4u*)(l1_ + 32); la0 = *(const GAS v4u*)(l1_ + 128); la1 = *(const GAS v4u*)(l1_ + 160); } while (0)
#define V3_PRODUCE(chunk) do { \
        const f32x4 z4_ = (f32x4){0.f, 0.f, 0.f, 0.f}; const f32x4 cw_ = mfma16(lw1, bw1, mfma16(lw0, bw0, z4_)), ca_ = mfma16(la1, ba1, mfma16(la0, ba0, z4_)); \
        LAS float* trw_ = (LAS float*)(ws + 5120); LAS float* tra_ = trw_ + 272; \
        _Pragma("unroll") for (int e_ = 0; e_ < 4; ++e_) { trw_[(4 * g + e_) * 17 + fr] = fexp(-0.6065306597f * fsigmoid(w0c + cw_[e_])); tra_[(4 * g + e_) * 17 + fr] = fsigmoid(a0c + ca_[e_]); } \
        float n8_[8]; float ssq_ = 0.f; \
        unpack8(kn0, n8_); ssq_ += (n8_[0] * kkn[0].x) * (n8_[0] * kkn[0].x) + (n8_[1] * kkn[0].y) * (n8_[1] * kkn[0].y) + (n8_[2] * kkn[0].z) * (n8_[2] * kkn[0].z) + (n8_[3] * kkn[0].w) * (n8_[3] * kkn[0].w) \
                                 + (n8_[4] * kkn[1].x) * (n8_[4] * kkn[1].x) + (n8_[5] * kkn[1].y) * (n8_[5] * kkn[1].y) + (n8_[6] * kkn[1].z) * (n8_[6] * kkn[1].z) + (n8_[7] * kkn[1].w) * (n8_[7] * kkn[1].w); \
        unpack8(kn1, n8_); ssq_ += (n8_[0] * kkn[2].x) * (n8_[0] * kkn[2].x) + (n8_[1] * kkn[2].y) * (n8_[1] * kkn[2].y) + (n8_[2] * kkn[2].z) * (n8_[2] * kkn[2].z) + (n8_[3] * kkn[2].w) * (n8_[3] * kkn[2].w) \
                                 + (n8_[4] * kkn[3].x) * (n8_[4] * kkn[3].x) + (n8_[5] * kkn[3].y) * (n8_[5] * kkn[3].y) + (n8_[6] * kkn[3].z) * (n8_[6] * kkn[3].z) + (n8_[7] * kkn[3].w) * (n8_[7] * kkn[3].w); \
        ssq_ = rows4_sum(ssq_); \
        const float inv_ = rsqrtf(ssq_ + 1e-12f); \
        LDS_WAIT(); asm volatile("" ::: "memory"); \
        const f32x4 w_ = (f32x4){trw_[fr * 17 + 4 * g], trw_[fr * 17 + 4 * g + 1], trw_[fr * 17 + 4 * g + 2], trw_[fr * 17 + 4 * g + 3]}; \
        const f32x4 a_ = (f32x4){tra_[fr * 17 + 4 * g], tra_[fr * 17 + 4 * g + 1], tra_[fr * 17 + 4 * g + 2], tra_[fr * 17 + 4 * g + 3]}; \
        const f32x4 k_ = (f32x4){bflo(gk.x), bfhi(gk.x), bflo(gk.y), bfhi(gk.y)}, r_ = (f32x4){bflo(gr.x), bfhi(gr.x), bflo(gr.y), bfhi(gr.y)}; \
        const f32x4 u_ = k_ * kkc * inv_; const f32x4 d_ = k_ * ((a_ - 1.f) * kac + 1.f); \
        float bon_ = (r_.x * d_.x * rkc.x + r_.y * d_.y * rkc.y) + (r_.z * d_.z * rkc.z + r_.w * d_.w * rkc.w); \
        bon_ = rows4_sum(bon_); \
        if (g == 0) BONP[grow * 16 + h] = bon_; \
        f32x4 gm_ = w_; \
        _Pragma("unroll") for (int c_ = 0; c_ < 4; ++c_) gm_[c_] *= row_shr1<1>(gm_[c_]); \
        _Pragma("unroll") for (int c_ = 0; c_ < 4; ++c_) gm_[c_] *= row_shr1<2>(gm_[c_]); \
        _Pragma("unroll") for (int c_ = 0; c_ < 4; ++c_) gm_[c_] *= row_shr1<4>(gm_[c_]); \
        _Pragma("unroll") for (int c_ = 0; c_ < 4; ++c_) gm_[c_] *= row_shr1<8>(gm_[c_]); \
        f32x4 gp_; _Pragma("unroll") for (int c_ = 0; c_ < 4; ++c_) gp_[c_] = row_shr1<1>(gm_[c_]); \
        const f32x4 ig_ = (f32x4){frcp(gm_.x), frcp(gm_.y), frcp(gm_.z), frcp(gm_.w)}; \
        const f32x4 at_ = gp_ * (-u_), bt_ = (u_ * a_) * ig_, kt_ = d_ * ig_, rt_ = gm_ * r_; \
        LAS unsigned char* bb_ = cw + ((chunk) & 1) * BUF_B; \
        LAS unsigned char* vv_ = bb_ + O_VEC + fr * 144 + pos0 * 2; \
        const v2u hb_ = (v2u){pk2hw(bt_.x, bt_.y), pk2hw(bt_.z, bt_.w)}, hk_ = (v2u){pk2hw(kt_.x, kt_.y), pk2hw(kt_.z, kt_.w)}; \
        *(LAS v2u*)(vv_) = (v2u){pk2hw(at_.x, at_.y), pk2hw(at_.z, at_.w)}; *(LAS v2u*)(vv_ + 2304) = hb_; *(LAS v2u*)(vv_ + 4608) = hk_; *(LAS v2u*)(vv_ + 6912) = (v2u){pk2hw(rt_.x, rt_.y), pk2hw(rt_.z, rt_.w)}; \
        LAS unsigned short* bk_ = (LAS unsigned short*)(bb_ + O_BKT) + j0 * 32 + (fr >> 2) * 8 + (fr & 3); \
        bk_[0] = (unsigned short)(hb_.x & 0xffffu); bk_[32] = (unsigned short)(hb_.x >> 16); bk_[64] = (unsigned short)(hb_.y & 0xffffu); bk_[96] = (unsigned short)(hb_.y >> 16); \
        bk_[4] = (unsigned short)(hk_.x & 0xffffu); bk_[36] = (unsigned short)(hk_.x >> 16); bk_[68] = (unsigned short)(hk_.y & 0xffffu); bk_[100] = (unsigned short)(hk_.y >> 16); \
        if (fr == 15) *(LAS f32x4*)((LAS float*)(bb_ + O_GC) + j0) = gm_; \
        LAS unsigned short* vt_ = (LAS unsigned short*)(bb_ + O_VT) + j0 * 16 + fr; \
        vt_[0] = (unsigned short)(gv.x & 0xffffu); vt_[16] = (unsigned short)(gv.x >> 16); vt_[32] = (unsigned short)(gv.y & 0xffffu); vt_[48] = (unsigned short)(gv.y >> 16); } while (0)
        V3_LOAD(0);
        __syncthreads();
        for (int i = lane; i < WS_B / 16; i += 64) *(LAS v4u*)(ws + i * 16) = (v4u){0u, 0u, 0u, 0u};
        V3_PRODUCE(0);
        V3_LOAD(1);
        __syncthreads();
        for (int n = 0; n < NCH; ++n) {
            if (n + 1 < NCH) { V3_PRODUCE(n + 1); if (n + 2 < NCH) V3_LOAD(n + 2); }
            {
                const LAS unsigned char* bb = cw + (n & 1) * BUF_B;
                const LAS unsigned char* vec = bb + O_VEC + fr * 144 + g * 16;
                const v4u xa0 = *(const LAS v4u*)(vec), xa1 = *(const LAS v4u*)(vec + 64), xb0 = *(const LAS v4u*)(vec + 2304), xb1 = *(const LAS v4u*)(vec + 2304 + 64),
                          xk0 = *(const LAS v4u*)(vec + 4608), xk1 = *(const LAS v4u*)(vec + 4608 + 64), xr0 = *(const LAS v4u*)(vec + 6912), xr1 = *(const LAS v4u*)(vec + 6912 + 64);
                const f32x4 zero4 = (f32x4){0.f, 0.f, 0.f, 0.f};
                f32x4 nab = mfma16(xb1, xa1, mfma16(xb0, xa0, zero4)), nak = mfma16(xk1, xa1, mfma16(xk0, xa0, zero4));
                f32x4 mbr = mfma16(xb1, xr1, mfma16(xb0, xr0, zero4)), mkr = mfma16(xk1, xr1, mfma16(xk0, xr0, zero4));
#pragma unroll
                for (int e = 0; e < 4; ++e) { const int r = 4 * g + e; if (!(r < fr)) { nab[e] = 0.f; nak[e] = 0.f; } if (!(r <= fr)) { mbr[e] = 0.f; mkr[e] = 0.f; } }
                *(LAS f32x4*)(ws + (fr * 16 + 4 * g) * 4) = nab;
                { const bool off = (g != (fr >> 2)); v4u o; o.x = off ? pk2hw(nab.x, nab.y) : 0u; o.y = off ? pk2hw(nab.z, nab.w) : 0u; o.z = 0u; o.w = 0u; *(LAS v4u*)(ws + 1024 + (fr * 4 + g) * 16) = o; }
                { v4u o; o.x = pk2hw(nak.x, nak.y); o.y = pk2hw(nak.z, nak.w); o.z = 0u; o.w = 0u; *(LAS v4u*)(ws + 2048 + (fr * 4 + g) * 16) = o; }
                { v4u o; o.x = pk2hw(mbr.x, mbr.y); o.y = pk2hw(mbr.z, mbr.w); o.z = pk2hw(mkr.x, mkr.y); o.w = pk2hw(mkr.z, mkr.w); *(LAS v4u*)(ws + 4096 + (fr * 4 + g) * 16) = o; }
                LDS_WAIT(); asm volatile("" ::: "memory");
                const f32x4 n1 = *(const LAS f32x4*)(ws + ((4 * g + 1) * 16 + 4 * g) * 4), n2 = *(const LAS f32x4*)(ws + ((4 * g + 2) * 16 + 4 * g) * 4), n3 = *(const LAS f32x4*)(ws + ((4 * g + 3) * 16 + 4 * g) * 4);
                const v4u noff = *(const LAS v4u*)(ws + 1024 + (fr * 4 + g) * 16);
                const f32x4 eye = (f32x4){(4 * g == fr) ? 1.f : 0.f, (4 * g + 1 == fr) ? 1.f : 0.f, (4 * g + 2 == fr) ? 1.f : 0.f, (4 * g + 3 == fr) ? 1.f : 0.f};
                f32x4 L = eye; blocksolve4(L, n1, n2, n3);
#pragma unroll
                for (int it = 0; it < 3; ++it) { v4u lb; lb.x = pk2hw(L.x, L.y); lb.y = pk2hw(L.z, L.w); lb.z = 0u; lb.w = 0u; L = mfma16(noff, lb, eye); blocksolve4(L, n1, n2, n3); }
                { LAS unsigned short* lu = (LAS unsigned short*)(ws + 3072) + (fr >> 2) * 8 + (fr & 3);
                  lu[(4 * g) * 32] = (unsigned short)f2bfhw(L.x); lu[(4 * g + 1) * 32] = (unsigned short)f2bfhw(L.y); lu[(4 * g + 2) * 32] = (unsigned short)f2bfhw(L.z); lu[(4 * g + 3) * 32] = (unsigned short)f2bfhw(L.w); }
                LDS_WAIT(); asm volatile("" ::: "memory");
                v4u tb0, tb1; tb0.x = pk2hw(T[0].x, T[0].y); tb0.y = pk2hw(T[0].z, T[0].w); tb0.z = pk2hw(T[1].x, T[1].y); tb0.w = pk2hw(T[1].z, T[1].w);
                tb1.x = pk2hw(T[2].x, T[2].y); tb1.y = pk2hw(T[2].z, T[2].w); tb1.z = pk2hw(T[3].x, T[3].y); tb1.w = pk2hw(T[3].z, T[3].w);
                const f32x4 Wa = mfma16(xa1, tb1, mfma16(xa0, tb0, zero4)), Wr = mfma16(xr1, tb1, mfma16(xr0, tb0, zero4));
                const v2u vt = *(const LAS v2u*)(bb + O_VT + (16 * wq + fr) * 32 + g * 8);
                v4u vb; vb.x = vt.x; vb.y = vt.y; vb.z = 0u; vb.w = 0u;
                const v4u ng = *(const LAS v4u*)(ws + 2048 + (fr * 4 + g) * 16), lu4 = *(const LAS v4u*)(ws + 3072 + (fr * 4 + g) * 16), my = *(const LAS v4u*)(ws + 4096 + (fr * 4 + g) * 16);
                const f32x4 Gm = mfma16(ng, vb, Wa);
                v4u gb; gb.x = pk2hw(Gm.x, Gm.y); gb.y = pk2hw(Gm.z, Gm.w); gb.z = 0u; gb.w = 0u;
                const f32x4 U = mfma16(lu4, gb, zero4);
                v4u bop; bop.x = pk2hw(U.x, U.y); bop.y = pk2hw(U.z, U.w); bop.z = vt.x; bop.w = vt.y;
                const f32x4 Y = mfma16(my, bop, Wr);
                { LAS float* yb = (LAS float*)(cw + O_YB + (n & 1) * 4096) + (4 * g) * 64 + 16 * wq + fr; yb[0] = Y.x; yb[64] = Y.y; yb[128] = Y.z; yb[192] = Y.w; }
#pragma unroll
                for (int jb = 0; jb < 4; ++jb) { const v4u bkt = *(const LAS v4u*)(bb + O_BKT + ((16 * jb + fr) * 4 + g) * 16);
                    const f32x4 gc = *(const LAS f32x4*)((const LAS float*)(bb + O_GC) + 16 * jb + 4 * g);
                    T[jb] = mfma16(bkt, bop, T[jb]) * gc; }
            }
            if (n >= 1) {
                const f32x4 y4 = *(const LAS f32x4*)((const LAS float*)(cw + O_YB + ((n - 1) & 1) * 4096) + ss * 64 + 4 * g4);
                v2u o; o.x = pk2hw(y4.x, y4.y); o.y = pk2hw(y4.z, y4.w);
                *(GAS v2u*)(Yz + (size_t)scan_row(z, b, (n - 1) * 16 + ss) * D + h * 64 + 4 * g4) = o;
            }
            __syncthreads();
        }
#undef V3_LOAD
#undef V3_PRODUCE
        {
            const f32x4 y4 = *(const LAS f32x4*)((const LAS float*)(cw + O_YB + ((NCH - 1) & 1) * 4096) + ss * 64 + 4 * g4);
            v2u o; o.x = pk2hw(y4.x, y4.y); o.y = pk2hw(y4.z, y4.w);
            *(GAS v2u*)(Yz + (size_t)scan_row(z, b, (NCH - 1) * 16 + ss) * D + h * 64 + 4 * g4) = o;
        }
    }
}
__device__ __forceinline__ void p5a_groupnorm(const Args& a, int lane, int wave, int bid, int G) {
#if MK_SCAN_CHUNKED
    const bf16 *Y0 = slotp(a, 0), *Y1 = slotp(a, 1), *V = slotp(a, 5); bf16* YN = slotp(a, 6);
#else
    const bf16 *Y0 = slotp(a, 5), *Y1 = slotp(a, 6), *V = slotp(a, 4); bf16* YN = slotp(a, 0);
#endif
    const float* BON = (const float*)(a.ws + WS_BON); const float* BON1 = (const float*)(a.ws + WS_INVN); const float* BONP8 = (const float*)((const unsigned char*)a.out + 72 * MiB);
    float lg[16], lb[16];
#pragma unroll
    for (int e = 0; e < 16; ++e) { lg[e] = a.in[I_LNG][16 * lane + e]; lb[e] = a.in[I_LNB][16 * lane + e]; }
    const int NGW = G * NWAVES;
    for (int row = bid * NWAVES + wave; row < NT; row += NGW) {
        const size_t o = (size_t)row * D + 16 * lane;
        float y[16], y1[16], v[16];
        load16(Y0 + o, y); load16(Y1 + o, y1); load16(V + o, v);
        float s = 0.f;
#pragma unroll
        for (int e = 0; e < 16; ++e) { y[e] += y1[e]; s += y[e]; }
        const float mean = quad_sum(s) * (1.f / 64.f); float q = 0.f;
#pragma unroll
        for (int e = 0; e < 16; ++e) { y[e] -= mean; q += y[e] * y[e]; }
        const float rstd = rsqrtf(quad_sum(q) * (1.f / 64.f) + 64e-5f);
#if MK_SCAN_CHUNKED == 2
        float bn = 0.f;
#pragma unroll
        for (int p = 0; p < 8; ++p) bn += BONP8[(size_t)p * NT * 16 + row * 16 + (lane >> 2)];
#else
        const float bn = BON[row * 16 + (lane >> 2)] + BON1[row * 16 + (lane >> 2)];
#endif
#pragma unroll
        for (int e = 0; e < 16; ++e) y[e] = y[e] * rstd * lg[e] + lb[e] + bn * v[e];
        store16(YN + o, y);
    }
}
template <int L> __device__ __forceinline__ void p_router(const Args& a, LAS unsigned char* lds, int tid, int lane, int wave, int bid, int G) {
    constexpr int nrows = (L == 0) ? NT : NLAT;
    LAS float* RW = (LAS float*)lds;
    LAS unsigned* lcnt = (LAS unsigned*)(lds + LDSCTL_OFF) + LC_LCNT;
    const float* rg = a.in[I_RG] + (size_t)L * D * 4; const float* re = a.in[I_RE] + (size_t)L * 4 * D * 8;
    { f32x4 wg[2], we[8][2];
#pragma unroll
      for (int i = 0; i < 2; ++i) wg[i] = *(const GAS f32x4*)(rg + (size_t)(tid + NTHR * i) * 4);
#pragma unroll
      for (int i = 0; i < 8; ++i) { const int idx = tid + NTHR * i, gq = idx >> 10, k = idx & 1023; const float* p = re + (size_t)gq * 8192 + k * 8; we[i][0] = *(const GAS f32x4*)p; we[i][1] = *(const GAS f32x4*)(p + 4); }
#pragma unroll
      for (int i = 0; i < 2; ++i) { const int k0 = tid + NTHR * i, k = ((((k0 & 511) >> 3) + 64 * (2 * (k0 >> 9) + ((k0 >> 2) & 1))) << 2) | (k0 & 3); RW[k] = wg[i].x; RW[1024 + k] = wg[i].y; RW[2048 + k] = wg[i].z; RW[3072 + k] = wg[i].w; }
#pragma unroll
      for (int i = 0; i < 8; ++i) { const int idx = tid + NTHR * i, gq = idx >> 10, k0 = idx & 1023, k = ((((k0 & 511) >> 3) + 64 * (2 * (k0 >> 9) + ((k0 >> 2) & 1))) << 2) | (k0 & 3); LAS float* d = RW + (4 + gq * 8) * 1024 + k;
          d[0] = we[i][0].x; d[1024] = we[i][0].y; d[2048] = we[i][0].z; d[3072] = we[i][0].w; d[4096] = we[i][1].x; d[5120] = we[i][1].y; d[6144] = we[i][1].z; d[7168] = we[i][1].w; } }
    if (tid < 32) lcnt[tid] = 0u;
    LAS float* rbias = (LAS float*)(lds + LDSCTL_OFF) + 216;
    if (tid >= 64 && tid < 100) rbias[tid - 64] = (tid < 68) ? a.in[I_RGB][L * 4 + (tid - 64)] : a.in[I_REB][L * 32 + (tid - 68)];
    for (int i = bid * NTHR + tid; i < MAXSLOT; i += G * NTHR) ((int*)(a.ws + WS_TOK))[i] = 0;
    __syncthreads();
    const bf16* X = slotp(a, 4); bf16* H2 = slotp(a, 6);
    unsigned* ROUTE = (unsigned*)(a.ws + WS_ROUTE);
    const int chunk = (nrows + G - 1) / G;
    f32x4 mgg[4], mhh[4]; int cmr = -1;
    for (int rr = 2 * wave; rr < chunk; rr += 2 * NWAVES) {
        const int lr0 = bid * chunk + rr; if (lr0 >= nrows) break;
        const bool ok1 = (rr + 1 < chunk) && (lr0 + 1 < nrows);
        int rowu[2]; rowu[0] = (L == 0) ? lr0 : lat_row(lr0); rowu[1] = ok1 ? ((L == 0) ? lr0 + 1 : lat_row(lr0 + 1)) : rowu[0];
        f32x4 hu[2][4]; float ss[2]; v2u xraw[2][4];
        ld_row_bf(X + (size_t)rowu[0] * D, lane, xraw[0]); ld_row_bf(X + (size_t)rowu[1] * D, lane, xraw[1]);
#pragma unroll
        for (int u = 0; u < 2; ++u) { ss[u] = 0.f;
#pragma unroll
            for (int j = 0; j < 4; ++j) { hu[u][j] = (f32x4){bflo(xraw[u][j].x), bfhi(xraw[u][j].x), bflo(xraw[u][j].y), bfhi(xraw[u][j].y)}; ss[u] += (hu[u][j].x * hu[u][j].x + hu[u][j].y * hu[u][j].y) + (hu[u][j].z * hu[u][j].z + hu[u][j].w * hu[u][j].w); } }
#pragma unroll
        for (int u = 0; u < 2; ++u) { const float rstd = rsqrtf(wave_sum(ss[u]) * (1.f / D) + 1e-6f); const int mr = mod_row(rowu[u]);
            if (mr != cmr) { cmr = mr;
                const float* g = a.in[I_N2G] + L * D; const float* sh = modp(a, L, mr, 3); const float* sc = modp(a, L, mr, 4);
#pragma unroll
                for (int j = 0; j < 4; ++j) { const int c = colb(lane, j); mgg[j] = *(const GAS f32x4*)(g + c) * (*(const GAS f32x4*)(sc + c) + 1.f); mhh[j] = *(const GAS f32x4*)(sh + c); } }
#pragma unroll
            for (int j = 0; j < 4; ++j) hu[u][j] = (hu[u][j] * rstd) * mgg[j] + mhh[j];
            if (u == 0 || ok1) store_row_bf16(H2 + (size_t)rowu[u] * D, lane, hu[u]); }
        const LAS f32x4* W4 = (const LAS f32x4*)RW;
        float gl[2][4];
        { float pg[8];
#pragma unroll
        for (int o = 0; o < 4; ++o) { float p0 = 0.f, p1 = 0.f;
#pragma unroll
            for (int j = 0; j < 4; ++j) { const f32x4 w = W4[o * 256 + lane + 64 * j]; p0 = __builtin_fmaf(hu[0][j].w, w.w, __builtin_fmaf(hu[0][j].z, w.z, __builtin_fmaf(hu[0][j].y, w.y, __builtin_fmaf(hu[0][j].x, w.x, p0)))); p1 = __builtin_fmaf(hu[1][j].w, w.w, __builtin_fmaf(hu[1][j].z, w.z, __builtin_fmaf(hu[1][j].y, w.y, __builtin_fmaf(hu[1][j].x, w.x, p1)))); }
            pg[o] = p0; pg[4 + o] = p1; }
        wave_sum_n(pg);
#pragma unroll
        for (int o = 0; o < 4; ++o) { gl[0][o] = pg[o] + rbias[o]; gl[1][o] = pg[4 + o] + rbias[o]; } }
#pragma unroll
        for (int u = 0; u < 2; ++u) {
        if (u == 1 && !ok1) break;
        const int row = rowu[u];
        int gi = 0; float gm = gl[u][0];
#pragma unroll
        for (int o = 1; o < 4; ++o) if (gl[u][o] > gm) { gm = gl[u][o]; gi = o; }
        float gs = 0.f;
#pragma unroll
        for (int o = 0; o < 4; ++o) gs += __expf(gl[u][o] - gm);
        const float gwt = 1.f / gs;
        float el[8];
#pragma unroll
        for (int e = 0; e < 8; ++e) { float p = 0.f; const int o = 4 + gi * 8 + e;
#pragma unroll
            for (int j = 0; j < 4; ++j) { const f32x4 w = W4[o * 256 + lane + 64 * j]; p = __builtin_fmaf(hu[u][j].w, w.w, __builtin_fmaf(hu[u][j].z, w.z, __builtin_fmaf(hu[u][j].y, w.y, __builtin_fmaf(hu[u][j].x, w.x, p)))); }
            el[e] = p; }
        wave_sum_n(el);
#pragma unroll
        for (int e = 0; e < 8; ++e) el[e] += rbias[4 + gi * 8 + e];
        int i0 = 0; float m0 = el[0];
#pragma unroll
        for (int e = 1; e < 8; ++e) if (el[e] > m0) { m0 = el[e]; i0 = e; }
        int i1 = -1; float m1 = -3.0e38f;
#pragma unroll
        for (int e = 0; e < 8; ++e) if (e != i0 && el[e] > m1) { m1 = el[e]; i1 = e; }
        const float t1 = __expf(m1 - m0);
        const float w0 = gwt / (1.f + t1), w1 = gwt * t1 / (1.f + t1);
        if (lane == 0) {
            const unsigned e0 = (unsigned)(gi * 8 + i0), e1 = (unsigned)(gi * 8 + i1);
            const unsigned r0 = __hip_atomic_fetch_add(lcnt + e0, 1u, __ATOMIC_RELAXED, __HIP_MEMORY_SCOPE_WORKGROUP);
            const unsigned r1 = __hip_atomic_fetch_add(lcnt + e1, 1u, __ATOMIC_RELAXED, __HIP_MEMORY_SCOPE_WORKGROUP);
            v4u q0; q0.x = e0; q0.y = e1; q0.z = r0; q0.w = r1;
            v4u q1; q1.x = __builtin_bit_cast(unsigned, w0); q1.y = __builtin_bit_cast(unsigned, w1); q1.z = 0u; q1.w = 0u;
            *(GAS v4u*)(ROUTE + (size_t)row * 8) = q0; *(GAS v4u*)(ROUTE + (size_t)row * 8 + 4) = q1;
        }
        }
    }
    __syncthreads();
    if (tid < 32) { unsigned* gcnt = (unsigned*)(a.ws + WS_CTL) + CW_CNT + 64 * L;
        const unsigned base = __hip_atomic_fetch_add(gcnt + tid, lcnt[tid], __ATOMIC_RELAXED, __HIP_MEMORY_SCOPE_AGENT);
        ((unsigned*)(a.ws + WS_BLKBASE))[bid * 32 + tid] = base; }
}
template <int L> __device__ __forceinline__ void moe_tables(const Args& a, LAS unsigned char* lds, int tid) {
    LAS int* seg = (LAS int*)(lds + LDSCTL_OFF) + LC_SEG; LAS int* ntl = (LAS int*)(lds + LDSCTL_OFF) + LC_NT; LAS unsigned char* te = lds + LDSCTL_OFF + LC_TILE_B;
    if (tid < 64) {
        const unsigned* gcnt = (const unsigned*)(a.ws + WS_CTL) + CW_CNT + 64 * L;
        const int c = (tid < 32) ? (int)__hip_atomic_load(gcnt + tid, RLX_AGENT) : 0; const int nt = (c + 255) >> 8;
        int incl = nt;
#pragma unroll
        for (int d = 1; d < 32; d <<= 1) { const int t = __shfl_up(incl, d); if (tid >= d) incl += t; }
        const int run = incl - nt, total = __shfl(incl, 31);
        if (tid < 32) { seg[tid] = run * 256; for (int t = 0; t < nt && run + t < 352; ++t) te[run + t] = (unsigned char)tid; }
        if (tid == 0) *ntl = total < 352 ? total : 352;
    }
    __syncthreads();
}
template <int L> __device__ __forceinline__ void p_dispatch(const Args& a, LAS unsigned char* lds, int tid, int lane, int wave, int bid, int G) {
    constexpr int nrows = (L == 0) ? NT : NLAT;
    moe_tables<L>(a, lds, tid);
    const LAS int* seg = (const LAS int*)(lds + LDSCTL_OFF) + LC_SEG;
    const unsigned* ROUTE = (const unsigned*)(a.ws + WS_ROUTE); const unsigned* BB = (const unsigned*)(a.ws + WS_BLKBASE);
    int* TS = (int*)(a.ws + WS_TOKSLOT); int* TOK = (int*)(a.ws + WS_TOK);
    const int chunk = (nrows + G - 1) / G;
    for (int lr = bid * NTHR + tid; lr < nrows; lr += G * NTHR) {
        const int row = (L == 0) ? lr : lat_row(lr); const int blk = lr / chunk;
        const v4u q0 = *(const GAS v4u*)(ROUTE + (size_t)row * 8);
        const int s0 = seg[q0.x] + (int)BB[blk * 32 + q0.x] + (int)q0.z, s1 = seg[q0.y] + (int)BB[blk * 32 + q0.y] + (int)q0.w;
        if (s0 < MAXSLOT && s1 < MAXSLOT) { TS[row * 2] = s0; TS[row * 2 + 1] = s1; TOK[s0] = row; TOK[s1] = row; }
    }
}
__device__ __forceinline__ void p11_combine_mod(const Args& a, int lane, int wave, int bid, int G) {
    bf16* X = slotp(a, 4); const bf16* YS = (const bf16*)(a.ws + WS_XS); const int* TS = (const int*)(a.ws + WS_TOKSLOT); bf16* H1 = slotp(a, 6);
    const float* RW = (const float*)(a.ws + WS_ROUTE);
    const int NGW = G * NWAVES; constexpr int CU_ = 4;
    for (int gi = bid * NWAVES + wave; gi < NT / CU_; gi += NGW) {
        const int row0 = CU_ * gi, mr = mod_row(row0);
        int s0[CU_], s1[CU_]; float w0[CU_], w1[CU_];
#pragma unroll
        for (int u = 0; u < CU_; ++u) { const int row = row0 + u; const v2u ts = *(const GAS v2u*)(TS + row * 2); const f32x2_t w = *(const GAS f32x2_t*)(RW + (size_t)row * 8 + 4);
            s0[u] = (int)ts.x; s1[u] = (int)ts.y; w0[u] = w.x; w1[u] = w.y; }
        v2u x[CU_][4], y0[CU_][4], y1[CU_][4];
#pragma unroll
        for (int u = 0; u < CU_; ++u)
            { ld_row_bf(X + (size_t)(row0 + u) * D, lane, x[u]); ld_row_bf(YS + (size_t)s0[u] * D, lane, y0[u]); ld_row_bf(YS + (size_t)s1[u] * D, lane, y1[u]); }
        const float* g2 = modp(a, 0, mr, 5);
        f32x4 v[CU_][4]; float ss[CU_]; v2u xo[CU_][4];
#pragma unroll
        for (int j = 0; j < 4; ++j) { const int c = colb(lane, j); const f32x4 gv = *(const GAS f32x4*)(g2 + c);
#pragma unroll
            for (int u = 0; u < CU_; ++u) {
                const f32x4 f = (f32x4){w0[u] * bflo(y0[u][j].x) + w1[u] * bflo(y1[u][j].x), w0[u] * bfhi(y0[u][j].x) + w1[u] * bfhi(y1[u][j].x), w0[u] * bflo(y0[u][j].y) + w1[u] * bflo(y1[u][j].y), w0[u] * bfhi(y0[u][j].y) + w1[u] * bfhi(y1[u][j].y)};
                const f32x4 xv = (f32x4){bflo(x[u][j].x), bfhi(x[u][j].x), bflo(x[u][j].y), bfhi(x[u][j].y)};
                v[u][j] = xv + gv * f;
                xo[u][j].x = pk2(v[u][j].x, v[u][j].y); xo[u][j].y = pk2(v[u][j].z, v[u][j].w);
                const float q = (v[u][j].x * v[u][j].x + v[u][j].y * v[u][j].y) + (v[u][j].z * v[u][j].z + v[u][j].w * v[u][j].w); ss[u] = (j == 0) ? q : ss[u] + q; } }
#pragma unroll
        for (int u = 0; u < CU_; ++u) st_row_bf(X + (size_t)(row0 + u) * D, lane, xo[u]);
        float rstd[CU_];
#pragma unroll
        for (int u = 0; u < CU_; ++u) rstd[u] = rsqrtf(wave_sum(ss[u]) * (1.f / D) + 1e-6f);
        const float* g = a.in[I_N1G] + D; const float* sh = modp(a, 1, mr, 0); const float* sc = modp(a, 1, mr, 1);
#pragma unroll
        for (int j = 0; j < 4; ++j) { const int c = colb(lane, j); const f32x4 gg = *(const GAS f32x4*)(g + c) * (*(const GAS f32x4*)(sc + c) + 1.f), hh = *(const GAS f32x4*)(sh + c);
#pragma unroll
            for (int u = 0; u < CU_; ++u) { const f32x4 h = (v[u][j] * rstd[u]) * gg + hh; xo[u][j].x = pk2(h.x, h.y); xo[u][j].y = pk2(h.z, h.w); } }
#pragma unroll
        for (int u = 0; u < CU_; ++u) st_row_bf(H1 + (size_t)(row0 + u) * D, lane, xo[u]);
    }
}
__device__ __forceinline__ void p12b_qknorm_rope(const Args& a, int lane, int wave, int bid, int G) {
    bf16 *Q = slotp(a, 0), *K = slotp(a, 1);
    const int ls = lane & 3, axis = ls >> 1, half = ls & 1;
    float qg[16], kg[16], inv[16];
#pragma unroll
    for (int e = 0; e < 16; ++e) { qg[e] = a.in[I_QNG][16 * ls + e]; kg[e] = a.in[I_KNG][16 * ls + e]; inv[e] = exp2f(-(float)e * (13.287712379549449f / 16.f)); }
    const int NGW = G * NWAVES;
    for (int row = bid * NWAVES + wave; row < NT; row += NGW) {
        const int t = row % TT; const size_t o = (size_t)row * D + 16 * lane;
        float q[16], k[16];
        load16(Q + o, q); load16(K + o, k);
        float sq = 0.f, sk = 0.f;
#pragma unroll
        for (int e = 0; e < 16; ++e) { sq += q[e] * q[e]; sk += k[e] * k[e]; }
        const float rq = rsqrtf(quad_sum(sq) * (1.f / 64.f) + 1e-6f), rk = rsqrtf(quad_sum(sk) * (1.f / 64.f) + 1e-6f);
#pragma unroll
        for (int e = 0; e < 16; ++e) { q[e] = q[e] * rq * qg[e]; k[e] = k[e] * rk * kg[e]; }
        if (t >= TC) {
            const int tl = t - TC; const float pos = (float)(axis ? (tl & 63) : (tl >> 6));
#pragma unroll
            for (int e = 0; e < 16; ++e) { const float ang = pos * inv[e]; const float c = __cosf(ang), s = __sinf(ang);
                const float pq = __shfl_xor(q[e], 1), pk = __shfl_xor(k[e], 1);
                q[e] = half ? (pq * s + q[e] * c) : (q[e] * c - pq * s);
                k[e] = half ? (pk * s + k[e] * c) : (k[e] * c - pk * s); }
        }
#pragma unroll
        for (int e = 0; e < 16; ++e) q[e] *= 0.18033688011112042f;
        store16(Q + o, q); store16(K + o, k);
    }
}
__device__ __forceinline__ void p12c_vtranspose(const Args& a, LAS unsigned char* lds, int lane, int wave, int bid, int G) {
    const bf16* V = slotp(a, 2); bf16* VT = slotp(a, 6);
    LAS unsigned short* T = (LAS unsigned short*)(lds + wave * 16384);
    const int NGW = G * NWAVES;
    for (int u = bid * NWAVES + wave; u < NB * 8 * (TT / 64); u += NGW) {
        const int b = u / (8 * (TT / 64)), rem = u - b * (8 * (TT / 64)), h = rem / (TT / 64), kc = rem - h * (TT / 64);
#pragma unroll 4
        for (int i = 0; i < 16; ++i) { const int chunk = i * 64 + lane, key = chunk >> 4, cg = chunk & 15;
            const v4u w = *(const GAS v4u*)(V + (size_t)(b * TT + kc * 64 + key) * D + h * 128 + cg * 8);
            const int kq = key & 15, pos = (key & ~15) | (kq & 3) | ((kq & 4) << 1) | ((kq & 8) >> 1);
            LAS unsigned short* t = T + (cg * 8) * 64 + pos;
            t[0 * 64] = (unsigned short)(w.x & 0xffffu); t[1 * 64] = (unsigned short)(w.x >> 16); t[2 * 64] = (unsigned short)(w.y & 0xffffu); t[3 * 64] = (unsigned short)(w.y >> 16);
            t[4 * 64] = (unsigned short)(w.z & 0xffffu); t[5 * 64] = (unsigned short)(w.z >> 16); t[6 * 64] = (unsigned short)(w.w & 0xffffu); t[7 * 64] = (unsigned short)(w.w >> 16); }
        LDS_WAIT(); asm volatile("" ::: "memory");
#pragma unroll 4
        for (int i = 0; i < 16; ++i) { const int chunk = i * 64 + lane, e = chunk >> 3, c8 = chunk & 7;
            const v4u o = *(const LAS v4u*)(T + e * 64 + c8 * 8);
            *(GAS v4u*)(VT + ((size_t)((b * 8 + h) * 128 + e)) * TT + kc * 64 + c8 * 8) = o; }
        LDS_WAIT(); asm volatile("" ::: "memory");
    }
}
typedef float f32x16 __attribute__((ext_vector_type(16)));
typedef short s16x8 __attribute__((ext_vector_type(8)));
__device__ __forceinline__ unsigned cvtpk(float lo, float hi) { unsigned r; asm volatile("v_cvt_pk_bf16_f32 %0, %1, %2" : "=v"(r) : "v"(lo), "v"(hi)); return r; }
__device__ __forceinline__ s16x8 pack_p(const f32x16& x, int s8) { v4u w; w.x = cvtpk(x[s8], x[s8 + 1]); w.y = cvtpk(x[s8 + 2], x[s8 + 3]); w.z = cvtpk(x[s8 + 4], x[s8 + 5]); w.w = cvtpk(x[s8 + 6], x[s8 + 7]); return __builtin_bit_cast(s16x8, w); }
__device__ __forceinline__ void p13_attention(const Args& a, LAS unsigned char* lds, int tid, int lane, int wave, int bid, int G) {
    const bf16 *Q = slotp(a, 0), *K = slotp(a, 1), *V = slotp(a, 2); bf16* AO = slotp(a, 6);
    constexpr int KP = 144, VP = 320, KBYTES = 64 * KP, STAGE = KBYTES + 64 * VP, NTILE = TT / 64, XOFF = 2 * STAGE, XP = 272;
    typedef short s16x4 __attribute__((ext_vector_type(4)));
    const int r32 = lane & 31, hh = lane >> 5;
    const float lam_init = 0.8f - 0.6f * expf(-0.3f);
    float d1 = 0.f, d2 = 0.f;
    for (int e = 0; e < 64; ++e) { d1 += a.in[I_LQ1][e] * a.in[I_LK1][e]; d2 += a.in[I_LQ2][e] * a.in[I_LK2][e]; }
    const float lam = expf(d1) - expf(d2) + lam_init;
    const int kkey = tid >> 3, kc8 = tid & 7, vkey = tid >> 4, vch = tid & 15;
    const unsigned klds = (unsigned)(kkey * KP + kc8 * 16), vlds0 = (unsigned)(KBYTES + vkey * VP + vch * 16), vlds1 = vlds0 + 32 * VP;
    const unsigned vrd = (unsigned)((4 * hh + ((lane & 15) >> 2)) * VP + (16 * ((lane >> 4) & 1) + 4 * (lane & 3)) * 2);
    LAS unsigned char* xw = lds + XOFF + (wave * 32 + r32) * XP;
    for (int unit = bid; unit < NB * 8 * 8; unit += G) {
        const int b = unit >> 6, h = (unit >> 3) & 7, qt = unit & 7;
        const int qrow = b * TT + TC + qt * 256 + wave * 32 + r32;
        const bf16* vg = V + (size_t)(b * TT + vkey) * D + h * 128 + vch * 8;
        f32x16 acc[4];
        float lsum = 0.f;
#pragma unroll 1
        for (int m = 0; m < 2; ++m) {
            s16x8 qf[4];
#pragma unroll
            for (int ks = 0; ks < 4; ++ks) qf[ks] = __builtin_bit_cast(s16x8, *(const GAS v4u*)(Q + (size_t)qrow * D + h * 128 + m * 64 + 16 * ks + 8 * hh));
#pragma unroll
            for (int eb = 0; eb < 4; ++eb)
#pragma unroll
                for (int r = 0; r < 16; ++r) acc[eb][r] = 0.f;
            lsum = 0.f;
            const bf16* kg = K + (size_t)(b * TT + kkey) * D + h * 128 + m * 64 + kc8 * 8;
            v4u sk = *(const GAS v4u*)kg, sv0 = *(const GAS v4u*)vg, sv1 = *(const GAS v4u*)(vg + (size_t)32 * D);
            __syncthreads();
            *(LAS v4u*)(lds + klds) = sk; *(LAS v4u*)(lds + vlds0) = sv0; *(LAS v4u*)(lds + vlds1) = sv1;
            __syncthreads();
            for (int t = 0; t < NTILE; ++t) {
                const bool more = (t + 1 < NTILE);
                if (more) { sk = *(const GAS v4u*)(kg + (size_t)(t + 1) * 64 * D); sv0 = *(const GAS v4u*)(vg + (size_t)(t + 1) * 64 * D); sv1 = *(const GAS v4u*)(vg + (size_t)(t + 1) * 64 * D + (size_t)32 * D); }
                const LAS unsigned char* kb_ = lds + (t & 1) * STAGE; const LAS unsigned char* vb_ = kb_ + KBYTES;
#pragma unroll
                for (int kb = 0; kb < 2; ++kb) {
                    f32x16 x;
#pragma unroll
                    for (int r = 0; r < 16; ++r) x[r] = 0.f;
#pragma unroll
                    for (int ks = 0; ks < 4; ++ks) { const s16x8 kf = *(const LAS s16x8*)(kb_ + (32 * kb + r32) * KP + (16 * ks + 8 * hh) * 2); x = __builtin_amdgcn_mfma_f32_32x32x16_bf16(kf, qf[ks], x, 0, 0, 0); }
#pragma unroll
                    for (int r = 0; r < 16; ++r) { x[r] = __builtin_amdgcn_exp2f(x[r]); lsum += x[r]; }
                    const s16x8 p0 = pack_p(x, 0), p1 = pack_p(x, 8);
#pragma unroll
                    for (int eb = 0; eb < 4; ++eb) {
                        const LAS unsigned char* vp_ = vb_ + vrd + (32 * kb) * VP + eb * 64;
                        const s16x4 t0 = __builtin_amdgcn_ds_read_tr16_b64_v4i16((LAS s16x4*)(vp_)), t1 = __builtin_amdgcn_ds_read_tr16_b64_v4i16((LAS s16x4*)(vp_ + 8 * VP));
                        const s16x4 t2 = __builtin_amdgcn_ds_read_tr16_b64_v4i16((LAS s16x4*)(vp_ + 16 * VP)), t3 = __builtin_amdgcn_ds_read_tr16_b64_v4i16((LAS s16x4*)(vp_ + 24 * VP));
                        const s16x8 vf0 = __builtin_shufflevector(t0, t1, 0, 1, 2, 3, 4, 5, 6, 7), vf1 = __builtin_shufflevector(t2, t3, 0, 1, 2, 3, 4, 5, 6, 7);
                        acc[eb] = __builtin_amdgcn_mfma_f32_32x32x16_bf16(vf0, p0, acc[eb], 0, 0, 0);
                        acc[eb] = __builtin_amdgcn_mfma_f32_32x32x16_bf16(vf1, p1, acc[eb], 0, 0, 0); }
                }
                if (more) { LAS unsigned char* nb_ = lds + ((t + 1) & 1) * STAGE; *(LAS v4u*)(nb_ + klds) = sk; *(LAS v4u*)(nb_ + vlds0) = sv0; *(LAS v4u*)(nb_ + vlds1) = sv1; }
                __syncthreads();
            }
            lsum += __shfl_xor(lsum, 32);
            if (m == 0) {
                const float il = 1.f / lsum;
#pragma unroll
                for (int eb = 0; eb < 4; ++eb)
#pragma unroll
                    for (int g4 = 0; g4 < 4; ++g4) { v2u o; o.x = pk2(acc[eb][4 * g4] * il, acc[eb][4 * g4 + 1] * il); o.y = pk2(acc[eb][4 * g4 + 2] * il, acc[eb][4 * g4 + 3] * il);
                        *(LAS v2u*)(xw + (32 * eb + 8 * g4 + 4 * hh) * 2) = o; }
            }
        }
        const float il1 = lam / lsum;
        float ssq = 0.f;
#pragma unroll
        for (int eb = 0; eb < 4; ++eb)
#pragma unroll
            for (int g4 = 0; g4 < 4; ++g4) { const v2u x0 = *(const LAS v2u*)(xw + (32 * eb + 8 * g4 + 4 * hh) * 2);
                const float o0 = bflo(x0.x) - acc[eb][4 * g4] * il1, o1 = bfhi(x0.x) - acc[eb][4 * g4 + 1] * il1, o2 = bflo(x0.y) - acc[eb][4 * g4 + 2] * il1, o3 = bfhi(x0.y) - acc[eb][4 * g4 + 3] * il1;
                acc[eb][4 * g4] = o0; acc[eb][4 * g4 + 1] = o1; acc[eb][4 * g4 + 2] = o2; acc[eb][4 * g4 + 3] = o3; ssq += (o0 * o0 + o1 * o1) + (o2 * o2 + o3 * o3); }
        ssq += __shfl_xor(ssq, 32);
        const float rstd = rsqrtf(ssq * (1.f / 128.f) + 1e-6f) * (1.f - lam_init);
#pragma unroll
        for (int eb = 0; eb < 4; ++eb)
#pragma unroll
            for (int g4 = 0; g4 < 4; ++g4) { const int e0 = 32 * eb + 8 * g4 + 4 * hh; const f32x4 sg = *(const GAS f32x4*)(a.in[I_SUBG] + e0);
                v2u o; o.x = pk2(acc[eb][4 * g4] * rstd * sg.x, acc[eb][4 * g4 + 1] * rstd * sg.y); o.y = pk2(acc[eb][4 * g4 + 2] * rstd * sg.z, acc[eb][4 * g4 + 3] * rstd * sg.w);
                *(GAS v2u*)(AO + (size_t)qrow * D + h * 128 + e0) = o; }
    }
}
__device__ __forceinline__ void p19_final(const Args& a, int lane, int wave, int bid, int G) {
    const bf16* X = slotp(a, 4); const bf16* YS = (const bf16*)(a.ws + WS_XS); const int* TS = (const int*)(a.ws + WS_TOKSLOT);
    const float* RW = (const float*)(a.ws + WS_ROUTE);
    const int NGW = G * NWAVES;
    for (int gi = bid * NWAVES + wave; gi < NLAT / 4; gi += NGW) {
        const int lr0 = 4 * gi, b = lr0 >> 11;
        int s0[4], s1[4]; float w0[4], w1[4];
#pragma unroll
        for (int u = 0; u < 4; ++u) { const int row = lat_row(lr0 + u); const v2u ts = *(const GAS v2u*)(TS + row * 2); const f32x2_t w = *(const GAS f32x2_t*)(RW + (size_t)row * 8 + 4);
            s0[u] = (int)ts.x; s1[u] = (int)ts.y; w0[u] = w.x; w1[u] = w.y; }
        v2u x[4][4], y0[4][4], y1[4][4];
#pragma unroll
        for (int u = 0; u < 4; ++u) { const int row = lat_row(lr0 + u);
            { ld_row_bf(X + (size_t)row * D, lane, x[u]); ld_row_bf(YS + (size_t)s0[u] * D, lane, y0[u]); ld_row_bf(YS + (size_t)s1[u] * D, lane, y1[u]); } }
        const float* g2 = modp(a, 1, b, 5);
        f32x4 gv[4];
#pragma unroll
        for (int j = 0; j < 4; ++j) gv[j] = *(const GAS f32x4*)(g2 + colb(lane, j));
#pragma unroll
        for (int u = 0; u < 4; ++u)
#pragma unroll
            for (int j = 0; j < 4; ++j) { const int c = colb(lane, j);
                const f32x4 f = (f32x4){w0[u] * bflo(y0[u][j].x) + w1[u] * bflo(y1[u][j].x), w0[u] * bfhi(y0[u][j].x) + w1[u] * bfhi(y1[u][j].x), w0[u] * bflo(y0[u][j].y) + w1[u] * bflo(y1[u][j].y), w0[u] * bfhi(y0[u][j].y) + w1[u] * bfhi(y1[u][j].y)};
                const f32x4 xv = (f32x4){bflo(x[u][j].x), bfhi(x[u][j].x), bflo(x[u][j].y), bfhi(x[u][j].y)};
                *(GAS f32x4*)(a.out + (size_t)(lr0 + u) * D + c) = xv + gv[j] * f; }
    }
}
__device__ __forceinline__ v4u pack2x4(const f32x4& v0, const f32x4& v1) { v4u w; w.x = pk2(v0.x, v0.y); w.y = pk2(v0.z, v0.w); w.z = pk2(v1.x, v1.y); w.w = pk2(v1.z, v1.w); return w; }
struct F_Lora1 {
    bf16* L1;
    __device__ __forceinline__ void op(int row, int col, const f32x4& v0, const f32x4& v1) const {
        const int t = col >> 8, c = col & 255, rr = row - t * NT; f32x4 x0 = v0, x1 = v1;
        if (c < 128) {
            if (t == 0) { x0 = (f32x4){ftanh(v0.x), ftanh(v0.y), ftanh(v0.z), ftanh(v0.w)}; x1 = (f32x4){ftanh(v1.x), ftanh(v1.y), ftanh(v1.z), ftanh(v1.w)}; }
            else if (t == 2) { x0 = (f32x4){fsigmoid(v0.x), fsigmoid(v0.y), fsigmoid(v0.z), fsigmoid(v0.w)}; x1 = (f32x4){fsigmoid(v1.x), fsigmoid(v1.y), fsigmoid(v1.z), fsigmoid(v1.w)}; }
            *(GAS v4u*)(L1 + (size_t)rr * 512 + t * 128 + c) = pack2x4(x0, x1);
        } else if (t == 2) { *(GAS v4u*)(L1 + (size_t)rr * 512 + 384 + (c - 128)) = (v4u){0u, 0u, 0u, 0u}; }
    }
};
struct F_Rkv {
    bf16* O;
    __device__ __forceinline__ void op(int row, int col, const f32x4& v0, const f32x4& v1) const {
        const int t = col >> 10, c = col & 1023; *(GAS v4u*)(O + (size_t)t * US + (size_t)(row - t * NT) * D + c) = pack2x4(v0, v1); }
};
struct StackOrder : pg8::StaticOrder {
    int per;
    __device__ __forceinline__ bool next(int i, pg8::Unit& u) const { if (!pg8::StaticOrder::next(i, u)) return false; u.pm += (u.pn / per) * (NT / 256); return true; }
};
struct F_Split3 {
    bf16* O; bf16* L1;
    __device__ __forceinline__ void op(int row, int col, const f32x4& v0, const f32x4& v1) const {
        if (col < 3072) { const int t = col >> 10, c = col & 1023; *(GAS v4u*)(O + (size_t)t * US + (size_t)row * D + c) = pack2x4(v0, v1); }
        else { const int cl = col - 3072, reg = cl >> 7; f32x4 x0 = v0, x1 = v1;
            if (reg == 0) { x0 = (f32x4){ftanh(v0.x), ftanh(v0.y), ftanh(v0.z), ftanh(v0.w)}; x1 = (f32x4){ftanh(v1.x), ftanh(v1.y), ftanh(v1.z), ftanh(v1.w)}; }
            else if (reg == 2) { x0 = (f32x4){fsigmoid(v0.x), fsigmoid(v0.y), fsigmoid(v0.z), fsigmoid(v0.w)}; x1 = (f32x4){fsigmoid(v1.x), fsigmoid(v1.y), fsigmoid(v1.z), fsigmoid(v1.w)}; }
            else if (reg == 3) { x0 = (f32x4){0.f, 0.f, 0.f, 0.f}; x1 = x0; }
            *(GAS v4u*)(L1 + (size_t)row * 512 + cl) = pack2x4(x0, x1); }
    }
};
struct F_Lora2 {
    bf16 *DD0, *DD1, *A0, *A1; const float* w0; const float* a0;
    __device__ __forceinline__ void op(int row, int col, const f32x4& v0, const f32x4& v1) const {
        const int t = col >> 10, c = col & 1023;
        bf16* dst = (t == 0) ? DD0 : (t == 1) ? DD1 : (t == 2) ? A0 : A1;
        const float* bias = (t < 2) ? (w0 + t * 1024 + c) : (a0 + (t - 2) * 1024 + c);
        const f32x4 b0 = *(const GAS f32x4*)bias, b1 = *(const GAS f32x4*)(bias + 4);
        float x[8] = {v0.x + b0.x, v0.y + b0.y, v0.z + b0.z, v0.w + b0.w, v1.x + b1.x, v1.y + b1.y, v1.z + b1.z, v1.w + b1.w};
#pragma unroll
        for (int e = 0; e < 8; ++e) { const float sg = fsigmoid(x[e]); x[e] = (t < 2) ? (1.f - fexp(-0.6065306597f * sg)) : sg; }
        *(GAS v4u*)(dst + (size_t)row * D + c) = pack8(x);
    }
};
struct F_Gate {
    const bf16* YN; bf16* Z;
    __device__ __forceinline__ void op(int row, int col, const f32x4& v0, const f32x4& v1) const {
        float y[8]; unpack8(*(const GAS v4u*)(YN + (size_t)row * D + col), y);
        float x[8] = {y[0] * v0.x, y[1] * v0.y, y[2] * v0.z, y[3] * v0.w, y[4] * v1.x, y[5] * v1.y, y[6] * v1.z, y[7] * v1.w};
        *(GAS v4u*)(Z + (size_t)row * D + col) = pack8(x);
    }
};
struct F_Wo0 {
    const float* x; const float* ctx; const float* mod0; bf16* X;
    __device__ __forceinline__ void op(int row, int col, const f32x4& v0, const f32x4& v1) const {
        const int b = row / TT, t = row - b * TT;
        const float* xr = ((t < TC) ? ctx + ((size_t)b * TC + t) * D : x + ((size_t)b * TL + (t - TC)) * D) + col;
        const float* g = mod0 + (size_t)((t < TC) ? 16 : b) * 6144 + 2 * D + col;
        *(GAS v4u*)(X + (size_t)row * D + col) = pack2x4(*(const GAS f32x4*)xr + *(const GAS f32x4*)g * v0, *(const GAS f32x4*)(xr + 4) + *(const GAS f32x4*)(g + 4) * v1);
    }
};
struct F_Wo1 {
    const float* gate; bf16* X;
    __device__ __forceinline__ void op(int row, int col, const f32x4& v0, const f32x4& v1) const {
        const float* g = gate + (size_t)(row / TT) * 6144 + col;
        GAS v4u* p = (GAS v4u*)(X + (size_t)row * D + col); float y[8]; unpack8(*p, y);
        const f32x4 g0 = *(const GAS f32x4*)g, g1 = *(const GAS f32x4*)(g + 4);
        float o[8] = {y[0] + g0.x * v0.x, y[1] + g0.y * v0.y, y[2] + g0.z * v0.z, y[3] + g0.w * v0.w, y[4] + g1.x * v1.x, y[5] + g1.y * v1.y, y[6] + g1.z * v1.z, y[7] + g1.w * v1.w};
        *p = pack8(o);
    }
};
struct F_GateUp {
    bf16* HID;
    __device__ __forceinline__ void op(int row, int col, const f32x4& g, const f32x4& u) const {
        const int hc = (col & 511) >> 1;
        v2u o; o.x = pk2(g.x * fsigmoid(g.x) * u.x, g.y * fsigmoid(g.y) * u.y); o.y = pk2(g.z * fsigmoid(g.z) * u.z, g.w * fsigmoid(g.w) * u.w);
        *(GAS v2u*)(HID + (size_t)row * 256 + hc) = o;
    }
};
struct F_Down {
    bf16* YS;
    __device__ __forceinline__ void op(int row, int col, const f32x4& v0, const f32x4& v1) const { *(GAS v4u*)(YS + (size_t)row * D + (col & 1023)) = pack2x4(v0, v1); }
};
struct EpiQKV {
    static constexpr bool PERM = true, AFTER_DRAIN = false;
    bf16* O; const float* qng; const float* kng; const float* rope;
    __device__ __forceinline__ void operator()(const f32x4 (&acc)[2][2][4][2], const pg8::Unit& u, int wr, int wc, int fr, int fq) const {
        const int row0 = u.pm * pg8::BM + wr * 64 + fr;
        if (u.pn >= 8) {
            const int col0 = (u.pn - 8) * pg8::BM + wc * 32 + 8 * fq;
#pragma unroll
            for (int ai = 0; ai < 2; ++ai)
#pragma unroll
                for (int m = 0; m < 4; ++m)
#pragma unroll
                    for (int bj = 0; bj < 2; ++bj) *(GAS v4u*)(O + (size_t)2 * US + (size_t)(row0 + ai * pg8::HALF + m * 16) * D + col0 + bj * pg8::HALF) = pack2x4(acc[ai][bj][m][0], acc[ai][bj][m][1]);
            return;
        }
        const bool isq = u.pn < 4;
        const int A = fq >> 1, B = fq & 1, e0 = 32 * A + 8 * B;
        bf16* dst = O + (isq ? (size_t)0 : US) + (u.pn & 3) * pg8::BM + 64 * wc + e0;
        const float* gn = (isq ? qng : kng) + e0;
        const float qs = isq ? 0.18033688011112042f : 1.f;
        const f32x4 gl0 = *(const GAS f32x4*)gn * qs, gl1 = *(const GAS f32x4*)(gn + 4) * qs, gh0 = *(const GAS f32x4*)(gn + 16) * qs, gh1 = *(const GAS f32x4*)(gn + 20) * qs;
        const int tb = u.pm % 9;
#pragma unroll
        for (int ai = 0; ai < 2; ++ai)
#pragma unroll
            for (int m = 0; m < 4; ++m) {
                f32x4 l0 = acc[ai][0][m][0], l1 = acc[ai][0][m][1], h0 = acc[ai][1][m][0], h1 = acc[ai][1][m][1];
                float ss = ((l0.x * l0.x + l0.y * l0.y) + (l0.z * l0.z + l0.w * l0.w)) + ((l1.x * l1.x + l1.y * l1.y) + (l1.z * l1.z + l1.w * l1.w))
                         + ((h0.x * h0.x + h0.y * h0.y) + (h0.z * h0.z + h0.w * h0.w)) + ((h1.x * h1.x + h1.y * h1.y) + (h1.z * h1.z + h1.w * h1.w));
                ss = rows4_sum(ss);
                const float rstd = rsqrtf(ss * (1.f / 64.f) + 1e-6f);
                l0 = l0 * rstd * gl0; l1 = l1 * rstd * gl1; h0 = h0 * rstd * gh0; h1 = h1 * rstd * gh1;
                if (tb != 0) {
                    const int pos = A ? (16 * m + fr) : (4 * (tb - 1) + wr + 2 * ai);
                    const float* rp = rope + pos * 32 + B * 16;
                    const f32x4 c0 = *(const GAS f32x4*)rp, c1 = *(const GAS f32x4*)(rp + 4), s0 = *(const GAS f32x4*)(rp + 8), s1 = *(const GAS f32x4*)(rp + 12);
                    const f32x4 nl0 = l0 * c0 - h0 * s0, nl1 = l1 * c1 - h1 * s1, nh0 = h0 * c0 + l0 * s0, nh1 = h1 * c1 + l1 * s1;
                    l0 = nl0; l1 = nl1; h0 = nh0; h1 = nh1;
                }
                bf16* d = dst + (size_t)(row0 + ai * pg8::HALF + m * 16) * D;
                *(GAS v4u*)d = pack2x4(l0, l1); *(GAS v4u*)(d + 16) = pack2x4(h0, h1);
            }
    }
};
struct EpiWo1 {
    static constexpr bool PERM = true, AFTER_DRAIN = false;
    const float* gate; bf16* X;
    __device__ __forceinline__ void operator()(const f32x4 (&acc)[2][2][4][2], const pg8::Unit& u, int wr, int wc, int fr, int fq) const {
        const int row0 = u.pm * pg8::BM + wr * 64 + fr, col0 = u.pn * pg8::BM + wc * 32 + 8 * fq;
        const float* g = gate + (size_t)(u.pm / 9) * 6144 + col0;
        f32x4 gv[2][2];
#pragma unroll
        for (int bj = 0; bj < 2; ++bj) { gv[bj][0] = *(const GAS f32x4*)(g + bj * pg8::HALF); gv[bj][1] = *(const GAS f32x4*)(g + bj * pg8::HALF + 4); }
        v4u xv[2][4][2];
#pragma unroll
        for (int ai = 0; ai < 2; ++ai)
#pragma unroll
            for (int m = 0; m < 4; ++m)
#pragma unroll
                for (int bj = 0; bj < 2; ++bj) xv[ai][m][bj] = *(const GAS v4u*)(X + (size_t)(row0 + ai * pg8::HALF + m * 16) * D + col0 + bj * pg8::HALF);
#pragma unroll
        for (int ai = 0; ai < 2; ++ai)
#pragma unroll
            for (int m = 0; m < 4; ++m)
#pragma unroll
                for (int bj = 0; bj < 2; ++bj) { float y[8]; unpack8(xv[ai][m][bj], y); const f32x4 v0 = acc[ai][bj][m][0], v1 = acc[ai][bj][m][1], g0 = gv[bj][0], g1 = gv[bj][1];
                    float o[8] = {y[0] + g0.x * v0.x, y[1] + g0.y * v0.y, y[2] + g0.z * v0.z, y[3] + g0.w * v0.w, y[4] + g1.x * v1.x, y[5] + g1.y * v1.y, y[6] + g1.z * v1.z, y[7] + g1.w * v1.w};
                    *(GAS v4u*)(X + (size_t)(row0 + ai * pg8::HALF + m * 16) * D + col0 + bj * pg8::HALF) = pack8(o); }
    }
};
struct EpiGate {
    static constexpr bool PERM = true, AFTER_DRAIN = false;
    const bf16* YN; bf16* Z;
    __device__ __forceinline__ void operator()(const f32x4 (&acc)[2][2][4][2], const pg8::Unit& u, int wr, int wc, int fr, int fq) const {
        const int row0 = u.pm * pg8::BM + wr * 64 + fr, col0 = u.pn * pg8::BM + wc * 32 + 8 * fq;
#pragma unroll
        for (int ai = 0; ai < 2; ++ai) {
            v4u yv[4][2];
#pragma unroll
            for (int m = 0; m < 4; ++m)
#pragma unroll
                for (int bj = 0; bj < 2; ++bj) yv[m][bj] = *(const GAS v4u*)(YN + (size_t)(row0 + ai * pg8::HALF + m * 16) * D + col0 + bj * pg8::HALF);
#pragma unroll
            for (int m = 0; m < 4; ++m)
#pragma unroll
                for (int bj = 0; bj < 2; ++bj) { float y[8]; unpack8(yv[m][bj], y); const f32x4 v0 = acc[ai][bj][m][0], v1 = acc[ai][bj][m][1];
                    float o[8] = {y[0] * v0.x, y[1] * v0.y, y[2] * v0.z, y[3] * v0.w, y[4] * v1.x, y[5] * v1.y, y[6] * v1.z, y[7] * v1.w};
                    *(GAS v4u*)(Z + (size_t)(row0 + ai * pg8::HALF + m * 16) * D + col0 + bj * pg8::HALF) = pack8(o); }
        }
    }
};
struct EpiWo0 {
    static constexpr bool PERM = true, AFTER_DRAIN = false;
    const float* x; const float* ctx; const float* mod0; bf16* X;
    __device__ __forceinline__ void operator()(const f32x4 (&acc)[2][2][4][2], const pg8::Unit& u, int wr, int wc, int fr, int fq) const {
        const int lrow = wr * 64 + fr, col0 = u.pn * pg8::BM + wc * 32 + 8 * fq;
        const int b = u.pm / 9, tb = u.pm - 9 * b;
        const float* xr0 = ((tb == 0) ? ctx + (size_t)b * TC * D : x + ((size_t)b * TL + (size_t)(tb - 1) * 256) * D) + (size_t)lrow * D + col0;
        const float* g = mod0 + (size_t)((tb == 0) ? 16 : b) * 6144 + 2 * D + col0;
        f32x4 gv[2][2];
#pragma unroll
        for (int bj = 0; bj < 2; ++bj) { gv[bj][0] = *(const GAS f32x4*)(g + bj * pg8::HALF); gv[bj][1] = *(const GAS f32x4*)(g + bj * pg8::HALF + 4); }
#pragma unroll
        for (int ai = 0; ai < 2; ++ai) {
            f32x4 xv[4][2][2];
#pragma unroll
            for (int m = 0; m < 4; ++m)
#pragma unroll
                for (int bj = 0; bj < 2; ++bj) { const float* p = xr0 + (size_t)(ai * pg8::HALF + m * 16) * D + bj * pg8::HALF; xv[m][bj][0] = *(const GAS f32x4*)p; xv[m][bj][1] = *(const GAS f32x4*)(p + 4); }
#pragma unroll
            for (int m = 0; m < 4; ++m)
#pragma unroll
                for (int bj = 0; bj < 2; ++bj)
                    *(GAS v4u*)(X + (size_t)(u.pm * pg8::BM + lrow + ai * pg8::HALF + m * 16) * D + col0 + bj * pg8::HALF) = pack2x4(xv[m][bj][0] + gv[bj][0] * acc[ai][bj][m][0], xv[m][bj][1] + gv[bj][1] * acc[ai][bj][m][1]);
        }
    }
};
struct MoeOrder {
    const LAS unsigned char* te; int nunits, nN, G, c;
    __device__ __forceinline__ bool next(int i, pg8::Unit& u) const { const int L = i * G + c; if (L >= nunits) return false; const int T = L / nN; u.pm = T; u.pn = (int)te[T] * nN + (L - T * nN); return true; }
    __device__ __forceinline__ void a_ready(const pg8::Unit&) const {}
    __device__ __forceinline__ void done(const pg8::Unit&) const {}
};
struct LatOrder {
    int G, c;
    __device__ __forceinline__ bool next(int i, pg8::Unit& u) const { const int L = i * G + c; if (L >= 512) return false; const int q = L >> 2; u.pm = (q >> 3) * 9 + 1 + (q & 7); u.pn = L & 3; return true; }
    __device__ __forceinline__ void a_ready(const pg8::Unit&) const {}
    __device__ __forceinline__ void done(const pg8::Unit&) const {}
};
__device__ __forceinline__ void moe_gather_table(const Args& a, LAS unsigned char* lds, int tid, int bid, int G, int nunits) {
    LAS int* gtab = (LAS int*)(lds + 131072); const int* TOK = (const int*)(a.ws + WS_TOK);
    for (int i = 0; i < 16; ++i) { const int Lu = i * G + bid; if (Lu >= nunits) break; if (tid < 256) gtab[i * 256 + tid] = TOK[(Lu >> 1) * 256 + tid] * 2048; }
    __syncthreads();
}
__device__ __forceinline__ int fresh_lane() { int t = threadIdx.x; asm volatile("" : "+v"(t)); return t & 63; }
__device__ __forceinline__ int fresh_wave() { int t = threadIdx.x; asm volatile("" : "+v"(t)); return __builtin_amdgcn_readfirstlane(t >> 6); }
__global__ void __launch_bounds__(NTHR, 2) mega_fwd(Args args) {
    extern __shared__ __attribute__((aligned(16))) unsigned char lds_raw[];
    LAS unsigned char* lds = (LAS unsigned char*)lds_raw;
    const int tid = threadIdx.x, bid = blockIdx.x, G = gridDim.x;
    { int t0 = threadIdx.x; asm volatile("" : "+v"(t0));
      for (int u = t0; u < (LDS_BYTES - LDSCTL_OFF) / 4; u += NTHR) ((LAS unsigned*)(lds + LDSCTL_OFF))[u] = 0u; }
    __syncthreads();
#if MK_ONE_LAUNCH
    XcdBarrier bar = xcd_barrier_post((unsigned*)(args.ws + WS_CTL) + CW_BAR, (volatile LAS unsigned*)(lds + LDSCTL_OFF) + LC_BAR);
#define GRID_BAR() xcd_barrier(bar)
#else
#define GRID_BAR() do { } while (0)
#endif
    const int lo = args.ph_lo, hi = args.ph_hi;
#define IN(k) (lo <= (k) && (k) < hi)
#define SEAM(k) do { if (IN(k) && IN((k) + 1)) GRID_BAR(); } while (0)
    const Args& a = args;
#define X32 (slotp(a, 4))
#define L1 ((bf16*)(a.ws + WS_L1))
#define te ((const LAS unsigned char*)(lds + LDSCTL_OFF + LC_TILE_B))
#define ntl ((const LAS int*)(lds + LDSCTL_OFF) + LC_NT)

    if (IN(0)) { p0_prologue(a, lds, tid, fresh_lane(), fresh_wave(), bid, G); } SEAM(0);
    if (IN(1)) { p1_modshift(a, fresh_lane(), fresh_wave(), bid, G); } SEAM(1);
    if (IN(2)) {
        pg8::Gemm g{slotp(a, 3), (const bf16*)(a.ws + WS_BT0) + (size_t)3072 * 1024, 1024, 1024}; StackOrder S; S.init(NT, 768, G, bid); S.per = 1;
        pg8::EpiP<F_Lora1> E{{L1}};
        pg8::gemm_phase<pg8::EpiP<F_Lora1>, StackOrder, true, true>(lds, g, S, E);
    } SEAM(2);
    if (IN(3)) {
        pg8::Gemm g{slotp(a, 0), (const bf16*)(a.ws + WS_BT0), 1024, 1024}; StackOrder S; S.init(NT, 3072, G, bid); S.per = 4;
        pg8::EpiP<F_Rkv> E{{slotp(a, 3)}};
        pg8::gemm_phase<pg8::EpiP<F_Rkv>, StackOrder, true, true>(lds, g, S, E);
    } SEAM(3);
#if MK_SCAN_CHUNKED == 2
    if (IN(5)) { p4_scan_v3(a, lds, tid, fresh_lane(), fresh_wave(), bid, G); } SEAM(5);
#elif MK_SCAN_CHUNKED
    if (IN(5)) { p4_scan_chunked(a, lds, tid, fresh_lane(), fresh_wave(), bid, G); } SEAM(5);
#else
    if (IN(5)) { p4_scan(a, lds, tid, fresh_lane(), fresh_wave(), bid, G); } SEAM(5);
#endif
    if (IN(6)) { p5a_groupnorm(a, fresh_lane(), fresh_wave(), bid, G); convert_moe(a, 0, WS_MW0, lds, fresh_wave(), fresh_lane(), bid, G); } SEAM(6);
    if (IN(7)) {
        pg8::Gemm g{L1 + 256, (const bf16*)(a.ws + WS_L2B), 512, 256}; pg8::StaticOrder S; S.init(NT, 1024, G, bid);
        EpiGate E{slotp(a, 6), slotp(a, 0)};
        pg8::gemm_phase<EpiGate, pg8::StaticOrder, true, true>(lds, g, S, E);
    } SEAM(7);
    if (IN(8)) {
        pg8::Gemm g{slotp(a, 0), (const bf16*)(a.ws + WS_WO0), 1024, 1024}; pg8::StaticOrder S; S.init(NT, 1024, G, bid);
        EpiWo0 E{a.in[I_X], a.in[I_CTX], (const float*)(a.ws + WS_MOD), X32};
        pg8::gemm_phase<EpiWo0, pg8::StaticOrder, true, true>(lds, g, S, E);
    } SEAM(8);
    if (IN(9)) { p_router<0>(a, lds, tid, fresh_lane(), fresh_wave(), bid, G); } SEAM(9);
    if (IN(10)) { p_dispatch<0>(a, lds, tid, fresh_lane(), fresh_wave(), bid, G); } SEAM(10);
    if (IN(11)) {
        moe_tables<0>(a, lds, tid);
        moe_gather_table(a, lds, tid, bid, G, *ntl * 2);
        pg8::Gemm g{slotp(a, 6), (const bf16*)(a.ws + WS_MW0), 1024, 1024}; MoeOrder S{te, *ntl * 2, 2, G, bid};
        pg8::EpiP<F_GateUp> E{{(bf16*)(a.ws + WS_HID)}};
        pg8::gemm_phase<pg8::EpiP<F_GateUp>, MoeOrder, true, true, true>(lds, g, S, E);
    } SEAM(11);
    if (IN(12)) {
        moe_tables<0>(a, lds, tid);
        pg8::Gemm g{(const bf16*)(a.ws + WS_HID), (const bf16*)(a.ws + WS_MW0) + (size_t)32 * 512 * 1024, 256, 256}; MoeOrder S{te, *ntl * 4, 4, G, bid};
        pg8::EpiP<F_Down> E{{(bf16*)(a.ws + WS_XS)}};
        pg8::gemm_phase<pg8::EpiP<F_Down>, MoeOrder, true, true>(lds, g, S, E);
    } SEAM(12);
    if (IN(13)) { p11_combine_mod(a, fresh_lane(), fresh_wave(), bid, G); convert_moe(a, 1, WS_MW1, lds, fresh_wave(), fresh_lane(), bid, G); } SEAM(13);
    if (IN(14)) {
        pg8::Gemm g{slotp(a, 6), (const bf16*)(a.ws + WS_WQKV), 1024, 1024}; pg8::StaticOrder S; S.init(NT, 3072, G, bid);
        EpiQKV E{slotp(a, 0), a.in[I_QNG], a.in[I_KNG], (const float*)(a.ws + WS_SW)};
        pg8::gemm_phase<EpiQKV, pg8::StaticOrder, true, true>(lds, g, S, E);
    } SEAM(14);
    if (IN(16)) { p13_attention(a, lds, tid, fresh_lane(), fresh_wave(), bid, G); } SEAM(16);
    if (IN(17)) {
        pg8::Gemm g{slotp(a, 6), (const bf16*)(a.ws + WS_WO1), 1024, 1024}; LatOrder S{G, bid};
        EpiWo1 E{modp(a, 1, 0, 2), X32};
        pg8::gemm_phase<EpiWo1, LatOrder, true, true>(lds, g, S, E);
    } SEAM(17);
    if (IN(18)) { p_router<1>(a, lds, tid, fresh_lane(), fresh_wave(), bid, G); } SEAM(18);
    if (IN(19)) { p_dispatch<1>(a, lds, tid, fresh_lane(), fresh_wave(), bid, G); } SEAM(19);
    if (IN(20)) {
        moe_tables<1>(a, lds, tid);
        moe_gather_table(a, lds, tid, bid, G, *ntl * 2);
        pg8::Gemm g{slotp(a, 6), (const bf16*)(a.ws + WS_MW1), 1024, 1024}; MoeOrder S{te, *ntl * 2, 2, G, bid};
        pg8::EpiP<F_GateUp> E{{(bf16*)(a.ws + WS_HID)}};
        pg8::gemm_phase<pg8::EpiP<F_GateUp>, MoeOrder, true, true, true>(lds, g, S, E);
    } SEAM(20);
    if (IN(21)) {
        moe_tables<1>(a, lds, tid);
        pg8::Gemm g{(const bf16*)(a.ws + WS_HID), (const bf16*)(a.ws + WS_MW1) + (size_t)32 * 512 * 1024, 256, 256}; MoeOrder S{te, *ntl * 4, 4, G, bid};
        pg8::EpiP<F_Down> E{{(bf16*)(a.ws + WS_XS)}};
        pg8::gemm_phase<pg8::EpiP<F_Down>, MoeOrder, true, true>(lds, g, S, E);
    } SEAM(21);
    if (IN(22)) { p19_final(a, fresh_lane(), fresh_wave(), bid, G); }
#undef IN
#undef SEAM
#undef X32
#undef L1
#undef te
#undef ntl
}

extern "C" void kernel_launch(void* const* d_in, const int* in_sizes, int n_in, void* d_out, int out_size, void* d_ws, size_t ws_size, hipStream_t stream) {
    static int grid = 0;
    if (grid == 0) {
        if (n_in != 40 || in_sizes[0] != NLAT * D || out_size != NLAT * D || ws_size < WS_END) {
            fprintf(stderr, "kernel_launch: unexpected shapes (n_in %d, in0 %d, out %d, ws %zu); nothing launched\n", n_in, n_in > 0 ? in_sizes[0] : -1, out_size, ws_size); grid = -1; return; }
        int dev = 0, cus = 0;
        if (hipGetDevice(&dev) != hipSuccess || hipDeviceGetAttribute(&cus, hipDeviceAttributeMultiprocessorCount, dev) != hipSuccess) { grid = -1; return; }
        if (hipFuncSetAttribute((const void*)mega_fwd, hipFuncAttributeMaxDynamicSharedMemorySize, LDS_BYTES) != hipSuccess) { fprintf(stderr, "kernel_launch: hipFuncSetAttribute failed\n"); grid = -1; return; }
        int per_cu = 0;
        if (hipOccupancyMaxActiveBlocksPerMultiprocessor(&per_cu, (const void*)mega_fwd, NTHR, LDS_BYTES) != hipSuccess || per_cu < 1) { fprintf(stderr, "kernel_launch: occupancy query says %d\n", per_cu); }
        (void)hipGetLastError();
        grid = cus < 256 ? cus : 256;
    }
    if (grid < 0) return;
    if (hipMemsetAsync((char*)d_ws + WS_CTL, 0, CTL_ZERO_BYTES, stream) != hipSuccess) return;
    Args a{};
    for (int i = 0; i < 40; ++i) a.in[i] = (const float*)d_in[i];
    a.out = (float*)d_out; a.ws = (unsigned char*)d_ws;
#if MK_ONE_LAUNCH
    a.ph_lo = 0; a.ph_hi = N_PH;
    hipLaunchKernelGGL(mega_fwd, dim3(grid), dim3(NTHR), LDS_BYTES, stream, a);
#else
    for (int p = 0; p < N_PH; ++p) { a.ph_lo = p; a.ph_hi = p + 1; hipLaunchKernelGGL(mega_fwd, dim3(grid), dim3(NTHR), LDS_BYTES, stream, a); }
#endif
}
```

```cpp
#include <hip/hip_runtime.h>
#include <cstdio>
#include <cstdint>

#ifndef MK_SCAN_CHUNKED
#define MK_SCAN_CHUNKED 2
#endif
#ifndef MK_ONE_LAUNCH
#define MK_ONE_LAUNCH 1
#endif
namespace pg8 {
#define PG8_LAS __attribute__((address_space(3)))
typedef unsigned short bf16_t;
typedef short bf16x8 __attribute__((ext_vector_type(8)));
typedef float f32x4 __attribute__((ext_vector_type(4)));
typedef unsigned u32x4 __attribute__((ext_vector_type(4)));
constexpr int BM = 256, BK = 64, HALF = 128, HTB = HALF * BK * 2  , STAGE_BYTES = 8 * HTB, NXCD = 8, WGM = 8;

__host__ __device__ __forceinline__ int lds_byte(int r, int c) { const int st = (r >> 4) * 2 + (c >> 5), rr = r & 15, cc = c & 31, ob = rr * 64 + cc * 2; return st * 1024 + (ob ^ (((ob >> 9) & 1) << 5)); }
__host__ __device__ __forceinline__ void stage_rc(int b, int& R, int& C) { const int st = b / 1024, sb = b % 1024, swz = sb ^ (((sb >> 9) & 1) << 5); R = (st >> 1) * 16 + swz / 64; C = (st & 1) * 32 + (swz % 64) / 2; }
__host__ __device__ __forceinline__ int perm32(int rho) { const int n = rho >> 4, i = rho & 15; return 8 * (i >> 2) + 4 * n + (i & 3); }

struct Unit { int pm, pn; };
struct Gemm { const bf16_t* A; const bf16_t* Bt; int lda, K; };

struct StaticOrder {
    int nM, nN, nwg, G, c;
    __host__ __device__ void init(int M, int N, int G_, int c_) { nM = M / BM; nN = N / BM; nwg = nM * nN; G = G_; c = c_; }
    __host__ __device__ bool next(int i, Unit& u) const {
        const long L = (long)i * G + c; if (L >= nwg) return false;
        int wgid = (int)L; { const int q = nwg / NXCD, r = nwg % NXCD, xcd = wgid % NXCD, off = wgid / NXCD; wgid = (xcd < r ? xcd * (q + 1) : r * (q + 1) + (xcd - r) * q) + off; }
        const int nig = WGM * nN, gid = wgid / nig, fm = gid * WGM, gsz = (nM - fm) < WGM ? (nM - fm) : WGM;
        u.pm = fm + ((wgid % nig) % gsz); u.pn = (wgid % nig) / gsz; return true;
    }
    __device__ __forceinline__ void a_ready(const Unit&) const {}
    __device__ __forceinline__ void done(const Unit&) const {}
};

__device__ __forceinline__ unsigned cvt_pk_bf16(float lo, float hi) { unsigned r; asm volatile("v_cvt_pk_bf16_f32 %0, %1, %2" : "=v"(r) : "v"(lo), "v"(hi)); return r; }
template <class F> struct EpiP {
    static constexpr bool PERM = true, AFTER_DRAIN = false; F f;
    __device__ __forceinline__ void operator()(const f32x4 (&acc)[2][2][4][2], const Unit& u, int wr, int wc, int fr, int fq) const {
        const int row0 = u.pm * BM + wr * 64 + fr, col0 = u.pn * BM + wc * 32 + 8 * fq;
#pragma unroll
        for (int ai = 0; ai < 2; ++ai)
#pragma unroll
            for (int m = 0; m < 4; ++m)
#pragma unroll
                for (int bj = 0; bj < 2; ++bj) f.op(row0 + ai * HALF + m * 16, col0 + bj * HALF, acc[ai][bj][m][0], acc[ai][bj][m][1]);
    }
};
template <class F> struct EpiN {
    static constexpr bool PERM = false, AFTER_DRAIN = false; F f;
    __device__ __forceinline__ void operator()(const f32x4 (&acc)[2][2][4][2], const Unit& u, int wr, int wc, int fr, int fq) const {
        const int row0 = u.pm * BM + wr * 64 + fr, col0 = u.pn * BM + wc * 32 + 4 * fq;
#pragma unroll
        for (int ai = 0; ai < 2; ++ai)
#pragma unroll
            for (int m = 0; m < 4; ++m)
#pragma unroll
                for (int bj = 0; bj < 2; ++bj)
#pragma unroll
                    for (int n = 0; n < 2; ++n) f.op(row0 + ai * HALF + m * 16, col0 + bj * HALF + n * 16, acc[ai][bj][m][n]);
    }
};
template <class Epi, class Sched, bool ALIGN_EPI = false, bool SP2 = false, bool GATHER = false>
__device__ __forceinline__ void gemm_phase(PG8_LAS unsigned char* lds, const Gemm g, const Sched& S, const Epi& E) {
    const int tid = threadIdx.x, wid = __builtin_amdgcn_readfirstlane(tid >> 6), lane = tid & 63, wr = wid >> 2, wc = wid & 3, fr = lane & 15, fq = lane >> 4;
    const int K = g.K, nt = K / BK;
    unsigned voffA[2], voffB[2];
#pragma unroll
    for (int i = 0; i < 2; ++i) { int R, C; stage_rc(tid * 16 + i * 8192, R, C); const int Rb = Epi::PERM ? ((R & ~31) + perm32(R & 31)) : R;
        voffA[i] = (unsigned)(R * g.lda + C) * 2u; voffB[i] = (unsigned)(Rb * K + C) * 2u; }
    const size_t kstep = (size_t)(BK * 2);
    const size_t hstepA = GATHER ? (size_t)0 : (size_t)HALF * g.lda * 2, hstepB = (size_t)HALF * K * 2;
    const size_t tstepA = 2 * hstepA, tstepB = 2 * hstepB;
    unsigned vC[2][2], vN[2][2];
    const PG8_LAS int* gtab = (const PG8_LAS int*)(lds + 131072);
#define PG8_GLOAD(dst, ui_) do { _Pragma("unroll") for (int _h = 0; _h < 2; ++_h) _Pragma("unroll") for (int _i = 0; _i < 2; ++_i) { int R, C; stage_rc(tid * 16 + _i * 8192, R, C); dst[_h][_i] = (unsigned)(gtab[(ui_) * 256 + 128 * _h + R] + C * 2); } } while (0)
#define PG8_STAGE_A(bufoff, gbase, h, nx) do { if constexpr (GATHER) { unsigned _v[2] = {(nx) ? vN[h][0] : vC[h][0], (nx) ? vN[h][1] : vC[h][1]}; PG8_STAGE(bufoff, gbase, _v); } else { PG8_STAGE(bufoff, (gbase) + (h) * hstepA, voffA); } } while (0)
    const unsigned ldsw = (unsigned)wid * 1024u;
    const int aoff = lds_byte(wr * 64 + fr, fq * 8), boff = lds_byte(wc * 32 + fr, fq * 8);
#define PG8_SA(b, h) (((b) * 2 + (h)) * HTB)
#define PG8_SB(b, h) ((4 + (b) * 2 + (h)) * HTB)
#define PG8_STAGE(bufoff, gbase, voff) do { _Pragma("unroll") for (int _i = 0; _i < 2; ++_i) \
        __builtin_amdgcn_global_load_lds((const unsigned*)((const char*)(gbase) + (voff)[_i]), (PG8_LAS unsigned*)(lds + (bufoff) + ldsw + _i * 8192), 16, 0, 0); } while (0)
#define PG8_LDA(dst, b, h) do { _Pragma("unroll") for (int m = 0; m < 4; ++m) _Pragma("unroll") for (int k = 0; k < 2; ++k) dst[m][k] = *(const PG8_LAS bf16x8*)(lds + PG8_SA(b, h) + aoff + m * 2048 + k * 1024); } while (0)
#define PG8_LDB(dst, b, h) do { _Pragma("unroll") for (int n = 0; n < 2; ++n) _Pragma("unroll") for (int k = 0; k < 2; ++k) dst[n][k] = *(const PG8_LAS bf16x8*)(lds + PG8_SB(b, h) + boff + n * 2048 + k * 1024); } while (0)
#define PG8_MMA(ai, bj, At, Bt) do { __builtin_amdgcn_s_setprio(1); _Pragma("unroll") for (int m = 0; m < 4; ++m) _Pragma("unroll") for (int n = 0; n < 2; ++n) _Pragma("unroll") for (int k = 0; k < 2; ++k) \
        acc[ai][bj][m][n] = __builtin_amdgcn_mfma_f32_16x16x32_bf16(Bt[n][k], At[m][k], acc[ai][bj][m][n], 0, 0, 0); __builtin_amdgcn_s_setprio(0); } while (0)
#define PG8_WAIT_V(n) asm volatile("s_waitcnt vmcnt(" #n ")" ::: "memory")
#define PG8_WAIT_L(n) asm volatile("s_waitcnt lgkmcnt(" #n ")" ::: "memory")
#define PG8_BAR __builtin_amdgcn_s_barrier()
#define PG8_SCHED __builtin_amdgcn_sched_barrier(0)
    Unit cur, nxt; int ui = 0;
    if (!S.next(0, cur)) return;
    f32x4 acc[2][2][4][2];
#pragma unroll
    for (int a = 0; a < 2; ++a)
#pragma unroll
        for (int b = 0; b < 2; ++b)
#pragma unroll
            for (int m = 0; m < 4; ++m)
#pragma unroll
                for (int n = 0; n < 2; ++n) acc[a][b][m][n] = (f32x4){0.f, 0.f, 0.f, 0.f};
    bf16x8 At[4][2], B0[2][2], B1[2][2];
    const char* cA = (const char*)g.A + (size_t)cur.pm * tstepA; const char* cB = (const char*)g.Bt + (size_t)cur.pn * tstepB;
    S.a_ready(cur);
    if constexpr (GATHER) { PG8_GLOAD(vC, 0); }
    if constexpr (SP2) {
        PG8_STAGE(PG8_SB(0, 0), cB, voffB); PG8_STAGE(PG8_SB(0, 1), cB + hstepB, voffB); PG8_STAGE_A(PG8_SA(0, 0), cA, 0, false); PG8_STAGE_A(PG8_SA(0, 1), cA, 1, false);
        if (wr == 1) PG8_BAR;
        PG8_WAIT_V(2); PG8_BAR;
        PG8_STAGE(PG8_SB(1, 0), cB + kstep, voffB); PG8_STAGE_A(PG8_SA(1, 0), cA + kstep, 0, false); PG8_STAGE(PG8_SB(1, 1), cB + hstepB + kstep, voffB);
        PG8_WAIT_V(6); PG8_BAR;
    } else {
        PG8_STAGE(PG8_SB(0, 0), cB, voffB); PG8_STAGE(PG8_SA(0, 0), cA, voffA); PG8_STAGE(PG8_SB(0, 1), cB + hstepB, voffB); PG8_STAGE(PG8_SA(0, 1), cA + hstepA, voffA);
        if (wr == 1) PG8_BAR;
        PG8_WAIT_V(4); PG8_BAR;
        PG8_STAGE(PG8_SB(1, 0), cB + kstep, voffB); PG8_STAGE(PG8_SA(1, 0), cA + kstep, voffA); PG8_STAGE(PG8_SB(1, 1), cB + hstepB + kstep, voffB);
        PG8_WAIT_V(6); PG8_BAR;
    }
    for (;;) {
        const bool has_next = S.next(ui + 1, nxt);
        if constexpr (GATHER) { if (has_next) { PG8_GLOAD(vN, ui + 1); } else { vN[0][0] = vC[0][0]; vN[0][1] = vC[0][1]; vN[1][0] = vC[1][0]; vN[1][1] = vC[1][1]; } }
        const char* nA = has_next ? (const char*)g.A + (size_t)nxt.pm * tstepA : cA; const char* nB = has_next ? (const char*)g.Bt + (size_t)nxt.pn * tstepB : cB;
        for (int t = 0; t < nt; t += 2) {
            const bool last = (t == nt - 2);
            const char* a1 = cA + (size_t)(t + 1) * kstep;
            const char* a2 = last ? nA : cA + (size_t)(t + 2) * kstep; const char* b2 = last ? nB : cB + (size_t)(t + 2) * kstep;
            const char* a3 = a2 + kstep; const char* b3 = b2 + kstep;
            if (last && has_next) S.a_ready(nxt);
            if constexpr (SP2) {
            PG8_LDB(B0, 0, 0); PG8_LDB(B1, 0, 1); PG8_SCHED; PG8_LDA(At, 0, 0); PG8_STAGE_A(PG8_SA(1, 1), a1, 1, false);
            PG8_WAIT_V(8); PG8_WAIT_L(0); PG8_BAR; PG8_MMA(0, 0, At, B0); PG8_MMA(0, 1, At, B1); PG8_BAR; PG8_SCHED;
            PG8_LDA(At, 0, 1); PG8_STAGE(PG8_SB(0, 0), b2, voffB); PG8_STAGE(PG8_SB(0, 1), b2 + hstepB, voffB); PG8_STAGE_A(PG8_SA(0, 0), a2, 0, last);
            PG8_WAIT_V(8); PG8_WAIT_L(0); PG8_BAR; PG8_MMA(1, 0, At, B0); PG8_MMA(1, 1, At, B1); PG8_BAR; PG8_SCHED;
            PG8_LDB(B0, 1, 0); PG8_LDB(B1, 1, 1); PG8_SCHED; PG8_LDA(At, 1, 0); PG8_STAGE_A(PG8_SA(0, 1), a2, 1, last);
            PG8_WAIT_V(8); PG8_WAIT_L(0); PG8_BAR; PG8_MMA(0, 0, At, B0); PG8_MMA(0, 1, At, B1); PG8_BAR; PG8_SCHED;
            PG8_LDA(At, 1, 1); PG8_STAGE(PG8_SB(1, 0), b3, voffB); PG8_STAGE(PG8_SB(1, 1), b3 + hstepB, voffB); PG8_STAGE_A(PG8_SA(1, 0), a3, 0, last);
            PG8_WAIT_V(8); PG8_WAIT_L(0); PG8_BAR; PG8_MMA(1, 0, At, B0); PG8_MMA(1, 1, At, B1); PG8_BAR; PG8_SCHED;
            } else {
            PG8_LDB(B0, 0, 0); PG8_SCHED; PG8_LDA(At, 0, 0); PG8_STAGE(PG8_SA(1, 1), a1 + hstepA, voffA);
            PG8_WAIT_L(8); PG8_BAR; PG8_WAIT_L(0); PG8_MMA(0, 0, At, B0); PG8_BAR; PG8_SCHED;
            PG8_LDB(B1, 0, 1); PG8_STAGE(PG8_SB(0, 0), b2, voffB);
            PG8_BAR; PG8_WAIT_L(0); PG8_MMA(0, 1, At, B1); PG8_BAR;
            PG8_LDA(At, 0, 1); PG8_STAGE(PG8_SA(0, 0), a2, voffA);
            PG8_BAR; PG8_WAIT_L(0); PG8_MMA(1, 0, At, B0); PG8_BAR; PG8_SCHED;
            PG8_STAGE(PG8_SB(0, 1), b2 + hstepB, voffB);
            PG8_WAIT_V(6); PG8_BAR; PG8_MMA(1, 1, At, B1); PG8_BAR;
            PG8_LDB(B0, 1, 0); PG8_SCHED; PG8_LDA(At, 1, 0); PG8_STAGE(PG8_SA(0, 1), a2 + hstepA, voffA);
            PG8_WAIT_L(8); PG8_BAR; PG8_WAIT_L(0); PG8_MMA(0, 0, At, B0); PG8_BAR; PG8_SCHED;
            PG8_LDB(B1, 1, 1); PG8_STAGE(PG8_SB(1, 0), b3, voffB);
            PG8_BAR; PG8_WAIT_L(0); PG8_MMA(0, 1, At, B1); PG8_BAR;
            PG8_LDA(At, 1, 1); PG8_STAGE(PG8_SA(1, 0), a3, voffA);
            PG8_BAR; PG8_WAIT_L(0); PG8_MMA(1, 0, At, B0); PG8_BAR; PG8_SCHED;
            PG8_STAGE(PG8_SB(1, 1), b3 + hstepB, voffB);
            PG8_WAIT_V(6); PG8_BAR; PG8_MMA(1, 1, At, B1); PG8_BAR;
            }
        }
        if constexpr (ALIGN_EPI) { if (wr == 0) PG8_BAR; }
        if constexpr (!Epi::AFTER_DRAIN) { E(acc, cur, wr, wc, fr, fq); S.done(cur); }
        if (!has_next) break;
#pragma unroll
        for (int a = 0; a < 2; ++a)
#pragma unroll
            for (int b = 0; b < 2; ++b)
#pragma unroll
                for (int m = 0; m < 4; ++m)
#pragma unroll
                    for (int n = 0; n < 2; ++n) acc[a][b][m][n] = (f32x4){0.f, 0.f, 0.f, 0.f};
        cur = nxt; cA = nA; cB = nB; ++ui;
        if constexpr (GATHER) { vC[0][0] = vN[0][0]; vC[0][1] = vN[0][1]; vC[1][0] = vN[1][0]; vC[1][1] = vN[1][1]; }
        if constexpr (ALIGN_EPI) { if (wr == 1) PG8_BAR; }
    }
    PG8_WAIT_V(0);
    if constexpr (!ALIGN_EPI) { if (wr == 0) PG8_BAR; }
    PG8_BAR;
    if constexpr (Epi::AFTER_DRAIN) { E.fused(acc, cur, wr, wc, fr, fq, lds, wid, lane); S.done(cur); }
#undef PG8_SA
#undef PG8_SB
#undef PG8_STAGE
#undef PG8_STAGE_A
#undef PG8_GLOAD
#undef PG8_LDA
#undef PG8_LDB
#undef PG8_MMA
#undef PG8_WAIT_V
#undef PG8_WAIT_L
#undef PG8_BAR
#undef PG8_SCHED
}
}

constexpr int NWAVES = 8, NTHR = 512;
constexpr int D = 1024, NB = 16, TL = 2048, TC = 256, TT = TL + TC, NT = NB * TT, NLAT = NB * TL;
constexpr int N_PH = 23;
constexpr size_t MiB = 1u << 20;
constexpr size_t US = (size_t)NT * D;
constexpr size_t WS_CTL = 0, CTL_ZERO_BYTES = 1 * MiB;
constexpr size_t WS_MOD = 1 * MiB;
constexpr size_t WS_BT0 = 2 * MiB;
constexpr size_t WS_WO0 = 16 * MiB, WS_WQKV = 18 * MiB, WS_WO1 = 24 * MiB, WS_L2A = 26 * MiB, WS_L2B = 28 * MiB;
constexpr size_t WS_BON = 30 * MiB, WS_INVN = 32 * MiB + 512 * 1024, WS_ROUTE = 35 * MiB, WS_TOKSLOT = 36 * MiB + 512 * 1024, WS_SW = 37 * MiB  , WS_TOK = 37 * MiB + 64 * 1024  , WS_BLKBASE = 37 * MiB + 512 * 1024;
constexpr size_t WS_S0 = 40 * MiB, SLOTB = 72 * MiB;
constexpr size_t WS_L1 = 472 * MiB;
constexpr size_t WS_XS = 40 * MiB, WS_HID = 200 * MiB, WS_MW0 = 240 * MiB, WS_MW1 = 256 * MiB, WS_END = 512 * MiB;
constexpr int MAXSLOT = 81920;
constexpr int CW_TMO = 0, CW_BAR = 4096, CW_CNT = 16384;
constexpr int RING_BYTES = 131072, RW_BYTES = 147456, LDSCTL_OFF = 147456, LDS_BYTES = 147456 + 1024;
constexpr int LC_LCNT = 0, LC_SEG = 32, LC_NT = 64, LC_BAR = 72, LC_TILE_B = 512;

#define GAS __attribute__((address_space(1)))
#define LAS __attribute__((address_space(3)))
typedef unsigned short bf16;
typedef unsigned v4u __attribute__((ext_vector_type(4)));
typedef unsigned v2u __attribute__((ext_vector_type(2)));
typedef float f32x4 __attribute__((ext_vector_type(4)));
#define RLX_AGENT __ATOMIC_RELAXED, __HIP_MEMORY_SCOPE_AGENT
#define LDS_WAIT() asm volatile("s_waitcnt lgkmcnt(0)" ::: "memory")
#define VM_WAIT() asm volatile("s_waitcnt vmcnt(0)" ::: "memory")

__device__ __forceinline__ unsigned f2bf(float f) { unsigned u = __builtin_bit_cast(unsigned, f); return (u + 0x7fffu + ((u >> 16) & 1u)) >> 16; }
__device__ __forceinline__ unsigned pk2(float lo, float hi) { return f2bf(lo) | (f2bf(hi) << 16); }
typedef float f32x2_t __attribute__((ext_vector_type(2)));
typedef __bf16 bf16x2_t __attribute__((ext_vector_type(2)));
__device__ __forceinline__ unsigned pk2hw(float lo, float hi) { const f32x2_t v = {lo, hi}; const bf16x2_t b = __builtin_convertvector(v, bf16x2_t); return __builtin_bit_cast(unsigned, b); }
__device__ __forceinline__ unsigned f2bfhw(float f) { return pk2hw(f, 0.f) & 0xffffu; }
__device__ __forceinline__ float bflo(unsigned w) { return __builtin_bit_cast(float, w << 16); }
__device__ __forceinline__ float bfhi(unsigned w) { return __builtin_bit_cast(float, w & 0xffff0000u); }
__device__ __forceinline__ void unpack8(v4u w, float (&f)[8]) { f[0] = bflo(w.x); f[1] = bfhi(w.x); f[2] = bflo(w.y); f[3] = bfhi(w.y); f[4] = bflo(w.z); f[5] = bfhi(w.z); f[6] = bflo(w.w); f[7] = bfhi(w.w); }
__device__ __forceinline__ v4u pack8(const float (&f)[8]) { v4u w; w.x = pk2(f[0], f[1]); w.y = pk2(f[2], f[3]); w.z = pk2(f[4], f[5]); w.w = pk2(f[6], f[7]); return w; }
__device__ __forceinline__ float fexp(float x) { return __expf(x); }
__device__ __forceinline__ float frcp(float x) { return __builtin_amdgcn_rcpf(x); }
__device__ __forceinline__ float fsigmoid(float x) { return frcp(1.f + fexp(-x)); }
__device__ __forceinline__ float ftanh(float x) { return 1.f - 2.f * frcp(1.f + fexp(2.f * x)); }
template <int CTRL, int ROWMASK> __device__ __forceinline__ float dpp_get(float v) { return __builtin_bit_cast(float, __builtin_amdgcn_update_dpp(0, __builtin_bit_cast(int, v), CTRL, ROWMASK, 0xf, false)); }
__device__ __forceinline__ float wave_sum(float v) {
    v += dpp_get<0xB1, 0xf>(v);
    v += dpp_get<0x4E, 0xf>(v);
    v += dpp_get<0x141, 0xf>(v);
    v += dpp_get<0x140, 0xf>(v);
    v += dpp_get<0x142, 0xa>(v);
    v += dpp_get<0x143, 0xc>(v);
    return __builtin_bit_cast(float, __builtin_amdgcn_readlane(__builtin_bit_cast(int, v), 63));
}
template <int N> __device__ __forceinline__ void wave_sum_n(float (&v)[N]) {
#pragma unroll
    for (int i = 0; i < N; ++i) v[i] += dpp_get<0xB1, 0xf>(v[i]);
#pragma unroll
    for (int i = 0; i < N; ++i) v[i] += dpp_get<0x4E, 0xf>(v[i]);
#pragma unroll
    for (int i = 0; i < N; ++i) v[i] += dpp_get<0x141, 0xf>(v[i]);
#pragma unroll
    for (int i = 0; i < N; ++i) v[i] += dpp_get<0x140, 0xf>(v[i]);
#pragma unroll
    for (int i = 0; i < N; ++i) v[i] += dpp_get<0x142, 0xa>(v[i]);
#pragma unroll
    for (int i = 0; i < N; ++i) v[i] += dpp_get<0x143, 0xc>(v[i]);
#pragma unroll
    for (int i = 0; i < N; ++i) v[i] = __builtin_bit_cast(float, __builtin_amdgcn_readlane(__builtin_bit_cast(int, v[i]), 63));
}
__device__ __forceinline__ float rows4_sum(float x) {
    float p = x, q = x;
    asm volatile("s_nop 1\n\tv_permlane16_swap_b32 %0, %1\n\ts_nop 1" : "+v"(p), "+v"(q));
    const float s1 = p + q; p = s1; q = s1;
    asm volatile("s_nop 1\n\tv_permlane32_swap_b32 %0, %1\n\ts_nop 1" : "+v"(p), "+v"(q));
    return p + q;
}
__device__ __forceinline__ float quad_sum(float v) { v += __shfl_xor(v, 1); v += __shfl_xor(v, 2); return v; }

struct Args { const float* in[40]; float* out; unsigned char* ws; int ph_lo, ph_hi; };

enum { I_X = 0, I_C, I_CTX, I_CCTX, I_N1G, I_N2G, I_WMOD, I_BMOD, I_MU, I_WRKV, I_W0, I_W1, I_W2, I_A0, I_A1, I_A2, I_G1, I_G2, I_KK, I_KA, I_RK, I_LNG, I_LNB, I_RWO,
       I_QKV, I_QNG, I_KNG, I_LQ1, I_LK1, I_LQ2, I_LK2, I_SUBG, I_DWO, I_RG, I_RGB, I_RE, I_REB, I_MG, I_MU_, I_MD };

__device__ __forceinline__ const float* in_row(const Args& a, int row) {
    const int b = row / TT, t = row - b * TT;
    return t < TC ? a.in[I_CTX] + ((size_t)b * TC + t) * D : a.in[I_X] + ((size_t)b * TL + (t - TC)) * D;
}
__device__ __forceinline__ int mod_row(int row) { const int b = row / TT, t = row - b * TT; return t < TC ? 16 : b; }
__device__ __forceinline__ const float* modp(const Args& a, int layer, int mrow, int chunk) { return (const float*)(a.ws + WS_MOD) + ((size_t)(layer * 17 + mrow) * 6 + chunk) * D; }
__device__ __forceinline__ bf16* slotp(const Args& a, int k) { return k < 6 ? (bf16*)(a.ws + WS_S0 + (size_t)k * SLOTB) : (bf16*)a.out; }
__device__ __forceinline__ int lat_row(int lr) { return (lr >> 11) * TT + TC + (lr & 2047); }
#define XB_TMO      128
#define XB_XCNT(j)  (256  + 64 * (j))
#define XB_XSUB(j)  (1280 + 64 * (j))
#define XB_XGEN(j)  (2304 + 64 * (j))
#define XB_TOP      3328
#define XB_TOPGEN   3392
#define XCD_BAR_WORDS 3456
#define XB_SPIN_CAP (1u << 22)

__device__ __forceinline__ unsigned xb_ld(unsigned* p)              { return __hip_atomic_load(p, __ATOMIC_RELAXED, __HIP_MEMORY_SCOPE_AGENT); }
__device__ __forceinline__ unsigned xb_add(unsigned* p, unsigned v) { return __hip_atomic_fetch_add(p, v, __ATOMIC_RELAXED, __HIP_MEMORY_SCOPE_AGENT); }
__device__ __forceinline__ unsigned xb_xcc_id() { return (unsigned)__builtin_amdgcn_s_getreg((3 << 11) | 20) & 0xFu; }
#define XB_SPIN(cond, bar) do { unsigned _sp = 0; while (cond) { __builtin_amdgcn_s_sleep(1); \
    if ((++_sp & 255u) == 0u) { if (xb_ld(&(bar)[XB_TMO])) break; if (_sp > XB_SPIN_CAP) { atomicAdd(&(bar)[XB_TMO], 1u); break; } } } } while (0)

struct XcdBarrier {
    unsigned* bar; unsigned x;
    volatile LAS unsigned* st;
};

__device__ __forceinline__ XcdBarrier xcd_barrier_post(unsigned* bar, volatile LAS unsigned* st) {
    XcdBarrier b; b.bar = bar; b.x = xb_xcc_id(); b.st = st;
    if (threadIdx.x == 0) (void)xb_add(&bar[XB_XCNT(b.x)], 1u);
    return b;
}
__device__ __forceinline__ void xcd_barrier_complete(unsigned* bar, unsigned x, unsigned& nloc, unsigned& nx) {
    const unsigned G = gridDim.x * gridDim.y * gridDim.z;
    unsigned sum, cnt, mine, sp = 0u;
    for (;;) {
        sum = 0u; cnt = 0u; mine = 0u;
#pragma unroll
        for (unsigned j = 0; j < 16; ++j) { const unsigned c = xb_ld(&bar[XB_XCNT(j)]); sum += c; cnt += (c > 0u) ? 1u : 0u; mine = (j == x) ? c : mine; }
        if (sum == G) break;
        __builtin_amdgcn_s_sleep(1);
        if ((++sp & 255u) == 0u) { if (xb_ld(&bar[XB_TMO])) break; if (sp > XB_SPIN_CAP) { atomicAdd(&bar[XB_TMO], 1u); break; } }
    }
    nloc = mine > 0u ? mine : 1u; nx = cnt > 0u ? cnt : 1u;
}

__device__ __forceinline__ void xcd_barrier(const XcdBarrier& b) {
    asm volatile("s_waitcnt vmcnt(0)" ::: "memory");
    __syncthreads();
    if (threadIdx.x == 0) {
        unsigned* bar = b.bar;
        __builtin_amdgcn_s_waitcnt(0);
        unsigned nloc = b.st[0], nx = b.st[1];
        if (nloc == 0u) { xcd_barrier_complete(bar, b.x, nloc, nx); b.st[0] = nloc; b.st[1] = nx; }
        const unsigned old = xb_add(&bar[XB_XSUB(b.x)], 1u);
        const unsigned gen = old / nloc;
        if (old + 1u == (gen + 1u) * nloc) {
            __builtin_amdgcn_fence(__ATOMIC_RELEASE, "agent");
            asm volatile("s_waitcnt vmcnt(0)" ::: "memory");
            const unsigned og = xb_add(&bar[XB_TOP], 1u);
            const unsigned tg = og / nx;
            if (og + 1u == (tg + 1u) * nx) xb_add(&bar[XB_TOPGEN], 1u);
            else XB_SPIN(xb_ld(&bar[XB_TOPGEN]) == tg, bar);
            __builtin_amdgcn_fence(__ATOMIC_ACQUIRE, "agent");
            xb_add(&bar[XB_XGEN(b.x)], 1u);
            asm volatile("s_waitcnt vmcnt(0)" ::: "memory");
        } else {
            XB_SPIN(xb_ld(&bar[XB_XGEN(b.x)]) == gen, bar);
            __builtin_amdgcn_fence(__ATOMIC_ACQUIRE, "agent");
            asm volatile("s_waitcnt vmcnt(0)" ::: "memory");
        }
    }
    __syncthreads();
}

__device__ __forceinline__ void tr_item(const float* W, int N, bf16* WT, int ldt, int row_off, int col_off, const float* ksc, int mode, LAS float* scr, int item, int lane) {
    const int nblk = N >> 5, kb = item / nblk, nb = item - kb * nblk, k0 = 64 * kb, n0 = 32 * nb;
    float tv[32];
#pragma unroll
    for (int i = 0; i < 32; ++i) { const int kk = 2 * i + (lane >> 5); tv[i] = W[(size_t)(k0 + kk) * N + n0 + (lane & 31)]; }
#pragma unroll
    for (int i = 0; i < 32; ++i) { const int kk = 2 * i + (lane >> 5); float v = tv[i]; if (ksc) v *= ksc[k0 + kk]; scr[kk * 33 + (lane & 31)] = v; }
    LDS_WAIT(); asm volatile("" ::: "memory");
    const int c = lane & 7;
#pragma unroll
    for (int j = 0; j < 4; ++j) { const int n = (lane >> 3) + 8 * j; const LAS float* s = scr + (8 * c) * 33 + n;
        v4u o; o.x = pk2(s[0 * 33], s[1 * 33]); o.y = pk2(s[2 * 33], s[3 * 33]); o.z = pk2(s[4 * 33], s[5 * 33]); o.w = pk2(s[6 * 33], s[7 * 33]);
        const int nn = n0 + n; const int drow = (mode == 0) ? nn : (mode == 3) ? ((nn >= 2048) ? nn : ((nn & ~255) + 128 * ((nn >> 4) & 1) + 32 * ((nn >> 6) & 3) + 16 * ((nn >> 5) & 1) + (nn & 15))) : ((nn >> 2) * 8 + (nn & 3) + (mode == 2 ? 4 : 0));
        *(GAS v4u*)(WT + (size_t)(row_off + drow) * ldt + col_off + k0 + 8 * c) = o; }
    LDS_WAIT(); asm volatile("" ::: "memory");
}
__device__ __forceinline__ void run_tr(int& base, const float* W, int K, int N, bf16* WT, int ldt, int row_off, int col_off, const float* ksc, int mode, LAS float* scr, int gw, int NGW, int lane) {
    const int nitems = (K >> 6) * (N >> 5);
    int it = gw - (base % NGW); if (it < 0) it += NGW;
    for (; it < nitems; it += NGW) tr_item(W, N, WT, ldt, row_off, col_off, ksc, mode, scr, it, lane);
    base += nitems;
}
__device__ __forceinline__ void zero_rect(bf16* base, int ld, int r0, int nr, int c0, int nc, int gt, int NGT) {
    const int cpr = nc >> 3, total = nr * cpr;
    for (int i = gt; i < total; i += NGT) { const int r = i / cpr, c = i - r * cpr; *(GAS v4u*)(base + (size_t)(r0 + r) * ld + c0 + 8 * c) = (v4u){0u, 0u, 0u, 0u}; }
}
__device__ __forceinline__ void convert_moe(const Args& a, int layer, size_t ws_off, LAS unsigned char* lds, int wave, int lane, int bid, int G) {
    LAS float* scr = (LAS float*)(lds + wave * 16384);
    const int gw = bid * NWAVES + wave, NGW = G * NWAVES; int base = 0;
    bf16* Wgu = (bf16*)(a.ws + ws_off); bf16* Wd = Wgu + (size_t)32 * 512 * 1024;
    for (int e = 0; e < 32; ++e) {
        const size_t eo = (size_t)(layer * 32 + e) * 1024 * 256;
        run_tr(base, a.in[I_MG] + eo, 1024, 256, Wgu + (size_t)e * 512 * 1024, 1024, 0, 0, nullptr, 1, scr, gw, NGW, lane);
        run_tr(base, a.in[I_MU_] + eo, 1024, 256, Wgu + (size_t)e * 512 * 1024, 1024, 0, 0, nullptr, 2, scr, gw, NGW, lane);
        run_tr(base, a.in[I_MD] + eo, 256, 1024, Wd + (size_t)e * 1024 * 256, 256, 0, 0, nullptr, 0, scr, gw, NGW, lane);
    }
}

__device__ __forceinline__ void p0_prologue(const Args& a, LAS unsigned char* lds, int tid, int lane, int wave, int bid, int G) {
    LAS float* sil = (LAS float*)lds;
    LAS float* part = (LAS float*)(lds + 69632);
    float* MOD = (float*)(a.ws + WS_MOD);
    for (int item = bid; item < 192; item += G) {
        const int l = item / 96, n0 = (item - l * 96) * 64;
        { float cv[34];
#pragma unroll
          for (int q = 0; q < 34; ++q) { const int i = tid + NTHR * q, r = q >> 1, k = i & 1023; cv[q] = (r < 16) ? a.in[I_C][r * 1024 + k] : a.in[I_CCTX][k]; }
#pragma unroll
          for (int q = 0; q < 34; ++q) sil[tid + NTHR * q] = cv[q] / (1.f + expf(-cv[q])); }
        __syncthreads();
        f32x4 acc[17];
#pragma unroll
        for (int r = 0; r < 17; ++r) acc[r] = (f32x4){0.f, 0.f, 0.f, 0.f};
        const int cq = lane & 15, kp = lane >> 4;
        const float* wm = a.in[I_WMOD] + (size_t)l * D * 6144 + n0 + 4 * cq;
#pragma unroll 1
        for (int jb = 0; jb < 4; ++jb) { f32x4 wv[2][4];
#pragma unroll
            for (int jj = 0; jj < 2; ++jj)
#pragma unroll
                for (int i = 0; i < 4; ++i) wv[jj][i] = *(const GAS f32x4*)(wm + (size_t)(128 * wave + 16 * (2 * jb + jj) + 4 * kp + i) * 6144);
#pragma unroll
            for (int jj = 0; jj < 2; ++jj) { const int k = 128 * wave + 16 * (2 * jb + jj) + 4 * kp;
#pragma unroll
                for (int r = 0; r < 17; ++r) { const f32x4 sv = *(const LAS f32x4*)(sil + r * 1024 + k); acc[r] += (wv[jj][0] * sv.x + wv[jj][1] * sv.y) + (wv[jj][2] * sv.z + wv[jj][3] * sv.w); } } }
#pragma unroll
        for (int r = 0; r < 17; ++r) {
#pragma unroll
            for (int c = 0; c < 4; ++c) acc[r][c] = rows4_sum(acc[r][c]);
            if (kp == 0) *(LAS f32x4*)(part + (wave * 17 + r) * 64 + 4 * cq) = acc[r]; }
        __syncthreads();
        for (int i = tid; i < 17 * 64; i += NTHR) { const int r = i >> 6, ln = i & 63; float s = 0.f;
#pragma unroll
            for (int w = 0; w < 8; ++w) s += part[(w * 17 + r) * 64 + ln];
            MOD[(size_t)(l * 17 + r) * 6144 + n0 + ln] = s + a.in[I_BMOD][l * 6144 + n0 + ln]; }
        __syncthreads();
    }
    LAS float* scr = (LAS float*)(lds + wave * 16384);
    const int gw = bid * NWAVES + wave, NGW = G * NWAVES; int base = 0;
    bf16* BT0 = (bf16*)(a.ws + WS_BT0);
    bf16* BLO = BT0 + (size_t)3072 * 1024;
    for (int j = 0; j < 3; ++j) run_tr(base, a.in[I_WRKV] + (size_t)j * D * D, 1024, 1024, BT0, 1024, j * 1024, 0, nullptr, 0, scr, gw, NGW, lane);
    for (int z = 0; z < 2; ++z) {
        run_tr(base, a.in[I_W1] + (size_t)z * D * 64, 1024, 64, BLO, 1024, 64 * z, 0, nullptr, 0, scr, gw, NGW, lane);
        run_tr(base, a.in[I_A1] + (size_t)z * D * 64, 1024, 64, BLO, 1024, 256 + 64 * z, 0, nullptr, 0, scr, gw, NGW, lane);
    }
    run_tr(base, a.in[I_G1], 1024, 128, BLO, 1024, 512, 0, nullptr, 0, scr, gw, NGW, lane);
    run_tr(base, a.in[I_RWO], 1024, 1024, (bf16*)(a.ws + WS_WO0), 1024, 0, 0, nullptr, 0, scr, gw, NGW, lane);
    run_tr(base, a.in[I_QKV], 1024, 3072, (bf16*)(a.ws + WS_WQKV), 1024, 0, 0, nullptr, 3, scr, gw, NGW, lane);
    run_tr(base, a.in[I_DWO], 1024, 1024, (bf16*)(a.ws + WS_WO1), 1024, 0, 0, nullptr, 0, scr, gw, NGW, lane);
    bf16* L2A = (bf16*)(a.ws + WS_L2A); bf16* L2B = (bf16*)(a.ws + WS_L2B);
    for (int z = 0; z < 2; ++z) {
        run_tr(base, a.in[I_W2] + (size_t)z * 64 * D, 64, 1024, L2A, 256, z * 1024, z * 64, nullptr, 0, scr, gw, NGW, lane);
        run_tr(base, a.in[I_A2] + (size_t)z * 64 * D, 64, 1024, L2A, 256, 2048 + z * 1024, 128 + z * 64, nullptr, 0, scr, gw, NGW, lane);
    }
    run_tr(base, a.in[I_G2], 128, 1024, L2B, 256, 0, 0, nullptr, 0, scr, gw, NGW, lane);
    const int gt = bid * NTHR + tid, NGT = G * NTHR;
    for (int i = gt; i < 64 * 16; i += NGT) { const int pos = i >> 4, f = i & 15; const float ang = (float)pos * exp2f(-(float)f * (13.287712379549449f / 16.f));
        float* R = (float*)(a.ws + WS_SW) + pos * 32 + (f >> 3) * 16 + (f & 7); R[0] = __cosf(ang); R[8] = __sinf(ang); }
    zero_rect(BLO, 1024, 128, 128, 0, 1024, gt, NGT); zero_rect(BLO, 1024, 384, 128, 0, 1024, gt, NGT); zero_rect(BLO, 1024, 640, 128, 0, 1024, gt, NGT);
    zero_rect(L2A, 256, 0, 1024, 64, 192, gt, NGT);
    zero_rect(L2A, 256, 1024, 1024, 0, 64, gt, NGT);  zero_rect(L2A, 256, 1024, 1024, 128, 128, gt, NGT);
    zero_rect(L2A, 256, 2048, 1024, 0, 128, gt, NGT); zero_rect(L2A, 256, 2048, 1024, 192, 64, gt, NGT);
    zero_rect(L2A, 256, 3072, 1024, 0, 192, gt, NGT);
    zero_rect(L2B, 256, 0, 1024, 128, 128, gt, NGT);
}

__device__ __forceinline__ int colb(int lane, int j) { return 8 * lane + 512 * (j >> 1) + 4 * (j & 1); }
__device__ __forceinline__ void ld_row_bf(const bf16* row, int lane, v2u (&x)[4]) {
#pragma unroll
    for (int jj = 0; jj < 2; ++jj) { const v4u t = *(const GAS v4u*)(row + 8 * lane + 512 * jj); x[2 * jj] = (v2u){t.x, t.y}; x[2 * jj + 1] = (v2u){t.z, t.w}; } }
__device__ __forceinline__ void st_row_bf(bf16* row, int lane, const v2u (&x)[4]) {
#pragma unroll
    for (int jj = 0; jj < 2; ++jj) { v4u t; t.x = x[2 * jj].x; t.y = x[2 * jj].y; t.z = x[2 * jj + 1].x; t.w = x[2 * jj + 1].y; *(GAS v4u*)(row + 8 * lane + 512 * jj) = t; } }
__device__ __forceinline__ void modulate_row(const float* xr, const float* g, const float* sh, const float* sc, int lane, f32x4 (&h)[4]) {
    f32x4 v[4]; float ss = 0.f;
#pragma unroll
    for (int j = 0; j < 4; ++j) { v[j] = *(const GAS f32x4*)(xr + colb(lane, j)); ss += (v[j].x * v[j].x + v[j].y * v[j].y) + (v[j].z * v[j].z + v[j].w * v[j].w); }
    const float rstd = rsqrtf(wave_sum(ss) * (1.f / D) + 1e-6f);
#pragma unroll
    for (int j = 0; j < 4; ++j) { const int c = colb(lane, j); const f32x4 gv = *(const GAS f32x4*)(g + c), sv = *(const GAS f32x4*)(sc + c), hv = *(const GAS f32x4*)(sh + c);
        h[j] = (v[j] * rstd) * gv * (sv + 1.f) + hv; }
}
__device__ __forceinline__ f32x4 ld4bf(const bf16* p) { const v2u y = *(const GAS v2u*)p; return (f32x4){bflo(y.x), bfhi(y.x), bflo(y.y), bfhi(y.y)}; }
__device__ __forceinline__ void modulate_row_bf(const bf16* xr, const float* g, const float* sh, const float* sc, int lane, f32x4 (&h)[4]) {
    f32x4 v[4]; float ss = 0.f;
    v2u xb_[4]; ld_row_bf(xr, lane, xb_);
#pragma unroll
    for (int j = 0; j < 4; ++j) { v[j] = (f32x4){bflo(xb_[j].x), bfhi(xb_[j].x), bflo(xb_[j].y), bfhi(xb_[j].y)}; ss += (v[j].x * v[j].x + v[j].y * v[j].y) + (v[j].z * v[j].z + v[j].w * v[j].w); }
    const float rstd = rsqrtf(wave_sum(ss) * (1.f / D) + 1e-6f);
#pragma unroll
    for (int j = 0; j < 4; ++j) { const int c = colb(lane, j); const f32x4 gv = *(const GAS f32x4*)(g + c), sv = *(const GAS f32x4*)(sc + c), hv = *(const GAS f32x4*)(sh + c);
        h[j] = (v[j] * rstd) * gv * (sv + 1.f) + hv; }
}
__device__ __forceinline__ void store_row_bf16(bf16* dst, int lane, const f32x4 (&h)[4]) {
#pragma unroll
    for (int jj = 0; jj < 2; ++jj) { v4u o; o.x = pk2hw(h[2 * jj].x, h[2 * jj].y); o.y = pk2hw(h[2 * jj].z, h[2 * jj].w); o.z = pk2hw(h[2 * jj + 1].x, h[2 * jj + 1].y); o.w = pk2hw(h[2 * jj + 1].z, h[2 * jj + 1].w); *(GAS v4u*)(dst + 8 * lane + 512 * jj) = o; }
}
__device__ __forceinline__ void h_l0(const Args& a, int row, int lane, f32x4 (&h)[4]) {
    const int mr = mod_row(row); modulate_row(in_row(a, row), a.in[I_N1G], modp(a, 0, mr, 0), modp(a, 0, mr, 1), lane, h);
}
__device__ __forceinline__ void p1_h(const Args& a, int row, int lane, int& cmr, f32x4 (&gg)[4], f32x4 (&hh)[4], f32x4 (&h)[4]) {
    const float* xr = in_row(a, row); f32x4 v[4]; float ss = 0.f;
#pragma unroll
    for (int j = 0; j < 4; ++j) { v[j] = *(const GAS f32x4*)(xr + colb(lane, j)); ss += (v[j].x * v[j].x + v[j].y * v[j].y) + (v[j].z * v[j].z + v[j].w * v[j].w); }
    const int mr = mod_row(row);
    if (mr != cmr) { cmr = mr; const float* g = a.in[I_N1G]; const float* sh = modp(a, 0, mr, 0); const float* sc = modp(a, 0, mr, 1);
#pragma unroll
        for (int j = 0; j < 4; ++j) { const int c = colb(lane, j); gg[j] = *(const GAS f32x4*)(g + c) * (*(const GAS f32x4*)(sc + c) + 1.f); hh[j] = *(const GAS f32x4*)(sh + c); } }
    const float rstd = rsqrtf(wave_sum(ss) * (1.f / D) + 1e-6f);
#pragma unroll
    for (int j = 0; j < 4; ++j) h[j] = (v[j] * rstd) * gg[j] + hh[j];
}
__device__ __forceinline__ void p1_modshift(const Args& a, int lane, int wave, int bid, int G) {
    const int NGW = G * NWAVES, gw = bid * NWAVES + wave, rpw = (NT + NGW - 1) / NGW, first = gw * rpw, last = (first + rpw < NT) ? first + rpw : NT;
    if (first >= NT) return;
    f32x4 mu[6][4];
#pragma unroll
    for (int m = 0; m < 6; ++m)
#pragma unroll
        for (int j = 0; j < 4; ++j) mu[m][j] = *(const GAS f32x4*)(a.in[I_MU] + m * D + colb(lane, j));
    f32x4 hp[4], hc[4], hn[4], mgg[4], mhh[4]; int cmr = -1;
#pragma unroll
    for (int j = 0; j < 4; ++j) hp[j] = (f32x4){0.f, 0.f, 0.f, 0.f};
    if (first > 0) p1_h(a, first - 1, lane, cmr, mgg, mhh, hp);
    p1_h(a, first, lane, cmr, mgg, mhh, hc);
    for (int row = first; row < last; ++row) {
        const int t = row % TT;
#pragma unroll
        for (int j = 0; j < 4; ++j) hn[j] = (f32x4){0.f, 0.f, 0.f, 0.f};
        if (row + 1 < NT) p1_h(a, row + 1, lane, cmr, mgg, mhh, hn);
        const float lv = (t != 0 && t != TC) ? 0.5f : 0.f, rv = (t != TC - 1 && t != TT - 1) ? 0.5f : 0.f;
        f32x4 dx[4];
#pragma unroll
        for (int j = 0; j < 4; ++j) dx[j] = hp[j] * lv + hn[j] * rv - hc[j];
#pragma unroll
        for (int m = 0; m < 6; ++m) {
            f32x4 mx[4];
#pragma unroll
            for (int j = 0; j < 4; ++j) mx[j] = hc[j] + dx[j] * mu[m][j];
            store_row_bf16(slotp(a, m) + (size_t)row * D, lane, mx);
        }
#pragma unroll
        for (int j = 0; j < 4; ++j) { hp[j] = hc[j]; hc[j] = hn[j]; }
    }
}

__device__ __forceinline__ void load16(const bf16* p, float (&f)[16]) {
    const v4u a = *(const GAS v4u*)p, b = *(const GAS v4u*)(p + 8);
    f[0] = bflo(a.x); f[1] = bfhi(a.x); f[2] = bflo(a.y); f[3] = bfhi(a.y); f[4] = bflo(a.z); f[5] = bfhi(a.z); f[6] = bflo(a.w); f[7] = bfhi(a.w);
    f[8] = bflo(b.x); f[9] = bfhi(b.x); f[10] = bflo(b.y); f[11] = bfhi(b.y); f[12] = bflo(b.z); f[13] = bfhi(b.z); f[14] = bflo(b.w); f[15] = bfhi(b.w);
}
__device__ __forceinline__ void store16(bf16* p, const float (&f)[16]) {
    v4u a, b; a.x = pk2(f[0], f[1]); a.y = pk2(f[2], f[3]); a.z = pk2(f[4], f[5]); a.w = pk2(f[6], f[7]);
    b.x = pk2(f[8], f[9]); b.y = pk2(f[10], f[11]); b.z = pk2(f[12], f[13]); b.w = pk2(f[14], f[15]);
    *(GAS v4u*)p = a; *(GAS v4u*)(p + 8) = b;
}
__device__ __forceinline__ void p3b_invn_bonus(const Args& a, int lane, int wave, int bid, int G) {
    const bf16 *R = slotp(a, 2), *K = slotp(a, 3), *A0 = slotp(a, 0), *A1 = slotp(a, 1);
    float* BON = (float*)(a.ws + WS_BON); float* INVN = (float*)(a.ws + WS_INVN);
    float kkc[16], kac[16], rkc[16];
#pragma unroll
    for (int e = 0; e < 16; ++e) { kkc[e] = a.in[I_KK][16 * lane + e]; kac[e] = a.in[I_KA][16 * lane + e]; rkc[e] = a.in[I_RK][16 * lane + e]; }
    const int NGW = G * NWAVES;
    for (int row = bid * NWAVES + wave; row < NT; row += NGW) {
        const size_t o = (size_t)row * D + 16 * lane;
        float r[16], k[16], a0[16], a1[16];
        load16(R + o, r); load16(K + o, k); load16(A0 + o, a0); load16(A1 + o, a1);
        float ss = 0.f, bn = 0.f;
#pragma unroll
        for (int e = 0; e < 16; ++e) { const float kf = k[e] * kkc[e]; ss += kf * kf;
            bn += r[e] * rkc[e] * k[e] * ((1.f + (a0[e] - 1.f) * kac[e]) + (1.f + (a1[e] - 1.f) * kac[e])); }
        ss = quad_sum(ss); bn = quad_sum(bn);
        if ((lane & 3) == 0) { INVN[row * 16 + (lane >> 2)] = rsqrtf(ss + 1e-12f); BON[row * 16 + (lane >> 2)] = bn; }
    }
}
__device__ __forceinline__ int scan_row(int z, int b, int sg) { const int t = (z == 0) ? sg : (sg < TC ? TC - 1 - sg : TT + TC - 1 - sg); return b * TT + t; }
__device__ __forceinline__ float afma(float a, float b, float c) { float d; asm("v_fma_f32 %0, %1, %2, %3" : "=v"(d) : "v"(a), "v"(b), "v"(c)); return d; }
__device__ __forceinline__ float amul(float a, float b) { float d; asm("v_mul_f32 %0, %1, %2" : "=v"(d) : "v"(a), "v"(b)); return d; }
#define ROWSUM4_STAGE(N) asm volatile("s_nop 1\n\tv_add_f32_dpp %0, %0, %0 row_ror:" #N " row_mask:0xf bank_mask:0xf\n\tv_add_f32_dpp %1, %1, %1 row_ror:" #N " row_mask:0xf bank_mask:0xf\n\t" \
    "v_add_f32_dpp %2, %2, %2 row_ror:" #N " row_mask:0xf bank_mask:0xf\n\tv_add_f32_dpp %3, %3, %3 row_ror:" #N " row_mask:0xf bank_mask:0xf" : "+v"(a), "+v"(b), "+v"(c), "+v"(d))
__device__ __forceinline__ void row_sum16x4(float& a, float& b, float& c, float& d) { ROWSUM4_STAGE(8); ROWSUM4_STAGE(4); ROWSUM4_STAGE(2); ROWSUM4_STAGE(1); }
template <int N> __device__ __forceinline__ float row_ror(float v) { return __builtin_bit_cast(float, __builtin_amdgcn_update_dpp(0, __builtin_bit_cast(int, v), 0x120 + N, 0xf, 0xf, false)); }
__device__ __forceinline__ float row_sum16(float v) { v += row_ror<8>(v); v += row_ror<4>(v); v += row_ror<2>(v); v += row_ror<1>(v); return v; }
__device__ __forceinline__ void p4_scan(const Args& a, LAS unsigned char* lds, int tid, int lane, int wave, int bid, int G) {
    const bf16 *R = slotp(a, 2), *K = slotp(a, 3), *V = slotp(a, 4);
    const float* INVN = (const float*)(a.ws + WS_INVN);
    constexpr int NCH = TT / 16;
    const int sc = tid >> 8, ss = (tid >> 4) & 15, g4 = tid & 15;
    const int wc = wave >> 2, wq = wave & 3, ig = lane >> 4, jg = lane & 15;
    for (int pair = bid; pair < 256; pair += G) {
        const int cid = pair * 2 + sc, z = cid >> 8, b = (cid >> 4) & 15, h = cid & 15;
        const bf16* Az = slotp(a, z); bf16* DDz = slotp(a, 5 + z);
        const int col0 = h * 64 + 4 * g4;
        const f32x4 kkc = *(const GAS f32x4*)(a.in[I_KK] + col0), kac = *(const GAS f32x4*)(a.in[I_KA] + col0);
        float T[4][4];
#pragma unroll
        for (int jj = 0; jj < 4; ++jj)
#pragma unroll
            for (int ii = 0; ii < 4; ++ii) T[jj][ii] = 0.f;
        v2u gr, gk, gv, ga, gd; float ginv;
        { const int row = scan_row(z, b, ss); const size_t o = (size_t)row * D + col0;
          gr = *(const GAS v2u*)(R + o); gk = *(const GAS v2u*)(K + o); gv = *(const GAS v2u*)(V + o); ga = *(const GAS v2u*)(Az + o); gd = *(const GAS v2u*)(DDz + o); ginv = INVN[row * 16 + h]; }
        __syncthreads();
        for (int n = -1; n < NCH; ++n) {
            if (n + 1 < NCH) {
                const float k0 = bflo(gk.x), k1 = bfhi(gk.x), k2 = bflo(gk.y), k3 = bfhi(gk.y), a0 = bflo(ga.x), a1 = bfhi(ga.x), a2 = bflo(ga.y), a3 = bfhi(ga.y);
                const float q0 = k0 * kkc.x * ginv, q1 = k1 * kkc.y * ginv, q2 = k2 * kkc.z * ginv, q3 = k3 * kkc.w * ginv;
                LAS float* p = (LAS float*)(lds + ((n + 1) & 1) * 49152 + sc * 24576 + ss * 1536) + 4 * g4;
                *(LAS f32x4*)(p)       = (f32x4){-q0, -q1, -q2, -q3};
                *(LAS f32x4*)(p + 64)  = (f32x4){1.f - bflo(gd.x), 1.f - bfhi(gd.x), 1.f - bflo(gd.y), 1.f - bfhi(gd.y)};
                *(LAS f32x4*)(p + 128) = (f32x4){q0 * a0, q1 * a1, q2 * a2, q3 * a3};
                *(LAS f32x4*)(p + 192) = (f32x4){k0 * (1.f + (a0 - 1.f) * kac.x), k1 * (1.f + (a1 - 1.f) * kac.y), k2 * (1.f + (a2 - 1.f) * kac.z), k3 * (1.f + (a3 - 1.f) * kac.w)};
                *(LAS f32x4*)(p + 256) = (f32x4){bflo(gr.x), bfhi(gr.x), bflo(gr.y), bfhi(gr.y)};
                *(LAS f32x4*)(p + 320) = (f32x4){bflo(gv.x), bfhi(gv.x), bflo(gv.y), bfhi(gv.y)};
            }
            if (n >= 1) {
                const f32x4 y4 = *(const LAS f32x4*)((const LAS float*)(lds + 98304 + ((n - 1) & 1) * 8192 + sc * 4096) + ss * 64 + 4 * g4);
                v2u o; o.x = pk2(y4.x, y4.y); o.y = pk2(y4.z, y4.w);
                *(GAS v2u*)(DDz + (size_t)scan_row(z, b, (n - 1) * 16 + ss) * D + col0) = o;
            }
            __syncthreads();
            if (n + 2 < NCH) { const int row = scan_row(z, b, (n + 2) * 16 + ss); const size_t o = (size_t)row * D + col0;
                gr = *(const GAS v2u*)(R + o); gk = *(const GAS v2u*)(K + o); gv = *(const GAS v2u*)(V + o); ga = *(const GAS v2u*)(Az + o); gd = *(const GAS v2u*)(DDz + o); ginv = INVN[row * 16 + h]; }
            const int m = n + 1;
            if (m < NCH) {
                const LAS float* cb = (const LAS float*)(lds + (m & 1) * 49152 + wc * 24576);
                LAS float* yb = (LAS float*)(lds + 98304 + (m & 1) * 8192 + wc * 4096);
                f32x4 nk = *(const LAS f32x4*)(cb + 4 * jg), w4 = *(const LAS f32x4*)(cb + 64 + 4 * jg), ka = *(const LAS f32x4*)(cb + 128 + 4 * jg),
                      kd = *(const LAS f32x4*)(cb + 192 + 4 * jg), r4 = *(const LAS f32x4*)(cb + 256 + 4 * jg), v4 = *(const LAS f32x4*)(cb + 320 + 16 * wq + 4 * ig);
#pragma unroll 2
                for (int s = 0; s < 16; ++s) {
                    const LAS float* pn = cb + ((s + 1) & 15) * 384;
                    const f32x4 nk_n = *(const LAS f32x4*)(pn + 4 * jg), w4_n = *(const LAS f32x4*)(pn + 64 + 4 * jg), ka_n = *(const LAS f32x4*)(pn + 128 + 4 * jg),
                                kd_n = *(const LAS f32x4*)(pn + 192 + 4 * jg), r4_n = *(const LAS f32x4*)(pn + 256 + 4 * jg), v4_n = *(const LAS f32x4*)(pn + 320 + 16 * wq + 4 * ig);
                    float sa0 = afma(T[3][0], nk.w, afma(T[2][0], nk.z, afma(T[1][0], nk.y, amul(T[0][0], nk.x))));
                    float sa1 = afma(T[3][1], nk.w, afma(T[2][1], nk.z, afma(T[1][1], nk.y, amul(T[0][1], nk.x))));
                    float sa2 = afma(T[3][2], nk.w, afma(T[2][2], nk.z, afma(T[1][2], nk.y, amul(T[0][2], nk.x))));
                    float sa3 = afma(T[3][3], nk.w, afma(T[2][3], nk.z, afma(T[1][3], nk.y, amul(T[0][3], nk.x))));
                    row_sum16x4(sa0, sa1, sa2, sa3);
                    const float sa[4] = {sa0, sa1, sa2, sa3};
#pragma unroll
                    for (int ii = 0; ii < 4; ++ii) {
                        T[0][ii] = afma(v4[ii], kd.x, afma(sa[ii], ka.x, amul(T[0][ii], w4.x))); T[1][ii] = afma(v4[ii], kd.y, afma(sa[ii], ka.y, amul(T[1][ii], w4.y)));
                        T[2][ii] = afma(v4[ii], kd.z, afma(sa[ii], ka.z, amul(T[2][ii], w4.z))); T[3][ii] = afma(v4[ii], kd.w, afma(sa[ii], ka.w, amul(T[3][ii], w4.w))); }
                    float y0 = afma(T[3][0], r4.w, afma(T[2][0], r4.z, afma(T[1][0], r4.y, amul(T[0][0], r4.x))));
                    float y1 = afma(T[3][1], r4.w, afma(T[2][1], r4.z, afma(T[1][1], r4.y, amul(T[0][1], r4.x))));
                    float y2 = afma(T[3][2], r4.w, afma(T[2][2], r4.z, afma(T[1][2], r4.y, amul(T[0][2], r4.x))));
                    float y3 = afma(T[3][3], r4.w, afma(T[2][3], r4.z, afma(T[1][3], r4.y, amul(T[0][3], r4.x))));
                    row_sum16x4(y0, y1, y2, y3);
                    if (jg == 0) *(LAS f32x4*)(yb + s * 64 + 16 * wq + 4 * ig) = (f32x4){y0, y1, y2, y3};
                    nk = nk_n; w4 = w4_n; ka = ka_n; kd = kd_n; r4 = r4_n; v4 = v4_n;
                }
            }
        }
        __syncthreads();
        {
            const f32x4 y4 = *(const LAS f32x4*)((const LAS float*)(lds + 98304 + ((NCH - 1) & 1) * 8192 + sc * 4096) + ss * 64 + 4 * g4);
            v2u o; o.x = pk2(y4.x, y4.y); o.y = pk2(y4.z, y4.w);
            *(GAS v2u*)(DDz + (size_t)scan_row(z, b, (NCH - 1) * 16 + ss) * D + col0) = o;
        }
    }
}
typedef short s16x8c __attribute__((ext_vector_type(8)));
__device__ __forceinline__ f32x4 mfma16(v4u a, v4u b, f32x4 c) { return __builtin_amdgcn_mfma_f32_16x16x32_bf16(__builtin_bit_cast(s16x8c, a), __builtin_bit_cast(s16x8c, b), c, 0, 0, 0); }
__device__ __forceinline__ void blocksolve4(f32x4& x, const f32x4& n1, const f32x4& n2, const f32x4& n3) {
    x.y += n1.x * x.x; x.z += n2.x * x.x + n2.y * x.y; x.w += n3.x * x.x + n3.y * x.y + n3.z * x.z; }
template <int N> __device__ __forceinline__ float row_shr1(float v) {
    return __builtin_bit_cast(float, __builtin_amdgcn_update_dpp(0x3f800000, __builtin_bit_cast(int, v), 0x110 + N, 0xf, 0xf, false)); }
__device__ __forceinline__ void p4_scan_chunked(const Args& a, LAS unsigned char* lds, int tid, int lane, int wave, int bid, int G) {
    const bf16 *R = slotp(a, 2), *K = slotp(a, 3), *V = slotp(a, 4);
    constexpr int NCH = TT / 16, RP = 68, RARR = 16 * RP;
    constexpr int O_RAW = 0, O_VT = 5 * RARR * 4, O_VEC = O_VT + 4096, O_BKT = O_VEC + 9216, O_GC = O_BKT + 4096, O_YB = O_GC + 256, O_WS = O_YB + 4096, WS_B = 5120, O_WL = O_WS + 4 * WS_B, O_AL = O_WL + RARR * 4, CHAIN_B = O_AL + RARR * 4;
    static_assert(2 * CHAIN_B <= RW_BYTES, "scan LDS");
    const int sc = tid >> 8, ss = (tid >> 4) & 15, g4 = tid & 15;
    const int wc = wave >> 2, wq = wave & 3, fr = lane & 15, g = lane >> 4;
    LAS unsigned char* cs = lds + sc * CHAIN_B;
    LAS unsigned char* cw = lds + wc * CHAIN_B;
    LAS unsigned char* ws = cw + O_WS + wq * WS_B;
    for (int pair = bid; pair < 256; pair += G) {
        const int cid = pair * 2 + sc, z = cid >> 8, b = (cid >> 4) & 15, h = cid & 15;
        bf16* Yz = slotp(a, z);
        const bf16* L1b = (const bf16*)(a.ws + WS_L1) + z * 64 + 8 * g;
        const bf16* L2A = (const bf16*)(a.ws + WS_L2A);
        const int lc = h * 64 + 16 * wq + fr;
        const v4u bw0 = *(const GAS v4u*)(L2A + (size_t)(z * 1024 + lc) * 256 + z * 64 + 8 * g), bw1 = *(const GAS v4u*)(L2A + (size_t)(z * 1024 + lc) * 256 + z * 64 + 32 + 8 * g),
                  ba0 = *(const GAS v4u*)(L2A + (size_t)(2048 + z * 1024 + lc) * 256 + 128 + z * 64 + 8 * g), ba1 = *(const GAS v4u*)(L2A + (size_t)(2048 + z * 1024 + lc) * 256 + 128 + z * 64 + 32 + 8 * g);
        const float w0c = a.in[I_W0][z * 1024 + lc], a0c = a.in[I_A0][z * 1024 + lc];
        const int col0 = h * 64 + 4 * g4;
        const f32x4 kkc = *(const GAS f32x4*)(a.in[I_KK] + col0), kac = *(const GAS f32x4*)(a.in[I_KA] + col0), rkc = *(const GAS f32x4*)(a.in[I_RK] + col0);
        float* BONz = (float*)(a.ws + (z ? WS_INVN : WS_BON));
        f32x4 T[4];
#pragma unroll
        for (int jb = 0; jb < 4; ++jb) T[jb] = (f32x4){0.f, 0.f, 0.f, 0.f};
        v2u gr, gk, gv; int grow; v4u lw0, lw1, la0, la1;
#define SCAN_LOAD(chunk) do { const int row_ = scan_row(z, b, (chunk) * 16 + ss); const size_t o_ = (size_t)row_ * D + col0; \
        gr = *(const GAS v2u*)(R + o_); gk = *(const GAS v2u*)(K + o_); gv = *(const GAS v2u*)(V + o_); grow = row_; } while (0)
#define SCAN_LOAD_L1(chunk) do { const bf16* l1_ = L1b + (size_t)scan_row(z, b, (chunk) * 16 + fr) * 512; lw0 = *(const GAS v4u*)l1_; lw1 = *(const GAS v4u*)(l1_ + 32); la0 = *(const GAS v4u*)(l1_ + 128); la1 = *(const GAS v4u*)(l1_ + 160); } while (0)
#define SCAN_LORA() do { const f32x4 z4_ = (f32x4){0.f, 0.f, 0.f, 0.f}; const f32x4 cw_ = mfma16(lw1, bw1, mfma16(lw0, bw0, z4_)), ca_ = mfma16(la1, ba1, mfma16(la0, ba0, z4_)); \
        LAS float* wl_ = (LAS float*)(cw + O_WL) + (4 * g) * RP + 16 * wq + fr; LAS float* al_ = (LAS float*)(cw + O_AL) + (4 * g) * RP + 16 * wq + fr; \
        _Pragma("unroll") for (int e_ = 0; e_ < 4; ++e_) { wl_[e_ * RP] = fexp(-0.6065306597f * fsigmoid(w0c + cw_[e_])); al_[e_ * RP] = fsigmoid(a0c + ca_[e_]); } } while (0)
#define SCAN_CONVERT(chunk) do { const float k0 = bflo(gk.x), k1 = bfhi(gk.x), k2 = bflo(gk.y), k3 = bfhi(gk.y); \
        const f32x4 av_ = *(const LAS f32x4*)((const LAS float*)(cs + O_AL) + ss * RP + 4 * g4), wv_ = *(const LAS f32x4*)((const LAS float*)(cs + O_WL) + ss * RP + 4 * g4); \
        const float a0 = av_.x, a1 = av_.y, a2 = av_.z, a3 = av_.w; \
        const float u0_ = k0 * kkc.x, u1_ = k1 * kkc.y, u2_ = k2 * kkc.z, u3_ = k3 * kkc.w; \
        const float d0_ = k0 * (1.f + (a0 - 1.f) * kac.x), d1_ = k1 * (1.f + (a1 - 1.f) * kac.y), d2_ = k2 * (1.f + (a2 - 1.f) * kac.z), d3_ = k3 * (1.f + (a3 - 1.f) * kac.w); \
        const float ssq_ = row_sum16((u0_ * u0_ + u1_ * u1_) + (u2_ * u2_ + u3_ * u3_)); \
        const float bon_ = row_sum16((bflo(gr.x) * d0_ * rkc.x + bfhi(gr.x) * d1_ * rkc.y) + (bflo(gr.y) * d2_ * rkc.z + bfhi(gr.y) * d3_ * rkc.w)); \
        const float ginv = rsqrtf(ssq_ + 1e-12f); \
        if (g4 == 0) BONz[grow * 16 + h] = bon_; \
        const float q0 = u0_ * ginv, q1 = u1_ * ginv, q2 = u2_ * ginv, q3 = u3_ * ginv; \
        LAS float* p_ = (LAS float*)(cs + O_RAW) + ss * RP + 4 * g4; \
        *(LAS f32x4*)(p_)            = wv_; \
        *(LAS f32x4*)(p_ + RARR)     = (f32x4){-q0, -q1, -q2, -q3}; \
        *(LAS f32x4*)(p_ + 2 * RARR) = (f32x4){q0 * a0, q1 * a1, q2 * a2, q3 * a3}; \
        *(LAS f32x4*)(p_ + 3 * RARR) = (f32x4){d0_, d1_, d2_, d3_}; \
        *(LAS f32x4*)(p_ + 4 * RARR) = (f32x4){bflo(gr.x), bfhi(gr.x), bflo(gr.y), bfhi(gr.y)}; \
        LAS unsigned short* vt_ = (LAS unsigned short*)(cs + O_VT + ((chunk) & 1) * 2048) + (4 * g4) * 16 + ss; \
        vt_[0] = (unsigned short)(gv.x & 0xffffu); vt_[16] = (unsigned short)(gv.x >> 16); vt_[32] = (unsigned short)(gv.y & 0xffffu); vt_[48] = (unsigned short)(gv.y >> 16); } while (0)
        SCAN_LOAD(0); SCAN_LOAD_L1(0);
        __syncthreads();
        for (int i = lane; i < WS_B / 16; i += 64) *(LAS v4u*)(ws + i * 16) = (v4u){0u, 0u, 0u, 0u};
        SCAN_LORA();
        SCAN_LOAD_L1(1);
        __syncthreads();
        SCAN_CONVERT(0);
        SCAN_LOAD(1);
        __syncthreads();
        for (int n = 0; n < NCH; ++n) {
            {
                const int j0 = 16 * wq + 4 * g;
                const LAS float* rw = (const LAS float*)(cw + O_RAW) + fr * RP + j0;
                const f32x4 w = *(const LAS f32x4*)rw, ap = *(const LAS f32x4*)(rw + RARR), bb = *(const LAS f32x4*)(rw + 2 * RARR), kd = *(const LAS f32x4*)(rw + 3 * RARR), rr = *(const LAS f32x4*)(rw + 4 * RARR);
                f32x4 gm = w;
#pragma unroll
                for (int c = 0; c < 4; ++c) { gm[c] *= row_shr1<1>(gm[c]); }
#pragma unroll
                for (int c = 0; c < 4; ++c) { gm[c] *= row_shr1<2>(gm[c]); }
#pragma unroll
                for (int c = 0; c < 4; ++c) { gm[c] *= row_shr1<4>(gm[c]); }
#pragma unroll
                for (int c = 0; c < 4; ++c) { gm[c] *= row_shr1<8>(gm[c]); }
                f32x4 gp;
#pragma unroll
                for (int c = 0; c < 4; ++c) gp[c] = row_shr1<1>(gm[c]);
                const f32x4 ig = (f32x4){frcp(gm.x), frcp(gm.y), frcp(gm.z), frcp(gm.w)};
                const f32x4 at = gp * ap, bt = bb * ig, kt = kd * ig, rt = gm * rr;
                const int pos0 = 32 * (wq >> 1) + 8 * g + 4 * (wq & 1);
                LAS unsigned char* vv = cw + O_VEC + fr * 144 + pos0 * 2;
                const v2u hb = (v2u){pk2(bt.x, bt.y), pk2(bt.z, bt.w)}, hk = (v2u){pk2(kt.x, kt.y), pk2(kt.z, kt.w)};
                *(LAS v2u*)(vv) = (v2u){pk2(at.x, at.y), pk2(at.z, at.w)}; *(LAS v2u*)(vv + 2304) = hb; *(LAS v2u*)(vv + 4608) = hk; *(LAS v2u*)(vv + 6912) = (v2u){pk2(rt.x, rt.y), pk2(rt.z, rt.w)};
                LAS unsigned short* bk = (LAS unsigned short*)(cw + O_BKT) + j0 * 32 + (fr >> 2) * 8 + (fr & 3);
                bk[0] = (unsigned short)(hb.x & 0xffffu); bk[32] = (unsigned short)(hb.x >> 16); bk[64] = (unsigned short)(hb.y & 0xffffu); bk[96] = (unsigned short)(hb.y >> 16);
                bk[4] = (unsigned short)(hk.x & 0xffffu); bk[36] = (unsigned short)(hk.x >> 16); bk[68] = (unsigned short)(hk.y & 0xffffu); bk[100] = (unsigned short)(hk.y >> 16);
                if (fr == 15) *(LAS f32x4*)((LAS float*)(cw + O_GC) + j0) = gm;
            }
            if (n >= 1) {
                const f32x4 y4 = *(const LAS f32x4*)((const LAS float*)(cs + O_YB) + ss * 64 + 4 * g4);
                v2u o; o.x = pk2(y4.x, y4.y); o.y = pk2(y4.z, y4.w);
                *(GAS v2u*)(Yz + (size_t)scan_row(z, b, (n - 1) * 16 + ss) * D + col0) = o;
            }
            if (n + 1 < NCH) SCAN_LORA();
            __syncthreads();
            if (n + 2 < NCH) SCAN_LOAD_L1(n + 2);
            {
                const LAS unsigned char* vec = cw + O_VEC + fr * 144 + g * 16;
                const v4u xa0 = *(const LAS v4u*)(vec), xa1 = *(const LAS v4u*)(vec + 64), xb0 = *(const LAS v4u*)(vec + 2304), xb1 = *(const LAS v4u*)(vec + 2304 + 64),
                          xk0 = *(const LAS v4u*)(vec + 4608), xk1 = *(const LAS v4u*)(vec + 4608 + 64), xr0 = *(const LAS v4u*)(vec + 6912), xr1 = *(const LAS v4u*)(vec + 6912 + 64);
                const f32x4 zero4 = (f32x4){0.f, 0.f, 0.f, 0.f};
                f32x4 nab = mfma16(xb1, xa1, mfma16(xb0, xa0, zero4)), nak = mfma16(xk1, xa1, mfma16(xk0, xa0, zero4));
                f32x4 mbr = mfma16(xb1, xr1, mfma16(xb0, xr0, zero4)), mkr = mfma16(xk1, xr1, mfma16(xk0, xr0, zero4));
#pragma unroll
                for (int e = 0; e < 4; ++e) { const int r = 4 * g + e; if (!(r < fr)) { nab[e] = 0.f; nak[e] = 0.f; } if (!(r <= fr)) { mbr[e] = 0.f; mkr[e] = 0.f; } }
                *(LAS f32x4*)(ws + (fr * 16 + 4 * g) * 4) = nab;
                { const bool off = (g != (fr >> 2)); v4u o; o.x = off ? pk2(nab.x, nab.y) : 0u; o.y = off ? pk2(nab.z, nab.w) : 0u; o.z = 0u; o.w = 0u; *(LAS v4u*)(ws + 1024 + (fr * 4 + g) * 16) = o; }
                { v4u o; o.x = pk2(nak.x, nak.y); o.y = pk2(nak.z, nak.w); o.z = 0u; o.w = 0u; *(LAS v4u*)(ws + 2048 + (fr * 4 + g) * 16) = o; }
                { v4u o; o.x = pk2(mbr.x, mbr.y); o.y = pk2(mbr.z, mbr.w); o.z = pk2(mkr.x, mkr.y); o.w = pk2(mkr.z, mkr.w); *(LAS v4u*)(ws + 4096 + (fr * 4 + g) * 16) = o; }
                LDS_WAIT(); asm volatile("" ::: "memory");
                const f32x4 n1 = *(const LAS f32x4*)(ws + ((4 * g + 1) * 16 + 4 * g) * 4), n2 = *(const LAS f32x4*)(ws + ((4 * g + 2) * 16 + 4 * g) * 4), n3 = *(const LAS f32x4*)(ws + ((4 * g + 3) * 16 + 4 * g) * 4);
                const v4u noff = *(const LAS v4u*)(ws + 1024 + (fr * 4 + g) * 16);
                const f32x4 eye = (f32x4){(4 * g == fr) ? 1.f : 0.f, (4 * g + 1 == fr) ? 1.f : 0.f, (4 * g + 2 == fr) ? 1.f : 0.f, (4 * g + 3 == fr) ? 1.f : 0.f};
                f32x4 L = eye; blocksolve4(L, n1, n2, n3);
#pragma unroll
                for (int it = 0; it < 3; ++it) { v4u lb; lb.x = pk2(L.x, L.y); lb.y = pk2(L.z, L.w); lb.z = 0u; lb.w = 0u; L = mfma16(noff, lb, eye); blocksolve4(L, n1, n2, n3); }
                { LAS unsigned short* lu = (LAS unsigned short*)(ws + 3072) + (fr >> 2) * 8 + (fr & 3);
                  lu[(4 * g) * 32] = (unsigned short)f2bf(L.x); lu[(4 * g + 1) * 32] = (unsigned short)f2bf(L.y); lu[(4 * g + 2) * 32] = (unsigned short)f2bf(L.z); lu[(4 * g + 3) * 32] = (unsigned short)f2bf(L.w); }
                LDS_WAIT(); asm volatile("" ::: "memory");
                v4u tb0, tb1; tb0.x = pk2(T[0].x, T[0].y); tb0.y = pk2(T[0].z, T[0].w); tb0.z = pk2(T[1].x, T[1].y); tb0.w = pk2(T[1].z, T[1].w);
                tb1.x = pk2(T[2].x, T[2].y); tb1.y = pk2(T[2].z, T[2].w); tb1.z = pk2(T[3].x, T[3].y); tb1.w = pk2(T[3].z, T[3].w);
                const f32x4 Wa = mfma16(xa1, tb1, mfma16(xa0, tb0, zero4)), Wr = mfma16(xr1, tb1, mfma16(xr0, tb0, zero4));
                const v2u vt = *(const LAS v2u*)(cw + O_VT + (n & 1) * 2048 + (16 * wq + fr) * 32 + g * 8);
                v4u vb; vb.x = vt.x; vb.y = vt.y; vb.z = 0u; vb.w = 0u;
                const v4u ng = *(const LAS v4u*)(ws + 2048 + (fr * 4 + g) * 16), lu4 = *(const LAS v4u*)(ws + 3072 + (fr * 4 + g) * 16), my = *(const LAS v4u*)(ws + 4096 + (fr * 4 + g) * 16);
                const f32x4 Gm = mfma16(ng, vb, Wa);
                v4u gb; gb.x = pk2(Gm.x, Gm.y); gb.y = pk2(Gm.z, Gm.w); gb.z = 0u; gb.w = 0u;
                const f32x4 U = mfma16(lu4, gb, zero4);
                v4u bop; bop.x = pk2(U.x, U.y); bop.y = pk2(U.z, U.w); bop.z = vt.x; bop.w = vt.y;
                const f32x4 Y = mfma16(my, bop, Wr);
                { LAS float* yb = (LAS float*)(cw + O_YB) + (4 * g) * 64 + 16 * wq + fr; yb[0] = Y.x; yb[64] = Y.y; yb[128] = Y.z; yb[192] = Y.w; }
#pragma unroll
                for (int jb = 0; jb < 4; ++jb) { const v4u bkt = *(const LAS v4u*)(cw + O_BKT + ((16 * jb + fr) * 4 + g) * 16);
                    const f32x4 gc = *(const LAS f32x4*)((const LAS float*)(cw + O_GC) + 16 * jb + 4 * g);
                    T[jb] = mfma16(bkt, bop, T[jb]) * gc; }
            }
            if (n + 1 < NCH) { SCAN_CONVERT(n + 1); if (n + 2 < NCH) SCAN_LOAD(n + 2); }
            __syncthreads();
        }
#undef SCAN_LOAD
#undef SCAN_LOAD_L1
#undef SCAN_CONVERT
#undef SCAN_LORA
        {
            const f32x4 y4 = *(const LAS f32x4*)((const LAS float*)(cs + O_YB) + ss * 64 + 4 * g4);
            v2u o; o.x = pk2(y4.x, y4.y); o.y = pk2(y4.z, y4.w);
            *(GAS v2u*)(Yz + (size_t)scan_row(z, b, (NCH - 1) * 16 + ss) * D + col0) = o;
        }
    }
}
__device__ __forceinline__ void p4_scan_v3(const Args& a, LAS unsigned char* lds, int tid, int lane, int wave, int bid, int G) {
    const bf16 *R = slotp(a, 3), *K = slotp(a, 4), *V = slotp(a, 5);
    constexpr int NCH = TT / 16;
    constexpr int O_VEC = 0, O_BKT = 9216, O_GC = 13312, O_VT = 13568, BUF_B = 15616, O_YB = 2 * BUF_B, O_WS = O_YB + 8192, WS_B = 5120 + 2176, CHAIN_B = O_WS + 4 * WS_B;
    static_assert(2 * CHAIN_B <= RW_BYTES, "scan LDS");
    const int sc = tid >> 8, ss = (tid >> 4) & 15, g4 = tid & 15;
    const int wq = wave & 3, fr = lane & 15, g = lane >> 4;
    LAS unsigned char* cw = lds + sc * CHAIN_B;
    LAS unsigned char* ws = cw + O_WS + wq * WS_B;
    for (int pair = bid; pair < 256; pair += G) {
        const int cid = pair * 2 + sc, z = cid >> 8, b = (cid >> 4) & 15, h = cid & 15;
        bf16* Yz = slotp(a, z);
        float* BONP = (float*)((unsigned char*)a.out + 72 * MiB) + (size_t)(z * 4 + wq) * NT * 16;
        const bf16* L1b = (const bf16*)(a.ws + WS_L1) + z * 64 + 8 * g;
        const bf16* L2A = (const bf16*)(a.ws + WS_L2A);
        const int lc = h * 64 + 16 * wq + fr;
        const v4u bw0 = *(const GAS v4u*)(L2A + (size_t)(z * 1024 + lc) * 256 + z * 64 + 8 * g), bw1 = *(const GAS v4u*)(L2A + (size_t)(z * 1024 + lc) * 256 + z * 64 + 32 + 8 * g),
                  ba0 = *(const GAS v4u*)(L2A + (size_t)(2048 + z * 1024 + lc) * 256 + 128 + z * 64 + 8 * g), ba1 = *(const GAS v4u*)(L2A + (size_t)(2048 + z * 1024 + lc) * 256 + 128 + z * 64 + 32 + 8 * g);
        const float w0c = a.in[I_W0][z * 1024 + lc], a0c = a.in[I_A0][z * 1024 + lc];
        const int j0 = 16 * wq + 4 * g, pcol = h * 64 + j0;
        const f32x4 kkc = *(const GAS f32x4*)(a.in[I_KK] + pcol), kac = *(const GAS f32x4*)(a.in[I_KA] + pcol), rkc = *(const GAS f32x4*)(a.in[I_RK] + pcol);
        f32x4 kkn[4];
#pragma unroll
        for (int c = 0; c < 4; ++c) kkn[c] = *(const GAS f32x4*)(a.in[I_KK] + h * 64 + 16 * g + 4 * c);
        const int pos0 = 32 * (wq >> 1) + 8 * g + 4 * (wq & 1);
        f32x4 T[4];
#pragma unroll
        for (int jb = 0; jb < 4; ++jb) T[jb] = (f32x4){0.f, 0.f, 0.f, 0.f};
        v2u gr, gk, gv; v4u kn0, kn1, lw0, lw1, la0, la1; int grow;
#define V3_LOAD(chunk) do { const int row_ = scan_row(z, b, (chunk) * 16 + fr); grow = row_; const size_t o_ = (size_t)row_ * D + pcol; \
        gr = *(const GAS v2u*)(R + o_); gk = *(const GAS v2u*)(K + o_); gv = *(const GAS v2u*)(V + o_); \
        kn0 = *(const GAS v4u*)(K + (size_t)row_ * D + h * 64 + 16 * g); kn1 = *(const GAS v4u*)(K + (size_t)row_ * D + h * 64 + 16 * g + 8); \
        const bf16* l1_ = L1b + (size_t)row_ * 512; lw0 = *(const GAS v4u*)l1_; lw1 = *(const GAS v4u*)(l1_ + 32); la0 = *(const GAS v4u*)(l1_ + 128); la1 = *(const GAS v4u*)(l1_ + 160); } while (0)
#define V3_PRODUCE(chunk) do { \
        const f32x4 z4_ = (f32x4){0.f, 0.f, 0.f, 0.f}; const f32x4 cw_ = mfma16(lw1, bw1, mfma16(lw0, bw0, z4_)), ca_ = mfma16(la1, ba1, mfma16(la0, ba0, z4_)); \
        LAS float* trw_ = (LAS float*)(ws + 5120); LAS float* tra_ = trw_ + 272; \
        _Pragma("unroll") for (int e_ = 0; e_ < 4; ++e_) { trw_[(4 * g + e_) * 17 + fr] = fexp(-0.6065306597f * fsigmoid(w0c + cw_[e_])); tra_[(4 * g + e_) * 17 + fr] = fsigmoid(a0c + ca_[e_]); } \
        float n8_[8]; float ssq_ = 0.f; \
        unpack8(kn0, n8_); ssq_ += (n8_[0] * kkn[0].x) * (n8_[0] * kkn[0].x) + (n8_[1] * kkn[0].y) * (n8_[1] * kkn[0].y) + (n8_[2] * kkn[0].z) * (n8_[2] * kkn[0].z) + (n8_[3] * kkn[0].w) * (n8_[3] * kkn[0].w) \
                                 + (n8_[4] * kkn[1].x) * (n8_[4] * kkn[1].x) + (n8_[5] * kkn[1].y) * (n8_[5] * kkn[1].y) + (n8_[6] * kkn[1].z) * (n8_[6] * kkn[1].z) + (n8_[7] * kkn[1].w) * (n8_[7] * kkn[1].w); \
        unpack8(kn1, n8_); ssq_ += (n8_[0] * kkn[2].x) * (n8_[0] * kkn[2].x) + (n8_[1] * kkn[2].y) * (n8_[1] * kkn[2].y) + (n8_[2] * kkn[2].z) * (n8_[2] * kkn[2].z) + (n8_[3] * kkn[2].w) * (n8_[3] * kkn[2].w) \
                                 + (n8_[4] * kkn[3].x) * (n8_[4] * kkn[3].x) + (n8_[5] * kkn[3].y) * (n8_[5] * kkn[3].y) + (n8_[6] * kkn[3].z) * (n8_[6] * kkn[3].z) + (n8_[7] * kkn[3].w) * (n8_[7] * kkn[3].w); \
        ssq_ = rows4_sum(ssq_); \
        const float inv_ = rsqrtf(ssq_ + 1e-12f); \
        LDS_WAIT(); asm volatile("" ::: "memory"); \
        const f32x4 w_ = (f32x4){trw_[fr * 17 + 4 * g], trw_[fr * 17 + 4 * g + 1], trw_[fr * 17 + 4 * g + 2], trw_[fr * 17 + 4 * g + 3]}; \
        const f32x4 a_ = (f32x4){tra_[fr * 17 + 4 * g], tra_[fr * 17 + 4 * g + 1], tra_[fr * 17 + 4 * g + 2], tra_[fr * 17 + 4 * g + 3]}; \
        const f32x4 k_ = (f32x4){bflo(gk.x), bfhi(gk.x), bflo(gk.y), bfhi(gk.y)}, r_ = (f32x4){bflo(gr.x), bfhi(gr.x), bflo(gr.y), bfhi(gr.y)}; \
        const f32x4 u_ = k_ * kkc * inv_; const f32x4 d_ = k_ * ((a_ - 1.f) * kac + 1.f); \
        float bon_ = (r_.x * d_.x * rkc.x + r_.y * d_.y * rkc.y) + (r_.z * d_.z * rkc.z + r_.w * d_.w * rkc.w); \
        bon_ = rows4_sum(bon_); \
        if (g == 0) BONP[grow * 16 + h] = bon_; \
        f32x4 gm_ = w_; \
        _Pragma("unroll") for (int c_ = 0; c_ < 4; ++c_) gm_[c_] *= row_shr1<1>(gm_[c_]); \
        _Pragma("unroll") for (int c_ = 0; c_ < 4; ++c_) gm_[c_] *= row_shr1<2>(gm_[c_]); \
        _Pragma("unroll") for (int c_ = 0; c_ < 4; ++c_) gm_[c_] *= row_shr1<4>(gm_[c_]); \
        _Pragma("unroll") for (int c_ = 0; c_ < 4; ++c_) gm_[c_] *= row_shr1<8>(gm_[c_]); \
        f32x4 gp_; _Pragma("unroll") for (int c_ = 0; c_ < 4; ++c_) gp_[c_] = row_shr1<1>(gm_[c_]); \
        const f32x4 ig_ = (f32x4){frcp(gm_.x), frcp(gm_.y), frcp(gm_.z), frcp(gm_.w)}; \
        const f32x4 at_ = gp_ * (-u_), bt_ = (u_ * a_) * ig_, kt_ = d_ * ig_, rt_ = gm_ * r_; \
        LAS unsigned char* bb_ = cw + ((chunk) & 1) * BUF_B; \
        LAS unsigned char* vv_ = bb_ + O_VEC + fr * 144 + pos0 * 2; \
        const v2u hb_ = (v2u){pk2hw(bt_.x, bt_.y), pk2hw(bt_.z, bt_.w)}, hk_ = (v2u){pk2hw(kt_.x, kt_.y), pk2hw(kt_.z, kt_.w)}; \
        *(LAS v2u*)(vv_) = (v2u){pk2hw(at_.x, at_.y), pk2hw(at_.z, at_.w)}; *(LAS v2u*)(vv_ + 2304) = hb_; *(LAS v2u*)(vv_ + 4608) = hk_; *(LAS v2u*)(vv_ + 6912) = (v2u){pk2hw(rt_.x, rt_.y), pk2hw(rt_.z, rt_.w)}; \
        LAS unsigned short* bk_ = (LAS unsigned short*)(bb_ + O_BKT) + j0 * 32 + (fr >> 2) * 8 + (fr & 3); \
        bk_[0] = (unsigned short)(hb_.x & 0xffffu); bk_[32] = (unsigned short)(hb_.x >> 16); bk_[64] = (unsigned short)(hb_.y & 0xffffu); bk_[96] = (unsigned short)(hb_.y >> 16); \
        bk_[4] = (unsigned short)(hk_.x & 0xffffu); bk_[36] = (unsigned short)(hk_.x >> 16); bk_[68] = (unsigned short)(hk_.y & 0xffffu); bk_[100] = (unsigned short)(hk_.y >> 16); \
        if (fr == 15) *(LAS f32x4*)((LAS float*)(bb_ + O_GC) + j0) = gm_; \
        LAS unsigned short* vt_ = (LAS unsigned short*)(bb_ + O_VT) + j0 * 16 + fr; \
        vt_[0] = (unsigned short)(gv.x & 0xffffu); vt_[16] = (unsigned short)(gv.x >> 16); vt_[32] = (unsigned short)(gv.y & 0xffffu); vt_[48] = (unsigned short)(gv.y >> 16); } while (0)
        V3_LOAD(0);
        __syncthreads();
        for (int i = lane; i < WS_B / 16; i += 64) *(LAS v4u*)(ws + i * 16) = (v4u){0u, 0u, 0u, 0u};
        V3_PRODUCE(0);
        V3_LOAD(1);
        __syncthreads();
        for (int n = 0; n < NCH; ++n) {
            if (n + 1 < NCH) { V3_PRODUCE(n + 1); if (n + 2 < NCH) V3_LOAD(n + 2); }
            {
                const LAS unsigned char* bb = cw + (n & 1) * BUF_B;
                const LAS unsigned char* vec = bb + O_VEC + fr * 144 + g * 16;
                const v4u xa0 = *(const LAS v4u*)(vec), xa1 = *(const LAS v4u*)(vec + 64), xb0 = *(const LAS v4u*)(vec + 2304), xb1 = *(const LAS v4u*)(vec + 2304 + 64),
                          xk0 = *(const LAS v4u*)(vec + 4608), xk1 = *(const LAS v4u*)(vec + 4608 + 64), xr0 = *(const LAS v4u*)(vec + 6912), xr1 = *(const LAS v4u*)(vec + 6912 + 64);
                const f32x4 zero4 = (f32x4){0.f, 0.f, 0.f, 0.f};
                f32x4 nab = mfma16(xb1, xa1, mfma16(xb0, xa0, zero4)), nak = mfma16(xk1, xa1, mfma16(xk0, xa0, zero4));
                f32x4 mbr = mfma16(xb1, xr1, mfma16(xb0, xr0, zero4)), mkr = mfma16(xk1, xr1, mfma16(xk0, xr0, zero4));
#pragma unroll
                for (int e = 0; e < 4; ++e) { const int r = 4 * g + e; if (!(r < fr)) { nab[e] = 0.f; nak[e] = 0.f; } if (!(r <= fr)) { mbr[e] = 0.f; mkr[e] = 0.f; } }
                *(LAS f32x4*)(ws + (fr * 16 + 4 * g) * 4) = nab;
                { const bool off = (g != (fr >> 2)); v4u o; o.x = off ? pk2hw(nab.x, nab.y) : 0u; o.y = off ? pk2hw(nab.z, nab.w) : 0u; o.z = 0u; o.w = 0u; *(LAS v4u*)(ws + 1024 + (fr * 4 + g) * 16) = o; }
                { v4u o; o.x = pk2hw(nak.x, nak.y); o.y = pk2hw(nak.z, nak.w); o.z = 0u; o.w = 0u; *(LAS v4u*)(ws + 2048 + (fr * 4 + g) * 16) = o; }
                { v4u o; o.x = pk2hw(mbr.x, mbr.y); o.y = pk2hw(mbr.z, mbr.w); o.z = pk2hw(mkr.x, mkr.y); o.w = pk2hw(mkr.z, mkr.w); *(LAS v4u*)(ws + 4096 + (fr * 4 + g) * 16) = o; }
                LDS_WAIT(); asm volatile("" ::: "memory");
                const f32x4 n1 = *(const LAS f32x4*)(ws + ((4 * g + 1) * 16 + 4 * g) * 4), n2 = *(const LAS f32x4*)(ws + ((4 * g + 2) * 16 + 4 * g) * 4), n3 = *(const LAS f32x4*)(ws + ((4 * g + 3) * 16 + 4 * g) * 4);
                const v4u noff = *(const LAS v4u*)(ws + 1024 + (fr * 4 + g) * 16);
                const f32x4 eye = (f32x4){(4 * g == fr) ? 1.f : 0.f, (4 * g + 1 == fr) ? 1.f : 0.f, (4 * g + 2 == fr) ? 1.f : 0.f, (4 * g + 3 == fr) ? 1.f : 0.f};
                f32x4 L = eye; blocksolve4(L, n1, n2, n3);
#pragma unroll
                for (int it = 0; it < 3; ++it) { v4u lb; lb.x = pk2hw(L.x, L.y); lb.y = pk2hw(L.z, L.w); lb.z = 0u; lb.w = 0u; L = mfma16(noff, lb, eye); blocksolve4(L, n1, n2, n3); }
                { LAS unsigned short* lu = (LAS unsigned short*)(ws + 3072) + (fr >> 2) * 8 + (fr & 3);
                  lu[(4 * g) * 32] = (unsigned short)f2bfhw(L.x); lu[(4 * g + 1) * 32] = (unsigned short)f2bfhw(L.y); lu[(4 * g + 2) * 32] = (unsigned short)f2bfhw(L.z); lu[(4 * g + 3) * 32] = (unsigned short)f2bfhw(L.w); }
                LDS_WAIT(); asm volatile("" ::: "memory");
                v4u tb0, tb1; tb0.x = pk2hw(T[0].x, T[0].y); tb0.y = pk2hw(T[0].z, T[0].w); tb0.z = pk2hw(T[1].x, T[1].y); tb0.w = pk2hw(T[1].z, T[1].w);
                tb1.x = pk2hw(T[2].x, T[2].y); tb1.y = pk2hw(T[2].z, T[2].w); tb1.z = pk2hw(T[3].x, T[3].y); tb1.w = pk2hw(T[3].z, T[3].w);
                const f32x4 Wa = mfma16(xa1, tb1, mfma16(xa0, tb0, zero4)), Wr = mfma16(xr1, tb1, mfma16(xr0, tb0, zero4));
                const v2u vt = *(const LAS v2u*)(bb + O_VT + (16 * wq + fr) * 32 + g * 8);
                v4u vb; vb.x = vt.x; vb.y = vt.y; vb.z = 0u; vb.w = 0u;
                const v4u ng = *(const LAS v4u*)(ws + 2048 + (fr * 4 + g) * 16), lu4 = *(const LAS v4u*)(ws + 3072 + (fr * 4 + g) * 16), my = *(const LAS v4u*)(ws + 4096 + (fr * 4 + g) * 16);
                const f32x4 Gm = mfma16(ng, vb, Wa);
                v4u gb; gb.x = pk2hw(Gm.x, Gm.y); gb.y = pk2hw(Gm.z, Gm.w); gb.z = 0u; gb.w = 0u;
                const f32x4 U = mfma16(lu4, gb, zero4);
                v4u bop; bop.x = pk2hw(U.x, U.y); bop.y = pk2hw(U.z, U.w); bop.z = vt.x; bop.w = vt.y;
                const f32x4 Y = mfma16(my, bop, Wr);
                { LAS float* yb = (LAS float*)(cw + O_YB + (n & 1) * 4096) + (4 * g) * 64 + 16 * wq + fr; yb[0] = Y.x; yb[64] = Y.y; yb[128] = Y.z; yb[192] = Y.w; }
#pragma unroll
                for (int jb = 0; jb < 4; ++jb) { const v4u bkt = *(const LAS v4u*)(bb + O_BKT + ((16 * jb + fr) * 4 + g) * 16);
                    const f32x4 gc = *(const LAS f32x4*)((const LAS float*)(bb + O_GC) + 16 * jb + 4 * g);
                    T[jb] = mfma16(bkt, bop, T[jb]) * gc; }
            }
            if (n >= 1) {
                const f32x4 y4 = *(const LAS f32x4*)((const LAS float*)(cw + O_YB + ((n - 1) & 1) * 4096) + ss * 64 + 4 * g4);
                v2u o; o.x = pk2hw(y4.x, y4.y); o.y = pk2hw(y4.z, y4.w);
                *(GAS v2u*)(Yz + (size_t)scan_row(z, b, (n - 1) * 16 + ss) * D + h * 64 + 4 * g4) = o;
            }
            __syncthreads();
        }
#undef V3_LOAD
#undef V3_PRODUCE
        {
            const f32x4 y4 = *(const LAS f32x4*)((const LAS float*)(cw + O_YB + ((NCH - 1) & 1) * 4096) + ss * 64 + 4 * g4);
            v2u o; o.x = pk2hw(y4.x, y4.y); o.y = pk2hw(y4.z, y4.w);
            *(GAS v2u*)(Yz + (size_t)scan_row(z, b, (NCH - 1) * 16 + ss) * D + h * 64 + 4 * g4) = o;
        }
    }
}
__device__ __forceinline__ void p5a_groupnorm(const Args& a, int lane, int wave, int bid, int G) {
#if MK_SCAN_CHUNKED
    const bf16 *Y0 = slotp(a, 0), *Y1 = slotp(a, 1), *V = slotp(a, 5); bf16* YN = slotp(a, 6);
#else
    const bf16 *Y0 = slotp(a, 5), *Y1 = slotp(a, 6), *V = slotp(a, 4); bf16* YN = slotp(a, 0);
#endif
    const float* BON = (const float*)(a.ws + WS_BON); const float* BON1 = (const float*)(a.ws + WS_INVN); const float* BONP8 = (const float*)((const unsigned char*)a.out + 72 * MiB);
    float lg[16], lb[16];
#pragma unroll
    for (int e = 0; e < 16; ++e) { lg[e] = a.in[I_LNG][16 * lane + e]; lb[e] = a.in[I_LNB][16 * lane + e]; }
    const int NGW = G * NWAVES;
    for (int row = bid * NWAVES + wave; row < NT; row += NGW) {
        const size_t o = (size_t)row * D + 16 * lane;
        float y[16], y1[16], v[16];
        load16(Y0 + o, y); load16(Y1 + o, y1); load16(V + o, v);
        float s = 0.f;
#pragma unroll
        for (int e = 0; e < 16; ++e) { y[e] += y1[e]; s += y[e]; }
        const float mean = quad_sum(s) * (1.f / 64.f); float q = 0.f;
#pragma unroll
        for (int e = 0; e < 16; ++e) { y[e] -= mean; q += y[e] * y[e]; }
        const float rstd = rsqrtf(quad_sum(q) * (1.f / 64.f) + 64e-5f);
#if MK_SCAN_CHUNKED == 2
        float bn = 0.f;
#pragma unroll
        for (int p = 0; p < 8; ++p) bn += BONP8[(size_t)p * NT * 16 + row * 16 + (lane >> 2)];
#else
        const float bn = BON[row * 16 + (lane >> 2)] + BON1[row * 16 + (lane >> 2)];
#endif
#pragma unroll
        for (int e = 0; e < 16; ++e) y[e] = y[e] * rstd * lg[e] + lb[e] + bn * v[e];
        store16(YN + o, y);
    }
}
template <int L> __device__ __forceinline__ void p_router(const Args& a, LAS unsigned char* lds, int tid, int lane, int wave, int bid, int G) {
    constexpr int nrows = (L == 0) ? NT : NLAT;
    LAS float* RW = (LAS float*)lds;
    LAS unsigned* lcnt = (LAS unsigned*)(lds + LDSCTL_OFF) + LC_LCNT;
    const float* rg = a.in[I_RG] + (size_t)L * D * 4; const float* re = a.in[I_RE] + (size_t)L * 4 * D * 8;
    { f32x4 wg[2], we[8][2];
#pragma unroll
      for (int i = 0; i < 2; ++i) wg[i] = *(const GAS f32x4*)(rg + (size_t)(tid + NTHR * i) * 4);
#pragma unroll
      for (int i = 0; i < 8; ++i) { const int idx = tid + NTHR * i, gq = idx >> 10, k = idx & 1023; const float* p = re + (size_t)gq * 8192 + k * 8; we[i][0] = *(const GAS f32x4*)p; we[i][1] = *(const GAS f32x4*)(p + 4); }
#pragma unroll
      for (int i = 0; i < 2; ++i) { const int k0 = tid + NTHR * i, k = ((((k0 & 511) >> 3) + 64 * (2 * (k0 >> 9) + ((k0 >> 2) & 1))) << 2) | (k0 & 3); RW[k] = wg[i].x; RW[1024 + k] = wg[i].y; RW[2048 + k] = wg[i].z; RW[3072 + k] = wg[i].w; }
#pragma unroll
      for (int i = 0; i < 8; ++i) { const int idx = tid + NTHR * i, gq = idx >> 10, k0 = idx & 1023, k = ((((k0 & 511) >> 3) + 64 * (2 * (k0 >> 9) + ((k0 >> 2) & 1))) << 2) | (k0 & 3); LAS float* d = RW + (4 + gq * 8) * 1024 + k;
          d[0] = we[i][0].x; d[1024] = we[i][0].y; d[2048] = we[i][0].z; d[3072] = we[i][0].w; d[4096] = we[i][1].x; d[5120] = we[i][1].y; d[6144] = we[i][1].z; d[7168] = we[i][1].w; } }
    if (tid < 32) lcnt[tid] = 0u;
    LAS float* rbias = (LAS float*)(lds + LDSCTL_OFF) + 216;
    if (tid >= 64 && tid < 100) rbias[tid - 64] = (tid < 68) ? a.in[I_RGB][L * 4 + (tid - 64)] : a.in[I_REB][L * 32 + (tid - 68)];
    for (int i = bid * NTHR + tid; i < MAXSLOT; i += G * NTHR) ((int*)(a.ws + WS_TOK))[i] = 0;
    __syncthreads();
    const bf16* X = slotp(a, 4); bf16* H2 = slotp(a, 6);
    unsigned* ROUTE = (unsigned*)(a.ws + WS_ROUTE);
    const int chunk = (nrows + G - 1) / G;
    f32x4 mgg[4], mhh[4]; int cmr = -1;
    for (int rr = 2 * wave; rr < chunk; rr += 2 * NWAVES) {
        const int lr0 = bid * chunk + rr; if (lr0 >= nrows) break;
        const bool ok1 = (rr + 1 < chunk) && (lr0 + 1 < nrows);
        int rowu[2]; rowu[0] = (L == 0) ? lr0 : lat_row(lr0); rowu[1] = ok1 ? ((L == 0) ? lr0 + 1 : lat_row(lr0 + 1)) : rowu[0];
        f32x4 hu[2][4]; float ss[2]; v2u xraw[2][4];
        ld_row_bf(X + (size_t)rowu[0] * D, lane, xraw[0]); ld_row_bf(X + (size_t)rowu[1] * D, lane, xraw[1]);
#pragma unroll
        for (int u = 0; u < 2; ++u) { ss[u] = 0.f;
#pragma unroll
            for (int j = 0; j < 4; ++j) { hu[u][j] = (f32x4){bflo(xraw[u][j].x), bfhi(xraw[u][j].x), bflo(xraw[u][j].y), bfhi(xraw[u][j].y)}; ss[u] += (hu[u][j].x * hu[u][j].x + hu[u][j].y * hu[u][j].y) + (hu[u][j].z * hu[u][j].z + hu[u][j].w * hu[u][j].w); } }
#pragma unroll
        for (int u = 0; u < 2; ++u) { const float rstd = rsqrtf(wave_sum(ss[u]) * (1.f / D) + 1e-6f); const int mr = mod_row(rowu[u]);
            if (mr != cmr) { cmr = mr;
                const float* g = a.in[I_N2G] + L * D; const float* sh = modp(a, L, mr, 3); const float* sc = modp(a, L, mr, 4);
#pragma unroll
                for (int j = 0; j < 4; ++j) { const int c = colb(lane, j); mgg[j] = *(const GAS f32x4*)(g + c) * (*(const GAS f32x4*)(sc + c) + 1.f); mhh[j] = *(const GAS f32x4*)(sh + c); } }
#pragma unroll
            for (int j = 0; j < 4; ++j) hu[u][j] = (hu[u][j] * rstd) * mgg[j] + mhh[j];
            if (u == 0 || ok1) store_row_bf16(H2 + (size_t)rowu[u] * D, lane, hu[u]); }
        const LAS f32x4* W4 = (const LAS f32x4*)RW;
        float gl[2][4];
        { float pg[8];
#pragma unroll
        for (int o = 0; o < 4; ++o) { float p0 = 0.f, p1 = 0.f;
#pragma unroll
            for (int j = 0; j < 4; ++j) { const f32x4 w = W4[o * 256 + lane + 64 * j]; p0 = __builtin_fmaf(hu[0][j].w, w.w, __builtin_fmaf(hu[0][j].z, w.z, __builtin_fmaf(hu[0][j].y, w.y, __builtin_fmaf(hu[0][j].x, w.x, p0)))); p1 = __builtin_fmaf(hu[1][j].w, w.w, __builtin_fmaf(hu[1][j].z, w.z, __builtin_fmaf(hu[1][j].y, w.y, __builtin_fmaf(hu[1][j].x, w.x, p1)))); }
            pg[o] = p0; pg[4 + o] = p1; }
        wave_sum_n(pg);
#pragma unroll
        for (int o = 0; o < 4; ++o) { gl[0][o] = pg[o] + rbias[o]; gl[1][o] = pg[4 + o] + rbias[o]; } }
#pragma unroll
        for (int u = 0; u < 2; ++u) {
        if (u == 1 && !ok1) break;
        const int row = rowu[u];
        int gi = 0; float gm = gl[u][0];
#pragma unroll
        for (int o = 1; o < 4; ++o) if (gl[u][o] > gm) { gm = gl[u][o]; gi = o; }
        float gs = 0.f;
#pragma unroll
        for (int o = 0; o < 4; ++o) gs += __expf(gl[u][o] - gm);
        const float gwt = 1.f / gs;
        float el[8];
#pragma unroll
        for (int e = 0; e < 8; ++e) { float p = 0.f; const int o = 4 + gi * 8 + e;
#pragma unroll
            for (int j = 0; j < 4; ++j) { const f32x4 w = W4[o * 256 + lane + 64 * j]; p = __builtin_fmaf(hu[u][j].w, w.w, __builtin_fmaf(hu[u][j].z, w.z, __builtin_fmaf(hu[u][j].y, w.y, __builtin_fmaf(hu[u][j].x, w.x, p)))); }
            el[e] = p; }
        wave_sum_n(el);
#pragma unroll
        for (int e = 0; e < 8; ++e) el[e] += rbias[4 + gi * 8 + e];
        int i0 = 0; float m0 = el[0];
#pragma unroll
        for (int e = 1; e < 8; ++e) if (el[e] > m0) { m0 = el[e]; i0 = e; }
        int i1 = -1; float m1 = -3.0e38f;
#pragma unroll
        for (int e = 0; e < 8; ++e) if (e != i0 && el[e] > m1) { m1 = el[e]; i1 = e; }
        const float t1 = __expf(m1 - m0);
        const float w0 = gwt / (1.f + t1), w1 = gwt * t1 / (1.f + t1);
        if (lane == 0) {
            const unsigned e0 = (unsigned)(gi * 8 + i0), e1 = (unsigned)(gi * 8 + i1);
            const unsigned r0 = __hip_atomic_fetch_add(lcnt + e0, 1u, __ATOMIC_RELAXED, __HIP_MEMORY_SCOPE_WORKGROUP);
            const unsigned r1 = __hip_atomic_fetch_add(lcnt + e1, 1u, __ATOMIC_RELAXED, __HIP_MEMORY_SCOPE_WORKGROUP);
            v4u q0; q0.x = e0; q0.y = e1; q0.z = r0; q0.w = r1;
            v4u q1; q1.x = __builtin_bit_cast(unsigned, w0); q1.y = __builtin_bit_cast(unsigned, w1); q1.z = 0u; q1.w = 0u;
            *(GAS v4u*)(ROUTE + (size_t)row * 8) = q0; *(GAS v4u*)(ROUTE + (size_t)row * 8 + 4) = q1;
        }
        }
    }
    __syncthreads();
    if (tid < 32) { unsigned* gcnt = (unsigned*)(a.ws + WS_CTL) + CW_CNT + 64 * L;
        const unsigned base = __hip_atomic_fetch_add(gcnt + tid, lcnt[tid], __ATOMIC_RELAXED, __HIP_MEMORY_SCOPE_AGENT);
        ((unsigned*)(a.ws + WS_BLKBASE))[bid * 32 + tid] = base; }
}
template <int L> __device__ __forceinline__ void moe_tables(const Args& a, LAS unsigned char* lds, int tid) {
    LAS int* seg = (LAS int*)(lds + LDSCTL_OFF) + LC_SEG; LAS int* ntl = (LAS int*)(lds + LDSCTL_OFF) + LC_NT; LAS unsigned char* te = lds + LDSCTL_OFF + LC_TILE_B;
    if (tid < 64) {
        const unsigned* gcnt = (const unsigned*)(a.ws + WS_CTL) + CW_CNT + 64 * L;
        const int c = (tid < 32) ? (int)__hip_atomic_load(gcnt + tid, RLX_AGENT) : 0; const int nt = (c + 255) >> 8;
        int incl = nt;
#pragma unroll
        for (int d = 1; d < 32; d <<= 1) { const int t = __shfl_up(incl, d); if (tid >= d) incl += t; }
        const int run = incl - nt, total = __shfl(incl, 31);
        if (tid < 32) { seg[tid] = run * 256; for (int t = 0; t < nt && run + t < 352; ++t) te[run + t] = (unsigned char)tid; }
        if (tid == 0) *ntl = total < 352 ? total : 352;
    }
    __syncthreads();
}
template <int L> __device__ __forceinline__ void p_dispatch(const Args& a, LAS unsigned char* lds, int tid, int lane, int wave, int bid, int G) {
    constexpr int nrows = (L == 0) ? NT : NLAT;
    moe_tables<L>(a, lds, tid);
    const LAS int* seg = (const LAS int*)(lds + LDSCTL_OFF) + LC_SEG;
    const unsigned* ROUTE = (const unsigned*)(a.ws + WS_ROUTE); const unsigned* BB = (const unsigned*)(a.ws + WS_BLKBASE);
    int* TS = (int*)(a.ws + WS_TOKSLOT); int* TOK = (int*)(a.ws + WS_TOK);
    const int chunk = (nrows + G - 1) / G;
    for (int lr = bid * NTHR + tid; lr < nrows; lr += G * NTHR) {
        const int row = (L == 0) ? lr : lat_row(lr); const int blk = lr / chunk;
        const v4u q0 = *(const GAS v4u*)(ROUTE + (size_t)row * 8);
        const int s0 = seg[q0.x] + (int)BB[blk * 32 + q0.x] + (int)q0.z, s1 = seg[q0.y] + (int)BB[blk * 32 + q0.y] + (int)q0.w;
        if (s0 < MAXSLOT && s1 < MAXSLOT) { TS[row * 2] = s0; TS[row * 2 + 1] = s1; TOK[s0] = row; TOK[s1] = row; }
    }
}
__device__ __forceinline__ void p11_combine_mod(const Args& a, int lane, int wave, int bid, int G) {
    bf16* X = slotp(a, 4); const bf16* YS = (const bf16*)(a.ws + WS_XS); const int* TS = (const int*)(a.ws + WS_TOKSLOT); bf16* H1 = slotp(a, 6);
    const float* RW = (const float*)(a.ws + WS_ROUTE);
    const int NGW = G * NWAVES; constexpr int CU_ = 4;
    for (int gi = bid * NWAVES + wave; gi < NT / CU_; gi += NGW) {
        const int row0 = CU_ * gi, mr = mod_row(row0);
        int s0[CU_], s1[CU_]; float w0[CU_], w1[CU_];
#pragma unroll
        for (int u = 0; u < CU_; ++u) { const int row = row0 + u; const v2u ts = *(const GAS v2u*)(TS + row * 2); const f32x2_t w = *(const GAS f32x2_t*)(RW + (size_t)row * 8 + 4);
            s0[u] = (int)ts.x; s1[u] = (int)ts.y; w0[u] = w.x; w1[u] = w.y; }
        v2u x[CU_][4], y0[CU_][4], y1[CU_][4];
#pragma unroll
        for (int u = 0; u < CU_; ++u)
            { ld_row_bf(X + (size_t)(row0 + u) * D, lane, x[u]); ld_row_bf(YS + (size_t)s0[u] * D, lane, y0[u]); ld_row_bf(YS + (size_t)s1[u] * D, lane, y1[u]); }
        const float* g2 = modp(a, 0, mr, 5);
        f32x4 v[CU_][4]; float ss[CU_]; v2u xo[CU_][4];
#pragma unroll
        for (int j = 0; j < 4; ++j) { const int c = colb(lane, j); const f32x4 gv = *(const GAS f32x4*)(g2 + c);
#pragma unroll
            for (int u = 0; u < CU_; ++u) {
                const f32x4 f = (f32x4){w0[u] * bflo(y0[u][j].x) + w1[u] * bflo(y1[u][j].x), w0[u] * bfhi(y0[u][j].x) + w1[u] * bfhi(y1[u][j].x), w0[u] * bflo(y0[u][j].y) + w1[u] * bflo(y1[u][j].y), w0[u] * bfhi(y0[u][j].y) + w1[u] * bfhi(y1[u][j].y)};
                const f32x4 xv = (f32x4){bflo(x[u][j].x), bfhi(x[u][j].x), bflo(x[u][j].y), bfhi(x[u][j].y)};
                v[u][j] = xv + gv * f;
                xo[u][j].x = pk2(v[u][j].x, v[u][j].y); xo[u][j].y = pk2(v[u][j].z, v[u][j].w);
                const float q = (v[u][j].x * v[u][j].x + v[u][j].y * v[u][j].y) + (v[u][j].z * v[u][j].z + v[u][j].w * v[u][j].w); ss[u] = (j == 0) ? q : ss[u] + q; } }
#pragma unroll
        for (int u = 0; u < CU_; ++u) st_row_bf(X + (size_t)(row0 + u) * D, lane, xo[u]);
        float rstd[CU_];
#pragma unroll
        for (int u = 0; u < CU_; ++u) rstd[u] = rsqrtf(wave_sum(ss[u]) * (1.f / D) + 1e-6f);
        const float* g = a.in[I_N1G] + D; const float* sh = modp(a, 1, mr, 0); const float* sc = modp(a, 1, mr, 1);
#pragma unroll
        for (int j = 0; j < 4; ++j) { const int c = colb(lane, j); const f32x4 gg = *(const GAS f32x4*)(g + c) * (*(const GAS f32x4*)(sc + c) + 1.f), hh = *(const GAS f32x4*)(sh + c);
#pragma unroll
            for (int u = 0; u < CU_; ++u) { const f32x4 h = (v[u][j] * rstd[u]) * gg + hh; xo[u][j].x = pk2(h.x, h.y); xo[u][j].y = pk2(h.z, h.w); } }
#pragma unroll
        for (int u = 0; u < CU_; ++u) st_row_bf(H1 + (size_t)(row0 + u) * D, lane, xo[u]);
    }
}
__device__ __forceinline__ void p12b_qknorm_rope(const Args& a, int lane, int wave, int bid, int G) {
    bf16 *Q = slotp(a, 0), *K = slotp(a, 1);
    const int ls = lane & 3, axis = ls >> 1, half = ls & 1;
    float qg[16], kg[16], inv[16];
#pragma unroll
    for (int e = 0; e < 16; ++e) { qg[e] = a.in[I_QNG][16 * ls + e]; kg[e] = a.in[I_KNG][16 * ls + e]; inv[e] = exp2f(-(float)e * (13.287712379549449f / 16.f)); }
    const int NGW = G * NWAVES;
    for (int row = bid * NWAVES + wave; row < NT; row += NGW) {
        const int t = row % TT; const size_t o = (size_t)row * D + 16 * lane;
        float q[16], k[16];
        load16(Q + o, q); load16(K + o, k);
        float sq = 0.f, sk = 0.f;
#pragma unroll
        for (int e = 0; e < 16; ++e) { sq += q[e] * q[e]; sk += k[e] * k[e]; }
        const float rq = rsqrtf(quad_sum(sq) * (1.f / 64.f) + 1e-6f), rk = rsqrtf(quad_sum(sk) * (1.f / 64.f) + 1e-6f);
#pragma unroll
        for (int e = 0; e < 16; ++e) { q[e] = q[e] * rq * qg[e]; k[e] = k[e] * rk * kg[e]; }
        if (t >= TC) {
            const int tl = t - TC; const float pos = (float)(axis ? (tl & 63) : (tl >> 6));
#pragma unroll
            for (int e = 0; e < 16; ++e) { const float ang = pos * inv[e]; const float c = __cosf(ang), s = __sinf(ang);
                const float pq = __shfl_xor(q[e], 1), pk = __shfl_xor(k[e], 1);
                q[e] = half ? (pq * s + q[e] * c) : (q[e] * c - pq * s);
                k[e] = half ? (pk * s + k[e] * c) : (k[e] * c - pk * s); }
        }
#pragma unroll
        for (int e = 0; e < 16; ++e) q[e] *= 0.18033688011112042f;
        store16(Q + o, q); store16(K + o, k);
    }
}
__device__ __forceinline__ void p12c_vtranspose(const Args& a, LAS unsigned char* lds, int lane, int wave, int bid, int G) {
    const bf16* V = slotp(a, 2); bf16* VT = slotp(a, 6);
    LAS unsigned short* T = (LAS unsigned short*)(lds + wave * 16384);
    const int NGW = G * NWAVES;
    for (int u = bid * NWAVES + wave; u < NB * 8 * (TT / 64); u += NGW) {
        const int b = u / (8 * (TT / 64)), rem = u - b * (8 * (TT / 64)), h = rem / (TT / 64), kc = rem - h * (TT / 64);
#pragma unroll 4
        for (int i = 0; i < 16; ++i) { const int chunk = i * 64 + lane, key = chunk >> 4, cg = chunk & 15;
            const v4u w = *(const GAS v4u*)(V + (size_t)(b * TT + kc * 64 + key) * D + h * 128 + cg * 8);
            const int kq = key & 15, pos = (key & ~15) | (kq & 3) | ((kq & 4) << 1) | ((kq & 8) >> 1);
            LAS unsigned short* t = T + (cg * 8) * 64 + pos;
            t[0 * 64] = (unsigned short)(w.x & 0xffffu); t[1 * 64] = (unsigned short)(w.x >> 16); t[2 * 64] = (unsigned short)(w.y & 0xffffu); t[3 * 64] = (unsigned short)(w.y >> 16);
            t[4 * 64] = (unsigned short)(w.z & 0xffffu); t[5 * 64] = (unsigned short)(w.z >> 16); t[6 * 64] = (unsigned short)(w.w & 0xffffu); t[7 * 64] = (unsigned short)(w.w >> 16); }
        LDS_WAIT(); asm volatile("" ::: "memory");
#pragma unroll 4
        for (int i = 0; i < 16; ++i) { const int chunk = i * 64 + lane, e = chunk >> 3, c8 = chunk & 7;
            const v4u o = *(const LAS v4u*)(T + e * 64 + c8 * 8);
            *(GAS v4u*)(VT + ((size_t)((b * 8 + h) * 128 + e)) * TT + kc * 64 + c8 * 8) = o; }
        LDS_WAIT(); asm volatile("" ::: "memory");
    }
}
typedef float f32x16 __attribute__((ext_vector_type(16)));
typedef short s16x8 __attribute__((ext_vector_type(8)));
__device__ __forceinline__ unsigned cvtpk(float lo, float hi) { unsigned r; asm volatile("v_cvt_pk_bf16_f32 %0, %1, %2" : "=v"(r) : "v"(lo), "v"(hi)); return r; }
__device__ __forceinline__ s16x8 pack_p(const f32x16& x, int s8) { v4u w; w.x = cvtpk(x[s8], x[s8 + 1]); w.y = cvtpk(x[s8 + 2], x[s8 + 3]); w.z = cvtpk(x[s8 + 4], x[s8 + 5]); w.w = cvtpk(x[s8 + 6], x[s8 + 7]); return __builtin_bit_cast(s16x8, w); }
__device__ __forceinline__ void p13_attention(const Args& a, LAS unsigned char* lds, int tid, int lane, int wave, int bid, int G) {
    const bf16 *Q = slotp(a, 0), *K = slotp(a, 1), *V = slotp(a, 2); bf16* AO = slotp(a, 6);
    constexpr int KP = 144, VP = 320, KBYTES = 64 * KP, STAGE = KBYTES + 64 * VP, NTILE = TT / 64, XOFF = 2 * STAGE, XP = 272;
    typedef short s16x4 __attribute__((ext_vector_type(4)));
    const int r32 = lane & 31, hh = lane >> 5;
    const float lam_init = 0.8f - 0.6f * expf(-0.3f);
    float d1 = 0.f, d2 = 0.f;
    for (int e = 0; e < 64; ++e) { d1 += a.in[I_LQ1][e] * a.in[I_LK1][e]; d2 += a.in[I_LQ2][e] * a.in[I_LK2][e]; }
    const float lam = expf(d1) - expf(d2) + lam_init;
    const int kkey = tid >> 3, kc8 = tid & 7, vkey = tid >> 4, vch = tid & 15;
    const unsigned klds = (unsigned)(kkey * KP + kc8 * 16), vlds0 = (unsigned)(KBYTES + vkey * VP + vch * 16), vlds1 = vlds0 + 32 * VP;
    const unsigned vrd = (unsigned)((4 * hh + ((lane & 15) >> 2)) * VP + (16 * ((lane >> 4) & 1) + 4 * (lane & 3)) * 2);
    LAS unsigned char* xw = lds + XOFF + (wave * 32 + r32) * XP;
    for (int unit = bid; unit < NB * 8 * 8; unit += G) {
        const int b = unit >> 6, h = (unit >> 3) & 7, qt = unit & 7;
        const int qrow = b * TT + TC + qt * 256 + wave * 32 + r32;
        const bf16* vg = V + (size_t)(b * TT + vkey) * D + h * 128 + vch * 8;
        f32x16 acc[4];
        float lsum = 0.f;
#pragma unroll 1
        for (int m = 0; m < 2; ++m) {
            s16x8 qf[4];
#pragma unroll
            for (int ks = 0; ks < 4; ++ks) qf[ks] = __builtin_bit_cast(s16x8, *(const GAS v4u*)(Q + (size_t)qrow * D + h * 128 + m * 64 + 16 * ks + 8 * hh));
#pragma unroll
            for (int eb = 0; eb < 4; ++eb)
#pragma unroll
                for (int r = 0; r < 16; ++r) acc[eb][r] = 0.f;
            lsum = 0.f;
            const bf16* kg = K + (size_t)(b * TT + kkey) * D + h * 128 + m * 64 + kc8 * 8;
            v4u sk = *(const GAS v4u*)kg, sv0 = *(const GAS v4u*)vg, sv1 = *(const GAS v4u*)(vg + (size_t)32 * D);
            __syncthreads();
            *(LAS v4u*)(lds + klds) = sk; *(LAS v4u*)(lds + vlds0) = sv0; *(LAS v4u*)(lds + vlds1) = sv1;
            __syncthreads();
            for (int t = 0; t < NTILE; ++t) {
                const bool more = (t + 1 < NTILE);
                if (more) { sk = *(const GAS v4u*)(kg + (size_t)(t + 1) * 64 * D); sv0 = *(const GAS v4u*)(vg + (size_t)(t + 1) * 64 * D); sv1 = *(const GAS v4u*)(vg + (size_t)(t + 1) * 64 * D + (size_t)32 * D); }
                const LAS unsigned char* kb_ = lds + (t & 1) * STAGE; const LAS unsigned char* vb_ = kb_ + KBYTES;
#pragma unroll
                for (int kb = 0; kb < 2; ++kb) {
                    f32x16 x;
#pragma unroll
                    for (int r = 0; r < 16; ++r) x[r] = 0.f;
#pragma unroll
                    for (int ks = 0; ks < 4; ++ks) { const s16x8 kf = *(const LAS s16x8*)(kb_ + (32 * kb + r32) * KP + (16 * ks + 8 * hh) * 2); x = __builtin_amdgcn_mfma_f32_32x32x16_bf16(kf, qf[ks], x, 0, 0, 0); }
#pragma unroll
                    for (int r = 0; r < 16; ++r) { x[r] = __builtin_amdgcn_exp2f(x[r]); lsum += x[r]; }
                    const s16x8 p0 = pack_p(x, 0), p1 = pack_p(x, 8);
#pragma unroll
                    for (int eb = 0; eb < 4; ++eb) {
                        const LAS unsigned char* vp_ = vb_ + vrd + (32 * kb) * VP + eb * 64;
                        const s16x4 t0 = __builtin_amdgcn_ds_read_tr16_b64_v4i16((LAS s16x4*)(vp_)), t1 = __builtin_amdgcn_ds_read_tr16_b64_v4i16((LAS s16x4*)(vp_ + 8 * VP));
                        const s16x4 t2 = __builtin_amdgcn_ds_read_tr16_b64_v4i16((LAS s16x4*)(vp_ + 16 * VP)), t3 = __builtin_amdgcn_ds_read_tr16_b64_v4i16((LAS s16x4*)(vp_ + 24 * VP));
                        const s16x8 vf0 = __builtin_shufflevector(t0, t1, 0, 1, 2, 3, 4, 5, 6, 7), vf1 = __builtin_shufflevector(t2, t3, 0, 1, 2, 3, 4, 5, 6, 7);
                        acc[eb] = __builtin_amdgcn_mfma_f32_32x32x16_bf16(vf0, p0, acc[eb], 0, 0, 0);
                        acc[eb] = __builtin_amdgcn_mfma_f32_32x32x16_bf16(vf1, p1, acc[eb], 0, 0, 0); }
                }
                if (more) { LAS unsigned char* nb_ = lds + ((t + 1) & 1) * STAGE; *(LAS v4u*)(nb_ + klds) = sk; *(LAS v4u*)(nb_ + vlds0) = sv0; *(LAS v4u*)(nb_ + vlds1) = sv1; }
                __syncthreads();
            }
            lsum += __shfl_xor(lsum, 32);
            if (m == 0) {
                const float il = 1.f / lsum;
#pragma unroll
                for (int eb = 0; eb < 4; ++eb)
#pragma unroll
                    for (int g4 = 0; g4 < 4; ++g4) { v2u o; o.x = pk2(acc[eb][4 * g4] * il, acc[eb][4 * g4 + 1] * il); o.y = pk2(acc[eb][4 * g4 + 2] * il, acc[eb][4 * g4 + 3] * il);
                        *(LAS v2u*)(xw + (32 * eb + 8 * g4 + 4 * hh) * 2) = o; }
            }
        }
        const float il1 = lam / lsum;
        float ssq = 0.f;
#pragma unroll
        for (int eb = 0; eb < 4; ++eb)
#pragma unroll
            for (int g4 = 0; g4 < 4; ++g4) { const v2u x0 = *(const LAS v2u*)(xw + (32 * eb + 8 * g4 + 4 * hh) * 2);
                const float o0 = bflo(x0.x) - acc[eb][4 * g4] * il1, o1 = bfhi(x0.x) - acc[eb][4 * g4 + 1] * il1, o2 = bflo(x0.y) - acc[eb][4 * g4 + 2] * il1, o3 = bfhi(x0.y) - acc[eb][4 * g4 + 3] * il1;
                acc[eb][4 * g4] = o0; acc[eb][4 * g4 + 1] = o1; acc[eb][4 * g4 + 2] = o2; acc[eb][4 * g4 + 3] = o3; ssq += (o0 * o0 + o1 * o1) + (o2 * o2 + o3 * o3); }
        ssq += __shfl_xor(ssq, 32);
        const float rstd = rsqrtf(ssq * (1.f / 128.f) + 1e-6f) * (1.f - lam_init);
#pragma unroll
        for (int eb = 0; eb < 4; ++eb)
#pragma unroll
            for (int g4 = 0; g4 < 4; ++g4) { const int e0 = 32 * eb + 8 * g4 + 4 * hh; const f32x4 sg = *(const GAS f32x4*)(a.in[I_SUBG] + e0);
                v2u o; o.x = pk2(acc[eb][4 * g4] * rstd * sg.x, acc[eb][4 * g4 + 1] * rstd * sg.y); o.y = pk2(acc[eb][4 * g4 + 2] * rstd * sg.z, acc[eb][4 * g4 + 3] * rstd * sg.w);
                *(GAS v2u*)(AO + (size_t)qrow * D + h * 128 + e0) = o; }
    }
}
__device__ __forceinline__ void p19_final(const Args& a, int lane, int wave, int bid, int G) {
    const bf16* X = slotp(a, 4); const bf16* YS = (const bf16*)(a.ws + WS_XS); const int* TS = (const int*)(a.ws + WS_TOKSLOT);
    const float* RW = (const float*)(a.ws + WS_ROUTE);
    const int NGW = G * NWAVES;
    for (int gi = bid * NWAVES + wave; gi < NLAT / 4; gi += NGW) {
        const int lr0 = 4 * gi, b = lr0 >> 11;
        int s0[4], s1[4]; float w0[4], w1[4];
#pragma unroll
        for (int u = 0; u < 4; ++u) { const int row = lat_row(lr0 + u); const v2u ts = *(const GAS v2u*)(TS + row * 2); const f32x2_t w = *(const GAS f32x2_t*)(RW + (size_t)row * 8 + 4);
            s0[u] = (int)ts.x; s1[u] = (int)ts.y; w0[u] = w.x; w1[u] = w.y; }
        v2u x[4][4], y0[4][4], y1[4][4];
#pragma unroll
        for (int u = 0; u < 4; ++u) { const int row = lat_row(lr0 + u);
            { ld_row_bf(X + (size_t)row * D, lane, x[u]); ld_row_bf(YS + (size_t)s0[u] * D, lane, y0[u]); ld_row_bf(YS + (size_t)s1[u] * D, lane, y1[u]); } }
        const float* g2 = modp(a, 1, b, 5);
        f32x4 gv[4];
#pragma unroll
        for (int j = 0; j < 4; ++j) gv[j] = *(const GAS f32x4*)(g2 + colb(lane, j));
#pragma unroll
        for (int u = 0; u < 4; ++u)
#pragma unroll
            for (int j = 0; j < 4; ++j) { const int c = colb(lane, j);
                const f32x4 f = (f32x4){w0[u] * bflo(y0[u][j].x) + w1[u] * bflo(y1[u][j].x), w0[u] * bfhi(y0[u][j].x) + w1[u] * bfhi(y1[u][j].x), w0[u] * bflo(y0[u][j].y) + w1[u] * bflo(y1[u][j].y), w0[u] * bfhi(y0[u][j].y) + w1[u] * bfhi(y1[u][j].y)};
                const f32x4 xv = (f32x4){bflo(x[u][j].x), bfhi(x[u][j].x), bflo(x[u][j].y), bfhi(x[u][j].y)};
                *(GAS f32x4*)(a.out + (size_t)(lr0 + u) * D + c) = xv + gv[j] * f; }
    }
}
__device__ __forceinline__ v4u pack2x4(const f32x4& v0, const f32x4& v1) { v4u w; w.x = pk2(v0.x, v0.y); w.y = pk2(v0.z, v0.w); w.z = pk2(v1.x, v1.y); w.w = pk2(v1.z, v1.w); return w; }
struct F_Lora1 {
    bf16* L1;
    __device__ __forceinline__ void op(int row, int col, const f32x4& v0, const f32x4& v1) const {
        const int t = col >> 8, c = col & 255, rr = row - t * NT; f32x4 x0 = v0, x1 = v1;
        if (c < 128) {
            if (t == 0) { x0 = (f32x4){ftanh(v0.x), ftanh(v0.y), ftanh(v0.z), ftanh(v0.w)}; x1 = (f32x4){ftanh(v1.x), ftanh(v1.y), ftanh(v1.z), ftanh(v1.w)}; }
            else if (t == 2) { x0 = (f32x4){fsigmoid(v0.x), fsigmoid(v0.y), fsigmoid(v0.z), fsigmoid(v0.w)}; x1 = (f32x4){fsigmoid(v1.x), fsigmoid(v1.y), fsigmoid(v1.z), fsigmoid(v1.w)}; }
            *(GAS v4u*)(L1 + (size_t)rr * 512 + t * 128 + c) = pack2x4(x0, x1);
        } else if (t == 2) { *(GAS v4u*)(L1 + (size_t)rr * 512 + 384 + (c - 128)) = (v4u){0u, 0u, 0u, 0u}; }
    }
};
struct F_Rkv {
    bf16* O;
    __device__ __forceinline__ void op(int row, int col, const f32x4& v0, const f32x4& v1) const {
        const int t = col >> 10, c = col & 1023; *(GAS v4u*)(O + (size_t)t * US + (size_t)(row - t * NT) * D + c) = pack2x4(v0, v1); }
};
struct StackOrder : pg8::StaticOrder {
    int per;
    __device__ __forceinline__ bool next(int i, pg8::Unit& u) const { if (!pg8::StaticOrder::next(i, u)) return false; u.pm += (u.pn / per) * (NT / 256); return true; }
};
struct F_Split3 {
    bf16* O; bf16* L1;
    __device__ __forceinline__ void op(int row, int col, const f32x4& v0, const f32x4& v1) const {
        if (col < 3072) { const int t = col >> 10, c = col & 1023; *(GAS v4u*)(O + (size_t)t * US + (size_t)row * D + c) = pack2x4(v0, v1); }
        else { const int cl = col - 3072, reg = cl >> 7; f32x4 x0 = v0, x1 = v1;
            if (reg == 0) { x0 = (f32x4){ftanh(v0.x), ftanh(v0.y), ftanh(v0.z), ftanh(v0.w)}; x1 = (f32x4){ftanh(v1.x), ftanh(v1.y), ftanh(v1.z), ftanh(v1.w)}; }
            else if (reg == 2) { x0 = (f32x4){fsigmoid(v0.x), fsigmoid(v0.y), fsigmoid(v0.z), fsigmoid(v0.w)}; x1 = (f32x4){fsigmoid(v1.x), fsigmoid(v1.y), fsigmoid(v1.z), fsigmoid(v1.w)}; }
            else if (reg == 3) { x0 = (f32x4){0.f, 0.f, 0.f, 0.f}; x1 = x0; }
            *(GAS v4u*)(L1 + (size_t)row * 512 + cl) = pack2x4(x0, x1); }
    }
};
struct F_Lora2 {
    bf16 *DD0, *DD1, *A0, *A1; const float* w0; const float* a0;
    __device__ __forceinline__ void op(int row, int col, const f32x4& v0, const f32x4& v1) const {
        const int t = col >> 10, c = col & 1023;
        bf16* dst = (t == 0) ? DD0 : (t == 1) ? DD1 : (t == 2) ? A0 : A1;
        const float* bias = (t < 2) ? (w0 + t * 1024 + c) : (a0 + (t - 2) * 1024 + c);
        const f32x4 b0 = *(const GAS f32x4*)bias, b1 = *(const GAS f32x4*)(bias + 4);
        float x[8] = {v0.x + b0.x, v0.y + b0.y, v0.z + b0.z, v0.w + b0.w, v1.x + b1.x, v1.y + b1.y, v1.z + b1.z, v1.w + b1.w};
#pragma unroll
        for (int e = 0; e < 8; ++e) { const float sg = fsigmoid(x[e]); x[e] = (t < 2) ? (1.f - fexp(-0.6065306597f * sg)) : sg; }
        *(GAS v4u*)(dst + (size_t)row * D + c) = pack8(x);
    }
};
struct F_Gate {
    const bf16* YN; bf16* Z;
    __device__ __forceinline__ void op(int row, int col, const f32x4& v0, const f32x4& v1) const {
        float y[8]; unpack8(*(const GAS v4u*)(YN + (size_t)row * D + col), y);
        float x[8] = {y[0] * v0.x, y[1] * v0.y, y[2] * v0.z, y[3] * v0.w, y[4] * v1.x, y[5] * v1.y, y[6] * v1.z, y[7] * v1.w};
        *(GAS v4u*)(Z + (size_t)row * D + col) = pack8(x);
    }
};
struct F_Wo0 {
    const float* x; const float* ctx; const float* mod0; bf16* X;
    __device__ __forceinline__ void op(int row, int col, const f32x4& v0, const f32x4& v1) const {
        const int b = row / TT, t = row - b * TT;
        const float* xr = ((t < TC) ? ctx + ((size_t)b * TC + t) * D : x + ((size_t)b * TL + (t - TC)) * D) + col;
        const float* g = mod0 + (size_t)((t < TC) ? 16 : b) * 6144 + 2 * D + col;
        *(GAS v4u*)(X + (size_t)row * D + col) = pack2x4(*(const GAS f32x4*)xr + *(const GAS f32x4*)g * v0, *(const GAS f32x4*)(xr + 4) + *(const GAS f32x4*)(g + 4) * v1);
    }
};
struct F_Wo1 {
    const float* gate; bf16* X;
    __device__ __forceinline__ void op(int row, int col, const f32x4& v0, const f32x4& v1) const {
        const float* g = gate + (size_t)(row / TT) * 6144 + col;
        GAS v4u* p = (GAS v4u*)(X + (size_t)row * D + col); float y[8]; unpack8(*p, y);
        const f32x4 g0 = *(const GAS f32x4*)g, g1 = *(const GAS f32x4*)(g + 4);
        float o[8] = {y[0] + g0.x * v0.x, y[1] + g0.y * v0.y, y[2] + g0.z * v0.z, y[3] + g0.w * v0.w, y[4] + g1.x * v1.x, y[5] + g1.y * v1.y, y[6] + g1.z * v1.z, y[7] + g1.w * v1.w};
        *p = pack8(o);
    }
};
struct F_GateUp {
    bf16* HID;
    __device__ __forceinline__ void op(int row, int col, const f32x4& g, const f32x4& u) const {
        const int hc = (col & 511) >> 1;
        v2u o; o.x = pk2(g.x * fsigmoid(g.x) * u.x, g.y * fsigmoid(g.y) * u.y); o.y = pk2(g.z * fsigmoid(g.z) * u.z, g.w * fsigmoid(g.w) * u.w);
        *(GAS v2u*)(HID + (size_t)row * 256 + hc) = o;
    }
};
struct F_Down {
    bf16* YS;
    __device__ __forceinline__ void op(int row, int col, const f32x4& v0, const f32x4& v1) const { *(GAS v4u*)(YS + (size_t)row * D + (col & 1023)) = pack2x4(v0, v1); }
};
struct EpiQKV {
    static constexpr bool PERM = true, AFTER_DRAIN = false;
    bf16* O; const float* qng; const float* kng; const float* rope;
    __device__ __forceinline__ void operator()(const f32x4 (&acc)[2][2][4][2], const pg8::Unit& u, int wr, int wc, int fr, int fq) const {
        const int row0 = u.pm * pg8::BM + wr * 64 + fr;
        if (u.pn >= 8) {
            const int col0 = (u.pn - 8) * pg8::BM + wc * 32 + 8 * fq;
#pragma unroll
            for (int ai = 0; ai < 2; ++ai)
#pragma unroll
                for (int m = 0; m < 4; ++m)
#pragma unroll
                    for (int bj = 0; bj < 2; ++bj) *(GAS v4u*)(O + (size_t)2 * US + (size_t)(row0 + ai * pg8::HALF + m * 16) * D + col0 + bj * pg8::HALF) = pack2x4(acc[ai][bj][m][0], acc[ai][bj][m][1]);
            return;
        }
        const bool isq = u.pn < 4;
        const int A = fq >> 1, B = fq & 1, e0 = 32 * A + 8 * B;
        bf16* dst = O + (isq ? (size_t)0 : US) + (u.pn & 3) * pg8::BM + 64 * wc + e0;
        const float* gn = (isq ? qng : kng) + e0;
        const float qs = isq ? 0.18033688011112042f : 1.f;
        const f32x4 gl0 = *(const GAS f32x4*)gn * qs, gl1 = *(const GAS f32x4*)(gn + 4) * qs, gh0 = *(const GAS f32x4*)(gn + 16) * qs, gh1 = *(const GAS f32x4*)(gn + 20) * qs;
        const int tb = u.pm % 9;
#pragma unroll
        for (int ai = 0; ai < 2; ++ai)
#pragma unroll
            for (int m = 0; m < 4; ++m) {
                f32x4 l0 = acc[ai][0][m][0], l1 = acc[ai][0][m][1], h0 = acc[ai][1][m][0], h1 = acc[ai][1][m][1];
                float ss = ((l0.x * l0.x + l0.y * l0.y) + (l0.z * l0.z + l0.w * l0.w)) + ((l1.x * l1.x + l1.y * l1.y) + (l1.z * l1.z + l1.w * l1.w))
                         + ((h0.x * h0.x + h0.y * h0.y) + (h0.z * h0.z + h0.w * h0.w)) + ((h1.x * h1.x + h1.y * h1.y) + (h1.z * h1.z + h1.w * h1.w));
                ss = rows4_sum(ss);
                const float rstd = rsqrtf(ss * (1.f / 64.f) + 1e-6f);
                l0 = l0 * rstd * gl0; l1 = l1 * rstd * gl1; h0 = h0 * rstd * gh0; h1 = h1 * rstd * gh1;
                if (tb != 0) {
                    const int pos = A ? (16 * m + fr) : (4 * (tb - 1) + wr + 2 * ai);
                    const float* rp = rope + pos * 32 + B * 16;
                    const f32x4 c0 = *(const GAS f32x4*)rp, c1 = *(const GAS f32x4*)(rp + 4), s0 = *(const GAS f32x4*)(rp + 8), s1 = *(const GAS f32x4*)(rp + 12);
                    const f32x4 nl0 = l0 * c0 - h0 * s0, nl1 = l1 * c1 - h1 * s1, nh0 = h0 * c0 + l0 * s0, nh1 = h1 * c1 + l1 * s1;
                    l0 = nl0; l1 = nl1; h0 = nh0; h1 = nh1;
                }
                bf16* d = dst + (size_t)(row0 + ai * pg8::HALF + m * 16) * D;
                *(GAS v4u*)d = pack2x4(l0, l1); *(GAS v4u*)(d + 16) = pack2x4(h0, h1);
            }
    }
};
struct EpiWo1 {
    static constexpr bool PERM = true, AFTER_DRAIN = false;
    const float* gate; bf16* X;
    __device__ __forceinline__ void operator()(const f32x4 (&acc)[2][2][4][2], const pg8::Unit& u, int wr, int wc, int fr, int fq) const {
        const int row0 = u.pm * pg8::BM + wr * 64 + fr, col0 = u.pn * pg8::BM + wc * 32 + 8 * fq;
        const float* g = gate + (size_t)(u.pm / 9) * 6144 + col0;
        f32x4 gv[2][2];
#pragma unroll
        for (int bj = 0; bj < 2; ++bj) { gv[bj][0] = *(const GAS f32x4*)(g + bj * pg8::HALF); gv[bj][1] = *(const GAS f32x4*)(g + bj * pg8::HALF + 4); }
        v4u xv[2][4][2];
#pragma unroll
        for (int ai = 0; ai < 2; ++ai)
#pragma unroll
            for (int m = 0; m < 4; ++m)
#pragma unroll
                for (int bj = 0; bj < 2; ++bj) xv[ai][m][bj] = *(const GAS v4u*)(X + (size_t)(row0 + ai * pg8::HALF + m * 16) * D + col0 + bj * pg8::HALF);
#pragma unroll
        for (int ai = 0; ai < 2; ++ai)
#pragma unroll
            for (int m = 0; m < 4; ++m)
#pragma unroll
                for (int bj = 0; bj < 2; ++bj) { float y[8]; unpack8(xv[ai][m][bj], y); const f32x4 v0 = acc[ai][bj][m][0], v1 = acc[ai][bj][m][1], g0 = gv[bj][0], g1 = gv[bj][1];
                    float o[8] = {y[0] + g0.x * v0.x, y[1] + g0.y * v0.y, y[2] + g0.z * v0.z, y[3] + g0.w * v0.w, y[4] + g1.x * v1.x, y[5] + g1.y * v1.y, y[6] + g1.z * v1.z, y[7] + g1.w * v1.w};
                    *(GAS v4u*)(X + (size_t)(row0 + ai * pg8::HALF + m * 16) * D + col0 + bj * pg8::HALF) = pack8(o); }
    }
};
struct EpiGate {
    static constexpr bool PERM = true, AFTER_DRAIN = false;
    const bf16* YN; bf16* Z;
    __device__ __forceinline__ void operator()(const f32x4 (&acc)[2][2][4][2], const pg8::Unit& u, int wr, int wc, int fr, int fq) const {
        const int row0 = u.pm * pg8::BM + wr * 64 + fr, col0 = u.pn * pg8::BM + wc * 32 + 8 * fq;
#pragma unroll
        for (int ai = 0; ai < 2; ++ai) {
            v4u yv[4][2];
#pragma unroll
            for (int m = 0; m < 4; ++m)
#pragma unroll
                for (int bj = 0; bj < 2; ++bj) yv[m][bj] = *(const GAS v4u*)(YN + (size_t)(row0 + ai * pg8::HALF + m * 16) * D + col0 + bj * pg8::HALF);
#pragma unroll
            for (int m = 0; m < 4; ++m)
#pragma unroll
                for (int bj = 0; bj < 2; ++bj) { float y[8]; unpack8(yv[m][bj], y); const f32x4 v0 = acc[ai][bj][m][0], v1 = acc[ai][bj][m][1];
                    float o[8] = {y[0] * v0.x, y[1] * v0.y, y[2] * v0.z, y[3] * v0.w, y[4] * v1.x, y[5] * v1.y, y[6] * v1.z, y[7] * v1.w};
                    *(GAS v4u*)(Z + (size_t)(row0 + ai * pg8::HALF + m * 16) * D + col0 + bj * pg8::HALF) = pack8(o); }
        }
    }
};
struct EpiWo0 {
    static constexpr bool PERM = true, AFTER_DRAIN = false;
    const float* x; const float* ctx; const float* mod0; bf16* X;
    __device__ __forceinline__ void operator()(const f32x4 (&acc)[2][2][4][2], const pg8::Unit& u, int wr, int wc, int fr, int fq) const {
        const int lrow = wr * 64 + fr, col0 = u.pn * pg8::BM + wc * 32 + 8 * fq;
        const int b = u.pm / 9, tb = u.pm - 9 * b;
        const float* xr0 = ((tb == 0) ? ctx + (size_t)b * TC * D : x + ((size_t)b * TL + (size_t)(tb - 1) * 256) * D) + (size_t)lrow * D + col0;
        const float* g = mod0 + (size_t)((tb == 0) ? 16 : b) * 6144 + 2 * D + col0;
        f32x4 gv[2][2];
#pragma unroll
        for (int bj = 0; bj < 2; ++bj) { gv[bj][0] = *(const GAS f32x4*)(g + bj * pg8::HALF); gv[bj][1] = *(const GAS f32x4*)(g + bj * pg8::HALF + 4); }
#pragma unroll
        for (int ai = 0; ai < 2; ++ai) {
            f32x4 xv[4][2][2];
#pragma unroll
            for (int m = 0; m < 4; ++m)
#pragma unroll
                for (int bj = 0; bj < 2; ++bj) { const float* p = xr0 + (size_t)(ai * pg8::HALF + m * 16) * D + bj * pg8::HALF; xv[m][bj][0] = *(const GAS f32x4*)p; xv[m][bj][1] = *(const GAS f32x4*)(p + 4); }
#pragma unroll
            for (int m = 0; m < 4; ++m)
#pragma unroll
                for (int bj = 0; bj < 2; ++bj)
                    *(GAS v4u*)(X + (size_t)(u.pm * pg8::BM + lrow + ai * pg8::HALF + m * 16) * D + col0 + bj * pg8::HALF) = pack2x4(xv[m][bj][0] + gv[bj][0] * acc[ai][bj][m][0], xv[m][bj][1] + gv[bj][1] * acc[ai][bj][m][1]);
        }
    }
};
struct MoeOrder {
    const LAS unsigned char* te; int nunits, nN, G, c;
    __device__ __forceinline__ bool next(int i, pg8::Unit& u) const { const int L = i * G + c; if (L >= nunits) return false; const int T = L / nN; u.pm = T; u.pn = (int)te[T] * nN + (L - T * nN); return true; }
    __device__ __forceinline__ void a_ready(const pg8::Unit&) const {}
    __device__ __forceinline__ void done(const pg8::Unit&) const {}
};
struct LatOrder {
    int G, c;
    __device__ __forceinline__ bool next(int i, pg8::Unit& u) const { const int L = i * G + c; if (L >= 512) return false; const int q = L >> 2; u.pm = (q >> 3) * 9 + 1 + (q & 7); u.pn = L & 3; return true; }
    __device__ __forceinline__ void a_ready(const pg8::Unit&) const {}
    __device__ __forceinline__ void done(const pg8::Unit&) const {}
};
__device__ __forceinline__ void moe_gather_table(const Args& a, LAS unsigned char* lds, int tid, int bid, int G, int nunits) {
    LAS int* gtab = (LAS int*)(lds + 131072); const int* TOK = (const int*)(a.ws + WS_TOK);
    for (int i = 0; i < 16; ++i) { const int Lu = i * G + bid; if (Lu >= nunits) break; if (tid < 256) gtab[i * 256 + tid] = TOK[(Lu >> 1) * 256 + tid] * 2048; }
    __syncthreads();
}
__device__ __forceinline__ int fresh_lane() { int t = threadIdx.x; asm volatile("" : "+v"(t)); return t & 63; }
__device__ __forceinline__ int fresh_wave() { int t = threadIdx.x; asm volatile("" : "+v"(t)); return __builtin_amdgcn_readfirstlane(t >> 6); }
__global__ void __launch_bounds__(NTHR, 2) mega_fwd(Args args) {
    extern __shared__ __attribute__((aligned(16))) unsigned char lds_raw[];
    LAS unsigned char* lds = (LAS unsigned char*)lds_raw;
    const int tid = threadIdx.x, bid = blockIdx.x, G = gridDim.x;
    { int t0 = threadIdx.x; asm volatile("" : "+v"(t0));
      for (int u = t0; u < (LDS_BYTES - LDSCTL_OFF) / 4; u += NTHR) ((LAS unsigned*)(lds + LDSCTL_OFF))[u] = 0u; }
    __syncthreads();
#if MK_ONE_LAUNCH
    XcdBarrier bar = xcd_barrier_post((unsigned*)(args.ws + WS_CTL) + CW_BAR, (volatile LAS unsigned*)(lds + LDSCTL_OFF) + LC_BAR);
#define GRID_BAR() xcd_barrier(bar)
#else
#define GRID_BAR() do { } while (0)
#endif
    const int lo = args.ph_lo, hi = args.ph_hi;
#define IN(k) (lo <= (k) && (k) < hi)
#define SEAM(k) do { if (IN(k) && IN((k) + 1)) GRID_BAR(); } while (0)
    const Args& a = args;
#define X32 (slotp(a, 4))
#define L1 ((bf16*)(a.ws + WS_L1))
#define te ((const LAS unsigned char*)(lds + LDSCTL_OFF + LC_TILE_B))
#define ntl ((const LAS int*)(lds + LDSCTL_OFF) + LC_NT)

    if (IN(0)) { p0_prologue(a, lds, tid, fresh_lane(), fresh_wave(), bid, G); } SEAM(0);
    if (IN(1)) { p1_modshift(a, fresh_lane(), fresh_wave(), bid, G); } SEAM(1);
    if (IN(2)) {
        pg8::Gemm g{slotp(a, 3), (const bf16*)(a.ws + WS_BT0) + (size_t)3072 * 1024, 1024, 1024}; StackOrder S; S.init(NT, 768, G, bid); S.per = 1;
        pg8::EpiP<F_Lora1> E{{L1}};
        pg8::gemm_phase<pg8::EpiP<F_Lora1>, StackOrder, true, true>(lds, g, S, E);
    } SEAM(2);
    if (IN(3)) {
        pg8::Gemm g{slotp(a, 0), (const bf16*)(a.ws + WS_BT0), 1024, 1024}; StackOrder S; S.init(NT, 3072, G, bid); S.per = 4;
        pg8::EpiP<F_Rkv> E{{slotp(a, 3)}};
        pg8::gemm_phase<pg8::EpiP<F_Rkv>, StackOrder, true, true>(lds, g, S, E);
    } SEAM(3);
#if MK_SCAN_CHUNKED == 2
    if (IN(5)) { p4_scan_v3(a, lds, tid, fresh_lane(), fresh_wave(), bid, G); } SEAM(5);
#elif MK_SCAN_CHUNKED
    if (IN(5)) { p4_scan_chunked(a, lds, tid, fresh_lane(), fresh_wave(), bid, G); } SEAM(5);
#else
    if (IN(5)) { p4_scan(a, lds, tid, fresh_lane(), fresh_wave(), bid, G); } SEAM(5);
#endif
    if (IN(6)) { p5a_groupnorm(a, fresh_lane(), fresh_wave(), bid, G); convert_moe(a, 0, WS_MW0, lds, fresh_wave(), fresh_lane(), bid, G); } SEAM(6);
    if (IN(7)) {
        pg8::Gemm g{L1 + 256, (const bf16*)(a.ws + WS_L2B), 512, 256}; pg8::StaticOrder S; S.init(NT, 1024, G, bid);
        EpiGate E{slotp(a, 6), slotp(a, 0)};
        pg8::gemm_phase<EpiGate, pg8::StaticOrder, true, true>(lds, g, S, E);
    } SEAM(7);
    if (IN(8)) {
        pg8::Gemm g{slotp(a, 0), (const bf16*)(a.ws + WS_WO0), 1024, 1024}; pg8::StaticOrder S; S.init(NT, 1024, G, bid);
        EpiWo0 E{a.in[I_X], a.in[I_CTX], (const float*)(a.ws + WS_MOD), X32};
        pg8::gemm_phase<EpiWo0, pg8::StaticOrder, true, true>(lds, g, S, E);
    } SEAM(8);
    if (IN(9)) { p_router<0>(a, lds, tid, fresh_lane(), fresh_wave(), bid, G); } SEAM(9);
    if (IN(10)) { p_dispatch<0>(a, lds, tid, fresh_lane(), fresh_wave(), bid, G); } SEAM(10);
    if (IN(11)) {
        moe_tables<0>(a, lds, tid);
        moe_gather_table(a, lds, tid, bid, G, *ntl * 2);
        pg8::Gemm g{slotp(a, 6), (const bf16*)(a.ws + WS_MW0), 1024, 1024}; MoeOrder S{te, *ntl * 2, 2, G, bid};
        pg8::EpiP<F_GateUp> E{{(bf16*)(a.ws + WS_HID)}};
        pg8::gemm_phase<pg8::EpiP<F_GateUp>, MoeOrder, true, true, true>(lds, g, S, E);
    } SEAM(11);
    if (IN(12)) {
        moe_tables<0>(a, lds, tid);
        pg8::Gemm g{(const bf16*)(a.ws + WS_HID), (const bf16*)(a.ws + WS_MW0) + (size_t)32 * 512 * 1024, 256, 256}; MoeOrder S{te, *ntl * 4, 4, G, bid};
        pg8::EpiP<F_Down> E{{(bf16*)(a.ws + WS_XS)}};
        pg8::gemm_phase<pg8::EpiP<F_Down>, MoeOrder, true, true>(lds, g, S, E);
    } SEAM(12);
    if (IN(13)) { p11_combine_mod(a, fresh_lane(), fresh_wave(), bid, G); convert_moe(a, 1, WS_MW1, lds, fresh_wave(), fresh_lane(), bid, G); } SEAM(13);
    if (IN(14)) {
        pg8::Gemm g{slotp(a, 6), (const bf16*)(a.ws + WS_WQKV), 1024, 1024}; pg8::StaticOrder S; S.init(NT, 3072, G, bid);
        EpiQKV E{slotp(a, 0), a.in[I_QNG], a.in[I_KNG], (const float*)(a.ws + WS_SW)};
        pg8::gemm_phase<EpiQKV, pg8::StaticOrder, true, true>(lds, g, S, E);
    } SEAM(14);
    if (IN(16)) { p13_attention(a, lds, tid, fresh_lane(), fresh_wave(), bid, G); } SEAM(16);
    if (IN(17)) {
        pg8::Gemm g{slotp(a, 6), (const bf16*)(a.ws + WS_WO1), 1024, 1024}; LatOrder S{G, bid};
        EpiWo1 E{modp(a, 1, 0, 2), X32};
        pg8::gemm_phase<EpiWo1, LatOrder, true, true>(lds, g, S, E);
    } SEAM(17);
    if (IN(18)) { p_router<1>(a, lds, tid, fresh_lane(), fresh_wave(), bid, G); } SEAM(18);
    if (IN(19)) { p_dispatch<1>(a, lds, tid, fresh_lane(), fresh_wave(), bid, G); } SEAM(19);
    if (IN(20)) {
        moe_tables<1>(a, lds, tid);
        moe_gather_table(a, lds, tid, bid, G, *ntl * 2);
        pg8::Gemm g{slotp(a, 6), (const bf16*)(a.ws + WS_MW1), 1024, 1024}; MoeOrder S{te, *ntl * 2, 2, G, bid};
        pg8::EpiP<F_GateUp> E{{(bf16*)(a.ws + WS_HID)}};
        pg8::gemm_phase<pg8::EpiP<F_GateUp>, MoeOrder, true, true, true>(lds, g, S, E);
    } SEAM(20);
    if (IN(21)) {
        moe_tables<1>(a, lds, tid);
        pg8::Gemm g{(const bf16*)(a.ws + WS_HID), (const bf16*)(a.ws + WS_MW1) + (size_t)32 * 512 * 1024, 256, 256}; MoeOrder S{te, *ntl * 4, 4, G, bid};
        pg8::EpiP<F_Down> E{{(bf16*)(a.ws + WS_XS)}};
        pg8::gemm_phase<pg8::EpiP<F_Down>, MoeOrder, true, true>(lds, g, S, E);
    } SEAM(21);
    if (IN(22)) { p19_final(a, fresh_lane(), fresh_wave(), bid, G); }
#undef IN
#undef SEAM
#undef X32
#undef L1
#undef te
#undef ntl
}

extern "C" void kernel_launch(void* const* d_in, const int* in_sizes, int n_in, void* d_out, int out_size, void* d_ws, size_t ws_size, hipStream_t stream) {
    static int grid = 0;
    if (grid == 0) {
        if (n_in != 40 || in_sizes[0] != NLAT * D || out_size != NLAT * D || ws_size < WS_END) {
            fprintf(stderr, "kernel_launch: unexpected shapes (n_in %d, in0 %d, out %d, ws %zu); nothing launched\n", n_in, n_in > 0 ? in_sizes[0] : -1, out_size, ws_size); grid = -1; return; }
        int dev = 0, cus = 0;
        if (hipGetDevice(&dev) != hipSuccess || hipDeviceGetAttribute(&cus, hipDeviceAttributeMultiprocessorCount, dev) != hipSuccess) { grid = -1; return; }
        if (hipFuncSetAttribute((const void*)mega_fwd, hipFuncAttributeMaxDynamicSharedMemorySize, LDS_BYTES) != hipSuccess) { fprintf(stderr, "kernel_launch: hipFuncSetAttribute failed\n"); grid = -1; return; }
        int per_cu = 0;
        if (hipOccupancyMaxActiveBlocksPerMultiprocessor(&per_cu, (const void*)mega_fwd, NTHR, LDS_BYTES) != hipSuccess || per_cu < 1) { fprintf(stderr, "kernel_launch: occupancy query says %d\n", per_cu); }
        (void)hipGetLastError();
        grid = cus < 256 ? cus : 256;
    }
    if (grid < 0) return;
    if (hipMemsetAsync((char*)d_ws + WS_CTL, 0, CTL_ZERO_BYTES, stream) != hipSuccess) return;
    Args a{};
    for (int i = 0; i < 40; ++i) a.in[i] = (const float*)d_in[i];
    a.out = (float*)d_out; a.ws = (unsigned char*)d_ws;
#if MK_ONE_LAUNCH
    a.ph_lo = 0; a.ph_hi = N_PH;
    hipLaunchKernelGGL(mega_fwd, dim3(grid), dim3(NTHR), LDS_BYTES, stream, a);
#else
    for (int p = 0; p < N_PH; ++p) { a.ph_lo = p; a.ph_hi = p + 1; hipLaunchKernelGGL(mega_fwd, dim3(grid), dim3(NTHR), LDS_BYTES, stream, a); }
#endif
}
```
